# Optimizing an MI355X kernel written in HIP

```python
import jax, jax.numpy as jnp
from jax import lax
import numpy as np

D_MODEL = 1024
BATCH = 16
SEQ = 2048
DEPTH = 4
DEC_BATCH = 4
DEC_SEQ = 4096
PAST_LEN = 128

GRID_W = 64
BRANCH_W = 256
N_BRANCH = 4
HEAD_DIM = 64
ATTN_SCALE = HEAD_DIM ** -0.5
NA_HEADS = BRANCH_W // HEAD_DIM
NA_KH = 8
NA_KW = 16
NA_QB = 16
NA_KSPAN = 32
HG_HEADS = 4
HG_DK = BRANCH_W // HG_HEADS
HG_DV = BRANCH_W // HG_HEADS
HG_CHUNK = 64
SG_GROUPS = 4
SG_CHUNK = 128
DIL_HEADS = BRANCH_W // HEAD_DIM
DIL_CONFIGS = ((128, 1), (512, 4), (2048, 16))
D_FF = -(-8 * D_MODEL // (3 * 256)) * 256
IN_SIZES = (3 * BRANCH_W,
            BRANCH_W, BRANCH_W, BRANCH_W, BRANCH_W, BRANCH_W,
            2 * BRANCH_W,
            3 * BRANCH_W)
IN_WIDTH = sum(IN_SIZES)
NEG = -1e30
EPS = 1e-6

kernel_name = "hybrid_gated_encoder_na_hgrn2_sgu_dilated"


def _rms_norm(x, g):
    xf = x.astype(jnp.float32)
    y = xf * lax.rsqrt(jnp.mean(xf * xf, axis=-1, keepdims=True) + EPS)
    return (y * g.astype(jnp.float32)).astype(x.dtype)


def _heads(t, n):
    return t.reshape(t.shape[0], t.shape[1], n, -1)


def _alibi_slopes(n):
    start = 2.0 ** (-8.0 / n)
    return np.array([start ** (h + 1) for h in range(n)], np.float32)


def _neighbourhood_attention(q, k, v, rpb):
    B, L, H, hd = q.shape
    rows = L // GRID_W
    kh = min(NA_KH, rows)
    ncb = GRID_W // NA_QB
    r = np.arange(rows)
    row_idx = np.clip(r - kh // 2, 0, rows - kh)[:, None] + np.arange(kh)[None, :]
    qcol = np.arange(GRID_W).reshape(ncb, NA_QB)
    col0 = np.clip(np.arange(ncb) * NA_QB - NA_KW // 2, 0, GRID_W - NA_KSPAN)
    col_idx = col0[:, None] + np.arange(NA_KSPAN)[None, :]
    win0 = np.clip(qcol - NA_KW // 2, 0, GRID_W - NA_KW)
    kc = col_idx[:, None, :]
    col_valid = (kc >= win0[..., None]) & (kc < win0[..., None] + NA_KW)
    row_off = row_idx - r[:, None] + NA_KH - 1
    col_off = np.clip(kc - qcol[..., None], -(NA_KW - 1), NA_KW - 1) + NA_KW - 1
    bias = rpb[:, row_off[:, None, None, :, None], col_off[None, :, :, None, :]]
    bias = jnp.where(col_valid[None, None, :, :, None, :], bias.astype(jnp.float32), NEG)
    qg = q.reshape(B, rows, ncb, NA_QB, H, hd)
    kg = k.reshape(B, rows, GRID_W, H, hd)[:, row_idx][:, :, :, col_idx]
    vg = v.reshape(B, rows, GRID_W, H, hd)[:, row_idx][:, :, :, col_idx]
    s = jnp.einsum('brnqhd,brknjhd->bhrnqkj', qg, kg, preferred_element_type=jnp.float32) * ATTN_SCALE + bias[None]
    p = jax.nn.softmax(s.reshape(B, H, rows, ncb, NA_QB, kh * NA_KSPAN), axis=-1).reshape(s.shape)
    o = jnp.einsum('bhrnqkj,brknjhd->brnqhd', p.astype(v.dtype), vg)
    return o.reshape(B, L, H, hd)


def _hgrn2_scan(q, k, logf, v):
    B, L, H, dk = q.shape
    dv = v.shape[-1]
    C = HG_CHUNK
    nc = L // C

    def chunks(t):
        return t.reshape(B, nc, C, H, t.shape[-1]).transpose(1, 0, 3, 2, 4)

    qc, kc, gc, vc = chunks(q), chunks(k), chunks(logf), chunks(v)
    A = jnp.cumsum(gc, axis=3)
    lower = np.tril(np.ones((C, C), bool))[:, :, None]

    def step(S, inp):
        qi, ki, ai, vi = inp
        diff = ai[:, :, :, None, :] - ai[:, :, None, :, :]
        decay = jnp.where(lower, jnp.exp(jnp.where(lower, diff, 0.0)), 0.0)
        att = jnp.einsum('bhti,bhtsi,bhsi->bhts', qi, decay, ki)
        o = jnp.einsum('bhts,bhsj->bhtj', att, vi) + jnp.einsum('bhti,bhij->bhtj', qi * jnp.exp(ai), S)
        a_last = ai[:, :, -1, :]
        k_dec = ki * jnp.exp(a_last[:, :, None, :] - ai)
        S = S * jnp.exp(a_last)[..., None] + jnp.einsum('bhsi,bhsj->bhij', k_dec, vi)
        return S, o

    S0 = jnp.zeros((B, H, dk, dv), jnp.float32)
    _, o = lax.scan(step, S0, (qc, kc, A, vc))
    return o.transpose(1, 0, 3, 2, 4).reshape(B, L, H, dv)


def _hgrn2_bidirectional(f_fwd, f_bwd, q_pre, i_pre, g_pre, lb, gnorm):
    B, L, _ = q_pre.shape
    f32 = jnp.float32
    q = jax.nn.silu(_heads(q_pre, HG_HEADS).astype(f32))
    v = _heads(i_pre, HG_HEADS).astype(f32)

    def gates(f_pre, lbd):
        x = _heads(f_pre, HG_HEADS).astype(f32)
        lbd = lbd.reshape(HG_HEADS, HG_DK)
        f = lbd + (1.0 - lbd) * jax.nn.sigmoid(x)
        kk = (1.0 - lbd) * jax.nn.sigmoid(-x)
        return kk, jnp.log(f)

    k_f, lf_f = gates(f_fwd, lb[0])
    k_b, lf_b = gates(f_bwd, lb[1])
    flip = lambda t: jnp.flip(t, axis=1)
    o = _hgrn2_scan(q, k_f, lf_f, v) + flip(_hgrn2_scan(flip(q), flip(k_b), flip(lf_b), flip(v)))
    o = o * lax.rsqrt(jnp.mean(o * o, axis=-1, keepdims=True) + EPS)
    return o.reshape(B, L, BRANCH_W) * gnorm.astype(f32) * jax.nn.silu(g_pre.astype(f32))


def _spatial_gating(uv, ln_g, ln_b, w_s, b_s):
    B, L, _ = uv.shape
    z = jax.nn.gelu(uv.astype(jnp.float32))
    u, v = jnp.split(z, 2, axis=-1)
    mu = jnp.mean(v, axis=-1, keepdims=True)
    var = jnp.mean(jnp.square(v - mu), axis=-1, keepdims=True)
    v = (v - mu) * lax.rsqrt(var + EPS) * ln_g.astype(jnp.float32) + ln_b.astype(jnp.float32)
    v = v.reshape(B, L // SG_CHUNK, SG_CHUNK, SG_GROUPS, BRANCH_W // SG_GROUPS)
    mixed = jnp.einsum('gts,bnsgc->bntgc', w_s.astype(jnp.float32), v) + b_s.astype(jnp.float32).T[:, :, None]
    return u * mixed.reshape(B, L, BRANCH_W)


def _dilated_group(q, k, v, half, dil, slopes):
    B, L, H, hd = q.shape
    n = L // dil
    blk = half // dil
    nb = -(-n // blk)
    n_pad = nb * blk

    def to_classes(t):
        return t.reshape(B, n, dil, H, hd).transpose(0, 2, 3, 1, 4)

    pad_q = ((0, 0), (0, 0), (0, 0), (0, n_pad - n), (0, 0))
    pad_k = ((0, 0), (0, 0), (0, 0), (blk, n_pad - n + blk), (0, 0))
    qc = jnp.pad(to_classes(q), pad_q).reshape(B, dil, H, nb, blk, hd)

    def key_windows(t):
        tb = jnp.pad(to_classes(t), pad_k).reshape(B, dil, H, nb + 2, blk, hd)
        return jnp.concatenate([tb[:, :, :, :-2], tb[:, :, :, 1:-1], tb[:, :, :, 2:]], axis=4)

    kw, vw = key_windows(k), key_windows(v)
    qi = np.arange(n_pad).reshape(nb, blk)
    ki = (np.arange(nb)[:, None] - 1) * blk + np.arange(3 * blk)[None, :]
    step = ki[:, None, :] - qi[:, :, None]
    valid = (np.abs(step) <= blk) & (ki[:, None, :] >= 0) & (ki[:, None, :] < n)
    dist = (np.abs(step) * dil).astype(np.float32)
    bias = jnp.where(valid[None], -slopes[:, None, None, None] * dist[None], NEG)
    s = jnp.einsum('bchnqd,bchnkd->bchnqk', qc, kw, preferred_element_type=jnp.float32) * ATTN_SCALE + bias[None, None]
    m = jnp.max(s, axis=-1)
    e = jnp.exp(s - m[..., None])
    den = jnp.sum(e, axis=-1)
    o = jnp.einsum('bchnqk,bchnkd->bchnqd', e, vw.astype(jnp.float32)) / den[..., None]

    def from_classes(t):
        t = t.reshape(B, dil, H, n_pad, *t.shape[5:])[:, :, :, :n]
        t = jnp.moveaxis(t, 3, 1)
        return t.reshape(B, L, H, *t.shape[4:])

    return from_classes(o), from_classes(m), from_classes(den)


def _dilated_attention(q, k, v):
    slopes = jnp.asarray(_alibi_slopes(DIL_HEADS))
    outs, maxes, dens = [], [], []
    for window, dil in DIL_CONFIGS:
        o, m, d = _dilated_group(q, k, v, window // 2, dil, slopes)
        outs.append(o); maxes.append(m); dens.append(d)
    ms = jnp.stack(maxes)
    wts = jnp.stack(dens) * jnp.exp(ms - jnp.max(ms, axis=0))
    wts = wts / jnp.sum(wts, axis=0)
    return jnp.einsum('gblh,gblhd->blhd', wts, jnp.stack(outs))


def _token_mixer(h, w_in, w_gate, b_gate, w_branch, w_o, na_rpb, lb, hg_gnorm, sg_ln_g, sg_ln_b, sg_w, sg_b):
    B, L, _ = h.shape
    proj = h @ w_in
    cuts = [int(i) for i in np.cumsum(IN_SIZES)[:-1]]
    na_qkv, hg_ff, hg_fb, hg_q, hg_i, hg_g, sg_uv, dl_qkv = jnp.split(proj, cuts, axis=-1)
    nq, nk, nv = jnp.split(na_qkv, 3, axis=-1)
    y_na = _neighbourhood_attention(_heads(nq, NA_HEADS), _heads(nk, NA_HEADS), _heads(nv, NA_HEADS), na_rpb)
    y_hg = _hgrn2_bidirectional(hg_ff, hg_fb, hg_q, hg_i, hg_g, lb, hg_gnorm)
    y_sg = _spatial_gating(sg_uv, sg_ln_g, sg_ln_b, sg_w, sg_b)
    dq, dk, dv = jnp.split(dl_qkv, 3, axis=-1)
    y_dl = _dilated_attention(_heads(dq, DIL_HEADS), _heads(dk, DIL_HEADS), _heads(dv, DIL_HEADS))
    branches = (y_na.reshape(B, L, BRANCH_W), y_hg, y_sg, y_dl.reshape(B, L, BRANCH_W))
    merged = jnp.zeros_like(h)
    for bi in range(N_BRANCH):
        gate = jax.nn.sigmoid(h @ w_gate[bi] + b_gate[bi])
        merged = merged + gate * (branches[bi].astype(h.dtype) @ w_branch[bi])
    return merged @ w_o


def _swiglu(h, wg, wu, wd):
    return (jax.nn.silu(h @ wg) * (h @ wu)) @ wd


def _trunk(x, c, w_ada, b_ada, g_norm_mix, g_norm_ffn, w_in, w_gate, b_gate, w_branch, w_o,
           na_rpb, hg_lb, hg_gnorm, sg_ln_g, sg_ln_b, sg_w, sg_b, w_ffn_gate, w_ffn_up, w_ffn_down, g_final):
    lb_soft = jax.nn.softmax(hg_lb.astype(jnp.float32), axis=1)
    lower_bounds = jnp.cumsum(lb_soft, axis=1) - lb_soft[:, :1]
    cs = jax.nn.silu(c)
    for l in range(DEPTH):
        mod = cs @ w_ada[l] + b_ada[l]
        sh1, sc1, g1, sh2, sc2, g2 = [m[:, None, :] for m in jnp.split(mod, 6, axis=-1)]
        h = _rms_norm(x, g_norm_mix[l]) * (1 + sc1) + sh1
        y = _token_mixer(h, w_in[l], w_gate[l], b_gate[l], w_branch[l], w_o[l], na_rpb[l], lower_bounds[:, l],
                         hg_gnorm[l], sg_ln_g[l], sg_ln_b[l], sg_w[l], sg_b[l])
        x = x + (g1 * y).astype(x.dtype)
        h = _rms_norm(x, g_norm_ffn[l]) * (1 + sc2) + sh2
        x = x + (g2 * _swiglu(h, w_ffn_gate[l], w_ffn_up[l], w_ffn_down[l])).astype(x.dtype)
    return _rms_norm(x, g_final)


def setup_inputs(seed: int = 0) -> dict:
    key = jax.random.key(seed)
    ks = jax.random.split(key, 32)
    nrm = lambda i, shape, s: jax.random.normal(ks[i], shape, jnp.float32) * s
    D = D_MODEL
    return {
        "x_prompt": nrm(0, (BATCH, SEQ, D), 1.0),
        "x_sample": nrm(1, (DEC_BATCH, DEC_SEQ, D), 1.0),
        "c_prompt": nrm(2, (BATCH, D), 1.0),
        "c_sample": nrm(3, (DEC_BATCH, D), 1.0),
        "w_ada": nrm(4, (DEPTH, D, 6 * D), 0.5 * D ** -0.5),
        "b_ada": nrm(5, (DEPTH, 6 * D), 0.01),
        "g_norm_mix": 1.0 + nrm(6, (DEPTH, D), 0.1),
        "g_norm_ffn": 1.0 + nrm(7, (DEPTH, D), 0.1),
        "w_in": nrm(8, (DEPTH, D, IN_WIDTH), D ** -0.5),
        "w_gate": nrm(9, (DEPTH, N_BRANCH, D, D), D ** -0.5),
        "b_gate": nrm(10, (DEPTH, N_BRANCH, D), 0.01),
        "w_branch": nrm(11, (DEPTH, N_BRANCH, BRANCH_W, D), BRANCH_W ** -0.5),
        "w_o": nrm(12, (DEPTH, D, D), D ** -0.5),
        "na_rpb": nrm(13, (DEPTH, NA_HEADS, 2 * NA_KH - 1, 2 * NA_KW - 1), 0.2),
        "hg_lb": nrm(14, (2, DEPTH, HG_HEADS * HG_DK), 1.0),
        "hg_gnorm": 1.0 + nrm(15, (DEPTH, BRANCH_W), 0.1),
        "sg_ln_g": 1.0 + nrm(16, (DEPTH, BRANCH_W), 0.1),
        "sg_ln_b": nrm(17, (DEPTH, BRANCH_W), 0.01),
        "sg_w": nrm(18, (DEPTH, SG_GROUPS, SG_CHUNK, SG_CHUNK), SG_CHUNK ** -0.5),
        "sg_b": 1.0 + nrm(19, (DEPTH, SG_GROUPS, SG_CHUNK), 0.02),
        "w_ffn_gate": nrm(20, (DEPTH, D, D_FF), D ** -0.5),
        "w_ffn_up": nrm(21, (DEPTH, D, D_FF), D ** -0.5),
        "w_ffn_down": nrm(22, (DEPTH, D_FF, D), D_FF ** -0.5),
        "g_final": 1.0 + nrm(23, (D,), 0.1),
    }


def reference(x_prompt, x_sample, c_prompt, c_sample, w_ada, b_ada, g_norm_mix, g_norm_ffn, w_in, w_gate, b_gate,
              w_branch, w_o, na_rpb, hg_lb, hg_gnorm, sg_ln_g, sg_ln_b, sg_w, sg_b, w_ffn_gate, w_ffn_up,
              w_ffn_down, g_final):
    params = (w_ada, b_ada, g_norm_mix, g_norm_ffn, w_in, w_gate, b_gate, w_branch, w_o, na_rpb, hg_lb, hg_gnorm,
              sg_ln_g, sg_ln_b, sg_w, sg_b, w_ffn_gate, w_ffn_up, w_ffn_down, g_final)
    y_prompt = _trunk(x_prompt, c_prompt, *params)
    y_sample = _trunk(x_sample, c_sample, *params)
    return (y_prompt, y_sample)
```

```cpp
#include <hip/hip_runtime.h>
#include <hip/hip_cooperative_groups.h>
#include <cstdio>
#include <cstdint>
namespace cg = cooperative_groups;

#define LAS __attribute__((address_space(3)))
typedef unsigned short bf16_t;
typedef short bf16x8 __attribute__((ext_vector_type(8)));
typedef float f32x4 __attribute__((ext_vector_type(4)));
typedef unsigned u32x4 __attribute__((ext_vector_type(4)));
typedef unsigned u32x2 __attribute__((ext_vector_type(2)));

constexpr int DM = 1024, TC = 16384, NCHUNK = 3, NIN = 3328, DFF = 2816, NLAYER = 4, NB = 20;
constexpr int P_NAQ = 0, P_NAK = 256, P_NAV = 512, P_FF = 768, P_FB = 1024, P_HQ = 1280, P_HI = 1536, P_HGATE = 1792, P_SU = 2048, P_SV = 2304, P_DQ = 2560, P_DK = 2816, P_DV = 3072;
constexpr float EPSV = 1e-6f;
constexpr int LDS_BYTES = 147456;
constexpr int NTHR = 512;

constexpr size_t OFF_CTL = 0;
constexpr size_t OFF_MOD = 4096;
constexpr size_t SZ_MOD = (size_t)NB * NLAYER * 6144 * 4;
constexpr size_t OFF_MODP = OFF_MOD + SZ_MOD;
constexpr size_t OFF_WIN = OFF_MODP + 8 * SZ_MOD;
constexpr size_t OFF_WG = OFF_WIN + (size_t)NLAYER * NIN * DM * 2;
constexpr size_t OFF_WB = OFF_WG + (size_t)NLAYER * 4 * DM * DM * 2;
constexpr size_t OFF_WO = OFF_WB + (size_t)NLAYER * DM * DM * 2;
constexpr size_t OFF_WGU = OFF_WO + (size_t)NLAYER * DM * DM * 2;
constexpr size_t OFF_WD = OFF_WGU + (size_t)NLAYER * 2 * DFF * DM * 2;
constexpr size_t OFF_SGW = OFF_WD + (size_t)NLAYER * DM * DFF * 2;
constexpr size_t OFF_H = OFF_SGW + (size_t)NLAYER * 4 * 128 * 128 * 2;
constexpr size_t OFF_P = OFF_H + (size_t)TC * DM * 2;
constexpr size_t OFF_BR = OFF_P + (size_t)TC * NIN * 2;
constexpr size_t OFF_MG = OFF_BR + (size_t)TC * DM * 2;
constexpr size_t OFF_HGST = OFF_MG + (size_t)TC * DM * 2;
constexpr size_t OFF_HGD = OFF_HGST + (size_t)256 * 8 * 4096 * 4;
constexpr size_t WS_END = OFF_HGD + (size_t)256 * 8 * 64 * 4;
constexpr size_t MERGE_SCR_PER_BLOCK = 131072 + 262144;

struct Params {
    const float* in[24];
    float* out;
    unsigned char* ws;
};

__device__ __forceinline__ unsigned pk2(float lo, float hi) { unsigned r; asm("v_cvt_pk_bf16_f32 %0, %1, %2" : "=v"(r) : "v"(lo), "v"(hi)); return r; }
__device__ __forceinline__ bf16_t f2bf(float f) { return (bf16_t)(pk2(f, 0.f) & 0xffffu); }
__device__ __forceinline__ float bf2f(unsigned b) { return __uint_as_float(b << 16); }
__device__ __forceinline__ float bflo(unsigned w) { return __uint_as_float(w << 16); }
__device__ __forceinline__ float bfhi(unsigned w) { return __uint_as_float(w & 0xffff0000u); }
__device__ __forceinline__ float sigmoidf_(float x) { return 1.f / (1.f + __expf(-x)); }
__device__ __forceinline__ float siluf_(float x) { return x * sigmoidf_(x); }
__device__ __forceinline__ float gelu_tanh(float x) { return x * sigmoidf_(1.5957691216f * (x + 0.044715f * x * x * x)); }
__device__ __forceinline__ float wave_sum(float v) {
#pragma unroll
    for (int o = 1; o < 64; o <<= 1) v += __shfl_xor(v, o);
    return v;
}
__device__ __forceinline__ int opaque_tid() { int t = threadIdx.x; asm volatile("" : "+v"(t)); return t; }
#define MFMA16(a, b, c) __builtin_amdgcn_mfma_f32_16x16x32_bf16((a), (b), (c), 0, 0, 0)

__device__ __forceinline__ int chunk_L(int ck) { return ck < 2 ? 2048 : 4096; }
__device__ __forceinline__ int chunk_bbase(int ck) { return ck * 8; }

namespace pg8 {
constexpr int BM = 256, BK = 64, HALF = 128, HTB = HALF * BK * 2, STAGE_BYTES = 8 * HTB, NXCD = 8, WGM = 8;
__host__ __device__ __forceinline__ int lds_byte(int r, int c) { const int st = (r >> 4) * 2 + (c >> 5), rr = r & 15, cc = c & 31, ob = rr * 64 + cc * 2; return st * 1024 + (ob ^ (((ob >> 9) & 1) << 5)); }
__host__ __device__ __forceinline__ void stage_rc(int b, int& R, int& C) { const int st = b / 1024, sb = b % 1024, swz = sb ^ (((sb >> 9) & 1) << 5); R = (st >> 1) * 16 + swz / 64; C = (st & 1) * 32 + (swz % 64) / 2; }
__host__ __device__ __forceinline__ int perm32(int rho) { const int n = rho >> 4, i = rho & 15; return 8 * (i >> 2) + 4 * n + (i & 3); }

struct Unit { const char* a; const char* b; int nt; int pm, pn, kind; };

struct TileOrder {
    int nM, nN, nwg, G, c;
    __device__ __forceinline__ void init(int nM_, int nN_, int G_, int c_) { nM = nM_; nN = nN_; nwg = nM * nN; G = G_; c = c_; }
    __device__ __forceinline__ bool tile(int i, int& pm, int& pn) const {
        const long L = (long)i * G + c; if (L >= nwg) return false;
        int wgid = (int)L; { const int q = nwg / NXCD, r = nwg % NXCD, xcd = wgid % NXCD, off = wgid / NXCD; wgid = (xcd < r ? xcd * (q + 1) : r * (q + 1) + (xcd - r) * q) + off; }
        const int nig = WGM * nN, gid = wgid / nig, fm = gid * WGM, gsz = (nM - fm) < WGM ? (nM - fm) : WGM;
        pm = fm + ((wgid % nig) % gsz); pn = (wgid % nig) / gsz; return true;
    }
};

template <class Epi, class Sched>
__device__ __forceinline__ void gemm_phase(LAS unsigned char* lds, const int lda, const int ldb, const Sched& S, const Epi& E) {
    const int tid = opaque_tid(), wid = __builtin_amdgcn_readfirstlane(tid >> 6), lane = tid & 63, wr = wid >> 2, wc = wid & 3, fr = lane & 15, fq = lane >> 4;
    unsigned voffA[2], voffB[2];
#pragma unroll
    for (int i = 0; i < 2; ++i) { int R, C; stage_rc(tid * 16 + i * 8192, R, C); const int Rb = Epi::PERM ? ((R & ~31) + perm32(R & 31)) : R;
        voffA[i] = (unsigned)(R * lda + C) * 2u; voffB[i] = (unsigned)(Rb * ldb + C) * 2u; }
    const size_t kstep = (size_t)(BK * 2);
    const size_t hstepA = (size_t)HALF * lda * 2, hstepB = (size_t)HALF * ldb * 2;
    const unsigned ldsw = (unsigned)wid * 1024u;
    const int aoff = lds_byte(wr * 64 + fr, fq * 8), boff = lds_byte(wc * 32 + fr, fq * 8);
#define PG8_SA(b, h) (((b) * 2 + (h)) * HTB)
#define PG8_SB(b, h) ((4 + (b) * 2 + (h)) * HTB)
#define PG8_STAGE(bufoff, gbase, voff) do { _Pragma("unroll") for (int _i = 0; _i < 2; ++_i) \
        __builtin_amdgcn_global_load_lds((const unsigned*)((const char*)(gbase) + (voff)[_i]), (LAS unsigned*)(lds + (bufoff) + ldsw + _i * 8192), 16, 0, 0); } while (0)
#define PG8_LDA(dst, b, h) do { _Pragma("unroll") for (int m = 0; m < 4; ++m) _Pragma("unroll") for (int k = 0; k < 2; ++k) dst[m][k] = *(const LAS bf16x8*)(lds + PG8_SA(b, h) + aoff + m * 2048 + k * 1024); } while (0)
#define PG8_LDB(dst, b, h) do { _Pragma("unroll") for (int n = 0; n < 2; ++n) _Pragma("unroll") for (int k = 0; k < 2; ++k) dst[n][k] = *(const LAS bf16x8*)(lds + PG8_SB(b, h) + boff + n * 2048 + k * 1024); } while (0)
#define PG8_MMA(ai, bj, At, Bt) do { __builtin_amdgcn_s_setprio(1); _Pragma("unroll") for (int m = 0; m < 4; ++m) _Pragma("unroll") for (int n = 0; n < 2; ++n) _Pragma("unroll") for (int k = 0; k < 2; ++k) \
        acc[ai][bj][m][n] = __builtin_amdgcn_mfma_f32_16x16x32_bf16(Bt[n][k], At[m][k], acc[ai][bj][m][n], 0, 0, 0); __builtin_amdgcn_s_setprio(0); } while (0)
#define PG8_WAIT_V(n) asm volatile("s_waitcnt vmcnt(" #n ")" ::: "memory")
#define PG8_WAIT_L(n) asm volatile("s_waitcnt lgkmcnt(" #n ")" ::: "memory")
#define PG8_BAR __builtin_amdgcn_s_barrier()
#define PG8_SCHED __builtin_amdgcn_sched_barrier(0)
    Unit cur, nxt; int ui = 0;
    if (!S.next(0, cur)) return;
    f32x4 acc[2][2][4][2];
#pragma unroll
    for (int a = 0; a < 2; ++a)
#pragma unroll
        for (int b = 0; b < 2; ++b)
#pragma unroll
            for (int m = 0; m < 4; ++m)
#pragma unroll
                for (int n = 0; n < 2; ++n) acc[a][b][m][n] = (f32x4){0.f, 0.f, 0.f, 0.f};
    bf16x8 At[4][2], B0[2][2], B1[2][2];
    const char* cA = cur.a; const char* cB = cur.b;
    PG8_STAGE(PG8_SB(0, 0), cB, voffB); PG8_STAGE(PG8_SA(0, 0), cA, voffA); PG8_STAGE(PG8_SB(0, 1), cB + hstepB, voffB); PG8_STAGE(PG8_SA(0, 1), cA + hstepA, voffA);
    if (wr == 1) PG8_BAR;
    PG8_WAIT_V(4); PG8_BAR;
    PG8_STAGE(PG8_SB(1, 0), cB + kstep, voffB); PG8_STAGE(PG8_SA(1, 0), cA + kstep, voffA); PG8_STAGE(PG8_SB(1, 1), cB + hstepB + kstep, voffB);
    PG8_WAIT_V(6); PG8_BAR;
    for (;;) {
        const bool has_next = S.next(ui + 1, nxt);
        const char* nA = has_next ? nxt.a : cA; const char* nB = has_next ? nxt.b : cB;
        const int nt = cur.nt;
        for (int t = 0; t < nt; t += 2) {
            const bool last = (t == nt - 2);
            const char* a1 = cA + (size_t)(t + 1) * kstep;
            const char* a2 = last ? nA : cA + (size_t)(t + 2) * kstep; const char* b2 = last ? nB : cB + (size_t)(t + 2) * kstep;
            const char* a3 = a2 + kstep; const char* b3 = b2 + kstep;
            PG8_LDB(B0, 0, 0); PG8_SCHED; PG8_LDA(At, 0, 0); PG8_STAGE(PG8_SA(1, 1), a1 + hstepA, voffA);
            PG8_WAIT_L(8); PG8_BAR; PG8_WAIT_L(0); PG8_MMA(0, 0, At, B0); PG8_BAR; PG8_SCHED;
            PG8_LDB(B1, 0, 1); PG8_STAGE(PG8_SB(0, 0), b2, voffB);
            PG8_BAR; PG8_WAIT_L(0); PG8_MMA(0, 1, At, B1); PG8_BAR;
            PG8_LDA(At, 0, 1); PG8_STAGE(PG8_SA(0, 0), a2, voffA);
            PG8_BAR; PG8_WAIT_L(0); PG8_MMA(1, 0, At, B0); PG8_BAR; PG8_SCHED;
            PG8_STAGE(PG8_SB(0, 1), b2 + hstepB, voffB);
            PG8_WAIT_V(6); PG8_BAR; PG8_MMA(1, 1, At, B1); PG8_BAR;
            PG8_LDB(B0, 1, 0); PG8_SCHED; PG8_LDA(At, 1, 0); PG8_STAGE(PG8_SA(0, 1), a2 + hstepA, voffA);
            PG8_WAIT_L(8); PG8_BAR; PG8_WAIT_L(0); PG8_MMA(0, 0, At, B0); PG8_BAR; PG8_SCHED;
            PG8_LDB(B1, 1, 1); PG8_STAGE(PG8_SB(1, 0), b3, voffB);
            PG8_BAR; PG8_WAIT_L(0); PG8_MMA(0, 1, At, B1); PG8_BAR;
            PG8_LDA(At, 1, 1); PG8_STAGE(PG8_SA(1, 0), a3, voffA);
            PG8_BAR; PG8_WAIT_L(0); PG8_MMA(1, 0, At, B0); PG8_BAR; PG8_SCHED;
            PG8_STAGE(PG8_SB(1, 1), b3 + hstepB, voffB);
            PG8_WAIT_V(6); PG8_BAR; PG8_MMA(1, 1, At, B1); PG8_BAR;
        }
        E(acc, cur, wr, wc, fr, fq);
        if (!has_next) break;
#pragma unroll
        for (int a = 0; a < 2; ++a)
#pragma unroll
            for (int b = 0; b < 2; ++b)
#pragma unroll
                for (int m = 0; m < 4; ++m)
#pragma unroll
                    for (int n = 0; n < 2; ++n) acc[a][b][m][n] = (f32x4){0.f, 0.f, 0.f, 0.f};
        cur = nxt; cA = nA; cB = nB; ++ui;
    }
    PG8_WAIT_V(0);
    if (wr == 0) PG8_BAR;
    PG8_BAR;
#undef PG8_SA
#undef PG8_SB
#undef PG8_STAGE
#undef PG8_LDA
#undef PG8_LDB
#undef PG8_MMA
#undef PG8_WAIT_V
#undef PG8_WAIT_L
#undef PG8_BAR
#undef PG8_SCHED
}
}
using pg8::Unit;

struct SchedStd {
    pg8::TileOrder to; const char* A; const char* B; size_t atile, btile; int nt;
    __device__ __forceinline__ bool next(int i, Unit& u) const {
        int pm, pn; if (!to.tile(i, pm, pn)) return false;
        u.pm = pm; u.pn = pn; u.kind = 0; u.nt = nt; u.a = A + (size_t)pm * atile; u.b = B + (size_t)pn * btile; return true;
    }
};
struct SchedMerge {
    pg8::TileOrder to; const char* H; const char* BR; const char* WG; const char* WB;
    __device__ __forceinline__ bool next(int i, Unit& u) const {
        int pm, pn; if (!to.tile(i >> 3, pm, pn)) return false;
        const int sub = i & 7, bi = sub >> 1;
        u.pm = pm; u.pn = pn; u.kind = sub;
        if (sub & 1) { u.nt = 16; u.a = H + (size_t)pm * (256 * DM * 2); u.b = WG + (size_t)bi * (DM * DM * 2) + (size_t)pn * (256 * DM * 2); }
        else { u.nt = 4; u.a = BR + (size_t)pm * (256 * DM * 2) + bi * 512; u.b = WB + (size_t)pn * (256 * DM * 2) + bi * 512; }
        return true;
    }
};

struct EpiProj {
    static constexpr bool PERM = true;
    bf16_t* O; int ldc;
    __device__ __forceinline__ void operator()(const f32x4 (&acc)[2][2][4][2], const Unit& u, int wr, int wc, int fr, int fq) const {
        const int row0 = u.pm * 256 + wr * 64 + fr, col0 = u.pn * 256 + wc * 32 + 8 * fq;
#pragma unroll
        for (int ai = 0; ai < 2; ++ai)
#pragma unroll
            for (int m = 0; m < 4; ++m) { bf16_t* rowp = O + (size_t)(row0 + ai * 128 + m * 16) * ldc + col0;
#pragma unroll
                for (int bj = 0; bj < 2; ++bj) { const f32x4 v0 = acc[ai][bj][m][0], v1 = acc[ai][bj][m][1];
                    u32x4 o; o.x = pk2(v0[0], v0[1]); o.y = pk2(v0[2], v0[3]); o.z = pk2(v1[0], v1[1]); o.w = pk2(v1[2], v1[3]);
                    *(u32x4*)(rowp + bj * 128) = o; } }
    }
};
struct EpiAct {
    static constexpr bool PERM = true;
    bf16_t* O;
    __device__ __forceinline__ void operator()(const f32x4 (&acc)[2][2][4][2], const Unit& u, int wr, int wc, int fr, int fq) const {
        const int row0 = u.pm * 256 + wr * 64 + fr, col0 = u.pn * 128 + wc * 32 + 8 * fq;
#pragma unroll
        for (int ai = 0; ai < 2; ++ai)
#pragma unroll
            for (int m = 0; m < 4; ++m) { bf16_t* rowp = O + (size_t)(row0 + ai * 128 + m * 16) * DFF + col0;
                float r[8];
#pragma unroll
                for (int n = 0; n < 2; ++n)
#pragma unroll
                    for (int j = 0; j < 4; ++j) { const float g = acc[ai][0][m][n][j], up = acc[ai][1][m][n][j]; r[n * 4 + j] = siluf_(g) * up; }
                u32x4 o; o.x = pk2(r[0], r[1]); o.y = pk2(r[2], r[3]); o.z = pk2(r[4], r[5]); o.w = pk2(r[6], r[7]);
                *(u32x4*)rowp = o; }
    }
};
struct EpiRes {
    static constexpr bool PERM = false;
    float* X; const float* gm; int L; int bbase;
    __device__ __forceinline__ void operator()(const f32x4 (&acc)[2][2][4][2], const Unit& u, int wr, int wc, int fr, int fq) const {
        const int row0 = u.pm * 256 + wr * 64 + fr, col0 = u.pn * 256 + wc * 32 + 4 * fq;
        const int b = bbase + (u.pm * 256) / L;
        const float* g = gm + (size_t)b * (NLAYER * 6144) + col0;
        f32x4 gv[2][2];
#pragma unroll
        for (int bj = 0; bj < 2; ++bj)
#pragma unroll
            for (int n = 0; n < 2; ++n) gv[bj][n] = *(const f32x4*)(g + bj * 128 + n * 16);
#pragma unroll
        for (int ai = 0; ai < 2; ++ai)
#pragma unroll
            for (int m = 0; m < 4; ++m) { float* rowp = X + (size_t)(row0 + ai * 128 + m * 16) * DM + col0;
#pragma unroll
                for (int bj = 0; bj < 2; ++bj)
#pragma unroll
                    for (int n = 0; n < 2; ++n) { f32x4* p = (f32x4*)(rowp + bj * 128 + n * 16); const f32x4 x = *p; *p = x + gv[bj][n] * acc[ai][bj][m][n]; } }
    }
};
struct EpiMerge {
    static constexpr bool PERM = true;
    bf16_t* MG; const float* bgate;
    unsigned char* scr;
    __device__ __forceinline__ void operator()(const f32x4 (&acc)[2][2][4][2], const Unit& u, int wr, int wc, int fr, int fq) const {
        const int tid = opaque_tid(), bi = u.kind >> 1;
        unsigned char* pbp = scr + tid * 16;
        unsigned char* pmp = scr + 131072 + tid * 16;
        if ((u.kind & 1) == 0) {
#pragma unroll
            for (int bj = 0; bj < 2; ++bj)
#pragma unroll
                for (int ai = 0; ai < 2; ++ai)
#pragma unroll
                    for (int m = 0; m < 4; ++m) { const f32x4 v0 = acc[ai][bj][m][0], v1 = acc[ai][bj][m][1];
                        u32x4 o; o.x = pk2(v0[0], v0[1]); o.y = pk2(v0[2], v0[3]); o.z = pk2(v1[0], v1[1]); o.w = pk2(v1[2], v1[3]);
                        *(u32x4*)pbp = o; pbp += 8192; asm volatile("" : "+v"(pbp)); }
        } else {
            const int row0 = u.pm * 256 + wr * 64 + fr, col0 = u.pn * 256 + wc * 32 + 8 * fq;
            const float* bg = bgate + bi * DM + col0;
            bf16_t* mgp = MG + (size_t)row0 * DM + col0;
#pragma unroll
            for (int bj = 0; bj < 2; ++bj) {
                const f32x4 b0 = *(const f32x4*)(bg + bj * 128), b1 = *(const f32x4*)(bg + bj * 128 + 4);
#pragma unroll
                for (int ai = 0; ai < 2; ++ai)
#pragma unroll
                    for (int m = 0; m < 4; ++m) {
                        const u32x4 pv = *(const u32x4*)pbp; pbp += 8192; asm volatile("" : "+v"(pbp));
                        const f32x4 a0 = acc[ai][bj][m][0] + b0, a1 = acc[ai][bj][m][1] + b1;
                        f32x4 r0, r1;
                        r0[0] = sigmoidf_(a0[0]) * bflo(pv.x); r0[1] = sigmoidf_(a0[1]) * bfhi(pv.x); r0[2] = sigmoidf_(a0[2]) * bflo(pv.y); r0[3] = sigmoidf_(a0[3]) * bfhi(pv.y);
                        r1[0] = sigmoidf_(a1[0]) * bflo(pv.z); r1[1] = sigmoidf_(a1[1]) * bfhi(pv.z); r1[2] = sigmoidf_(a1[2]) * bflo(pv.w); r1[3] = sigmoidf_(a1[3]) * bfhi(pv.w);
                        if (bi > 0) { r0 += *(const f32x4*)pmp; r1 += *(const f32x4*)(pmp + 8192); }
                        if (bi < 3) { *(f32x4*)pmp = r0; *(f32x4*)(pmp + 8192) = r1; }
                        else { u32x4 o; o.x = pk2(r0[0], r0[1]); o.y = pk2(r0[2], r0[3]); o.z = pk2(r1[0], r1[1]); o.w = pk2(r1[2], r1[3]);
                            bf16_t* q = mgp + (size_t)(ai * 128 + m * 16) * DM + bj * 128; asm volatile("" : "+v"(q));
                            *(u32x4*)q = o; }
                        pmp += 16384; asm volatile("" : "+v"(pmp)); }
            }
        }
    }
};

__device__ __forceinline__ void transpose_item(const float* W, int N, int k0, int n0, bf16_t* dst  , int ldwt, LAS float* scr, int lane) {
#pragma unroll 8
    for (int i = 0; i < 32; ++i) { const int kk = 2 * i + (lane >> 5); scr[kk * 33 + (lane & 31)] = W[(size_t)(k0 + kk) * N + n0 + (lane & 31)]; }
    __builtin_amdgcn_wave_barrier();
    const int c = lane & 7;
#pragma unroll
    for (int j = 0; j < 4; ++j) { const int n = (lane >> 3) + 8 * j; const LAS float* s = scr + (8 * c) * 33 + n;
        u32x4 o; o.x = pk2(s[0 * 33], s[1 * 33]); o.y = pk2(s[2 * 33], s[3 * 33]); o.z = pk2(s[4 * 33], s[5 * 33]); o.w = pk2(s[6 * 33], s[7 * 33]);
        *(u32x4*)(dst + (size_t)n * ldwt + 8 * c) = o; }
    __builtin_amdgcn_wave_barrier();
}

__device__ __forceinline__ void phase_prologue(const Params& p, LAS unsigned char* lds) {
    const int tid = opaque_tid(), lane = tid & 63, wave = tid >> 6;
    unsigned char* ws = p.ws;
    {
        LAS float* scr = (LAS float*)(lds + wave * 8704);
        const int gw = blockIdx.x * 8 + wave, NGW = gridDim.x * 8;
        constexpr int I_IN = 16 * (NIN / 32), I_G = 4 * 16 * 32, I_B = 4 * 4 * 32, I_O = 16 * 32, I_F = 16 * (DFF / 32), I_D = (DFF / 64) * 32;
        constexpr int PER_LAYER = I_IN + I_G + I_B + I_O + 2 * I_F + I_D;
        for (int it = gw; it < NLAYER * PER_LAYER; it += NGW) {
            const int l = it / PER_LAYER; int r = it % PER_LAYER;
            if (r < I_IN) { const int nb = r % (NIN / 32), kb = r / (NIN / 32);
                transpose_item(p.in[8] + (size_t)l * DM * NIN, NIN, 64 * kb, 32 * nb, (bf16_t*)(ws + OFF_WIN) + ((size_t)l * NIN + 32 * nb) * DM + 64 * kb, DM, scr, lane); continue; }
            r -= I_IN;
            if (r < I_G) { const int bi = r / 512, rr = r % 512, nb = rr % 32, kb = rr / 32;
                transpose_item(p.in[9] + ((size_t)l * 4 + bi) * DM * DM, DM, 64 * kb, 32 * nb, (bf16_t*)(ws + OFF_WG) + (((size_t)l * 4 + bi) * DM + 32 * nb) * DM + 64 * kb, DM, scr, lane); continue; }
            r -= I_G;
            if (r < I_B) { const int bi = r / 128, rr = r % 128, nb = rr % 32, kb = rr / 32;
                transpose_item(p.in[11] + ((size_t)l * 4 + bi) * 256 * DM, DM, 64 * kb, 32 * nb, (bf16_t*)(ws + OFF_WB) + ((size_t)l * DM + 32 * nb) * DM + bi * 256 + 64 * kb, DM, scr, lane); continue; }
            r -= I_B;
            if (r < I_O) { const int nb = r % 32, kb = r / 32;
                transpose_item(p.in[12] + (size_t)l * DM * DM, DM, 64 * kb, 32 * nb, (bf16_t*)(ws + OFF_WO) + ((size_t)l * DM + 32 * nb) * DM + 64 * kb, DM, scr, lane); continue; }
            r -= I_O;
            if (r < 2 * I_F) { const int which = r / I_F, rr = r % I_F, nb = rr % (DFF / 32), kb = rr / (DFF / 32);
                const int n0 = 32 * nb, row = (n0 >> 7) * 256 + (n0 & 127) + which * 128;
                transpose_item(p.in[which ? 21 : 20] + (size_t)l * DM * DFF, DFF, 64 * kb, n0, (bf16_t*)(ws + OFF_WGU) + ((size_t)l * 2 * DFF + row) * DM + 64 * kb, DM, scr, lane); continue; }
            r -= 2 * I_F;
            { const int nb = r % 32, kb = r / 32;
                transpose_item(p.in[22] + (size_t)l * DFF * DM, DM, 64 * kb, 32 * nb, (bf16_t*)(ws + OFF_WD) + ((size_t)l * DM + 32 * nb) * DFF + 64 * kb, DFF, scr, lane); }
        }
    }
    {
        const float* src = p.in[18]; bf16_t* dst = (bf16_t*)(ws + OFF_SGW);
        for (int i = blockIdx.x * NTHR + tid; i < NLAYER * 4 * 128 * 128 / 4; i += gridDim.x * NTHR) {
            const f32x4 v = *(const f32x4*)(src + 4 * (size_t)i); u32x2 o; o.x = pk2(v[0], v[1]); o.y = pk2(v[2], v[3]); *(u32x2*)(dst + 4 * (size_t)i) = o; }
    }
    __syncthreads();
    {
        LAS float* cs = (LAS float*)lds;
        float* modp = (float*)(ws + OFF_MODP);
        for (int it = blockIdx.x; it < NLAYER * 12 * 8; it += gridDim.x) {
            const int ks = it & 7, nb = (it >> 3) % 12, l = it / 96;
            __syncthreads();
            for (int e = tid; e < 128 * NB; e += NTHR) { const int kk = e / NB, b = e % NB;
                const float c = b < 16 ? p.in[2][b * DM + 128 * ks + kk] : p.in[3][(b - 16) * DM + 128 * ks + kk];
                cs[kk * NB + b] = siluf_(c); }
            __syncthreads();
            const int n = nb * 512 + tid;
            const float* w = p.in[4] + ((size_t)l * DM + 128 * ks) * 6144 + n;
            float a[NB];
#pragma unroll
            for (int b = 0; b < NB; ++b) a[b] = 0.f;
#pragma unroll 4
            for (int kk = 0; kk < 128; ++kk) { const float wv = w[(size_t)kk * 6144];
#pragma unroll
                for (int b4 = 0; b4 < NB / 4; ++b4) { const f32x4 c4 = *(const LAS f32x4*)(cs + kk * NB + 4 * b4);
                    a[4 * b4 + 0] += c4[0] * wv; a[4 * b4 + 1] += c4[1] * wv; a[4 * b4 + 2] += c4[2] * wv; a[4 * b4 + 3] += c4[3] * wv; } }
#pragma unroll
            for (int b = 0; b < NB; ++b) modp[(((size_t)ks * NB + b) * NLAYER + l) * 6144 + n] = a[b];
        }
    }
}
__device__ __forceinline__ void phase_mod_reduce(const Params& p) {
    const float* modp = (const float*)(p.ws + OFF_MODP); float* mod = (float*)(p.ws + OFF_MOD);
    constexpr int NMOD = NB * NLAYER * 6144;
    for (int i = blockIdx.x * NTHR + opaque_tid(); i < NMOD; i += gridDim.x * NTHR) {
        const int n = i % 6144, l = (i / 6144) % NLAYER;
        float s = p.in[5][l * 6144 + n];
#pragma unroll
        for (int ks = 0; ks < 8; ++ks) s += modp[(size_t)ks * NMOD + i];
        mod[i] = s;
    }
}

__device__ __forceinline__ void phase_norm_mod(const float* xsrc, float* copy_to, bf16_t* H, const float* g, const float* mod_sh, const float* mod_sc, int L, int bbase) {
    const int tid = opaque_tid(), lane = tid & 63, gw = blockIdx.x * 8 + (tid >> 6), NGW = gridDim.x * 8;
    for (int row = gw; row < TC; row += NGW) {
        const int b = bbase + row / L;
        const f32x4* xr = (const f32x4*)(xsrc + (size_t)row * DM) + lane;
        f32x4 v[4]; float s = 0.f;
#pragma unroll
        for (int j = 0; j < 4; ++j) { v[j] = xr[64 * j]; s += (v[j][0] * v[j][0] + v[j][1] * v[j][1]) + (v[j][2] * v[j][2] + v[j][3] * v[j][3]); }
        const float rstd = rsqrtf(wave_sum(s) * (1.f / DM) + EPSV);
        if (copy_to) { f32x4* cr = (f32x4*)(copy_to + (size_t)row * DM) + lane;
#pragma unroll
            for (int j = 0; j < 4; ++j) cr[64 * j] = v[j]; }
        const f32x4* gr = (const f32x4*)g + lane;
        const f32x4* shr = (const f32x4*)(mod_sh + (size_t)b * (NLAYER * 6144)) + lane;
        const f32x4* scr = (const f32x4*)(mod_sc + (size_t)b * (NLAYER * 6144)) + lane;
        u32x2* o = (u32x2*)(H + (size_t)row * DM) + lane;
#pragma unroll
        for (int j = 0; j < 4; ++j) { const f32x4 gg = gr[64 * j], sh = shr[64 * j], sc = scr[64 * j];
            const f32x4 y = v[j] * rstd * gg * (sc + 1.f) + sh;
            u32x2 w; w.x = pk2(y[0], y[1]); w.y = pk2(y[2], y[3]); o[64 * j] = w; }
    }
}
__device__ __forceinline__ void phase_final_norm(float* X, const float* g) {
    const int tid = opaque_tid(), lane = tid & 63, gw = blockIdx.x * 8 + (tid >> 6), NGW = gridDim.x * 8;
    for (int row = gw; row < TC; row += NGW) {
        f32x4* xr = (f32x4*)(X + (size_t)row * DM) + lane;
        f32x4 v[4]; float s = 0.f;
#pragma unroll
        for (int j = 0; j < 4; ++j) { v[j] = xr[64 * j]; s += (v[j][0] * v[j][0] + v[j][1] * v[j][1]) + (v[j][2] * v[j][2] + v[j][3] * v[j][3]); }
        const float rstd = rsqrtf(wave_sum(s) * (1.f / DM) + EPSV);
        const f32x4* gr = (const f32x4*)g + lane;
#pragma unroll
        for (int j = 0; j < 4; ++j) xr[64 * j] = v[j] * rstd * gr[64 * j];
    }
}

struct AttnState { f32x4 o[4]; float m, l; };
constexpr int VT_LD = 40;
constexpr int VT_BYTES = 64 * VT_LD * 2;
template <class TokOfKey>
__device__ __forceinline__ void attn_stage_v(LAS bf16_t* vt, const bf16_t* P, int vcol, int lane, const TokOfKey& tok_of_key) {
#pragma unroll
    for (int i = 0; i < 4; ++i) { const int pc = lane + 64 * i, key = pc >> 3, ch = pc & 7;
        const u32x4 v = *(const u32x4*)(P + (size_t)tok_of_key(key) * NIN + vcol + 8 * ch);
        const int slot = 8 * ((key & 15) >> 2) + 4 * (key >> 4) + (key & 3);
        LAS bf16_t* d = vt + ch * VT_LD + slot;
        d[0 * 8 * VT_LD] = (bf16_t)(v.x & 0xffffu); d[1 * 8 * VT_LD] = (bf16_t)(v.x >> 16);
        d[2 * 8 * VT_LD] = (bf16_t)(v.y & 0xffffu); d[3 * 8 * VT_LD] = (bf16_t)(v.y >> 16);
        d[4 * 8 * VT_LD] = (bf16_t)(v.z & 0xffffu); d[5 * 8 * VT_LD] = (bf16_t)(v.z >> 16);
        d[6 * 8 * VT_LD] = (bf16_t)(v.w & 0xffffu); d[7 * 8 * VT_LD] = (bf16_t)(v.w >> 16); }
}
__device__ __forceinline__ void attn_update(AttnState& st, const float (&s)[2][4], const bool (&valid)[2][4], LAS bf16_t* vt, int fr, int fq) {
    float mx = fmaxf(fmaxf(fmaxf(s[0][0], s[0][1]), fmaxf(s[0][2], s[0][3])), fmaxf(fmaxf(s[1][0], s[1][1]), fmaxf(s[1][2], s[1][3])));
    mx = fmaxf(mx, __shfl_xor(mx, 16)); mx = fmaxf(mx, __shfl_xor(mx, 32));
    const float mn = fmaxf(st.m, mx), alpha = __expf(st.m - mn);
    float pv[2][4]; float ps = 0.f;
#pragma unroll
    for (int t = 0; t < 2; ++t)
#pragma unroll
        for (int r = 0; r < 4; ++r) { pv[t][r] = valid[t][r] ? __expf(s[t][r] - mn) : 0.f; ps += pv[t][r]; }
    st.m = mn; st.l = st.l * alpha + ps;
    union { bf16x8 v; unsigned u[4]; } pf;
    pf.u[0] = pk2(pv[0][0], pv[0][1]); pf.u[1] = pk2(pv[0][2], pv[0][3]); pf.u[2] = pk2(pv[1][0], pv[1][1]); pf.u[3] = pk2(pv[1][2], pv[1][3]);
    __builtin_amdgcn_wave_barrier();
#pragma unroll
    for (int dt = 0; dt < 4; ++dt) {
        const bf16x8 vf = *(const LAS bf16x8*)(vt + ((fr & 7) * 8 + 2 * dt + (fr >> 3)) * VT_LD + 8 * fq);
        st.o[dt] = st.o[dt] * alpha;
        st.o[dt] = MFMA16(vf, pf.v, st.o[dt]);
    }
    __builtin_amdgcn_wave_barrier();
}

__device__ __forceinline__ void na_item(int item, const bf16_t* P, bf16_t* BR, const float* rpb  , int L, LAS unsigned char* lds) {
    const int tid = opaque_tid(), lane = tid & 63, wave = tid >> 6, fr = lane & 15, fq = lane >> 4;
    const int rr = item >> 1, h = (item & 1) * 2 + (wave >> 2), n = wave & 3;
    const int rows = L >> 6, seq = rr / rows, r = rr % rows, seqbase = seq * L;
    const int r0 = min(max(r - 4, 0), rows - 8);
    LAS bf16_t* vt = (LAS bf16_t*)(lds + wave * VT_BYTES);
    const int qtok = seqbase + r * 64 + 16 * n + fr;
    bf16x8 qf[2];
#pragma unroll
    for (int ks = 0; ks < 2; ++ks) qf[ks] = *(const bf16x8*)(P + (size_t)qtok * NIN + P_NAQ + 64 * h + 32 * ks + 8 * fq);
    const int col0 = min(max(16 * n - 8, 0), 32), qcol = 16 * n + fr, win0 = min(max(qcol - 8, 0), 48);
    AttnState st;
#pragma unroll
    for (int dt = 0; dt < 4; ++dt) st.o[dt] = (f32x4){0.f, 0.f, 0.f, 0.f};
    st.m = -1e30f; st.l = 0.f;
    const float* rp = rpb + h * (15 * 31);
    for (int kr = 0; kr < 8; ++kr) {
        const int krow = r0 + kr, rowtok = seqbase + krow * 64 + col0;
        attn_stage_v(vt, P, P_NAV + 64 * h, lane, [&](int key) { return rowtok + key; });
        f32x4 sacc[2];
#pragma unroll
        for (int t = 0; t < 2; ++t) { sacc[t] = (f32x4){0.f, 0.f, 0.f, 0.f};
#pragma unroll
            for (int ks = 0; ks < 2; ++ks) { const bf16x8 kf = *(const bf16x8*)(P + (size_t)(rowtok + 16 * t + fr) * NIN + P_NAK + 64 * h + 32 * ks + 8 * fq);
                sacc[t] = MFMA16(kf, qf[ks], sacc[t]); } }
        const float* rrow = rp + (krow - r + 7) * 31;
        float s[2][4]; bool valid[2][4];
#pragma unroll
        for (int t = 0; t < 2; ++t)
#pragma unroll
            for (int g = 0; g < 4; ++g) { const int kc = col0 + 16 * t + 4 * fq + g; const bool v = (kc >= win0) && (kc < win0 + 16);
                const int ci = min(max(kc - qcol + 15, 0), 30);
                valid[t][g] = v; s[t][g] = v ? sacc[t][g] * 0.125f + rrow[ci] : -1e30f; }
        attn_update(st, s, valid, vt, fr, fq);
    }
    float l = st.l; l += __shfl_xor(l, 16); l += __shfl_xor(l, 32);
    const float inv = 1.f / l;
    bf16_t* orow = BR + (size_t)qtok * DM + 0 + 64 * h + 4 * fq;
#pragma unroll
    for (int dt = 0; dt < 4; ++dt) { u32x2 o; o.x = pk2(st.o[dt][0] * inv, st.o[dt][1] * inv); o.y = pk2(st.o[dt][2] * inv, st.o[dt][3] * inv); *(u32x2*)(orow + 16 * dt) = o; }
}

constexpr int DL_OLD = 68;
constexpr int DL_O_OFF = 8 * VT_BYTES;
constexpr int DL_M_OFF = DL_O_OFF + 256 * DL_OLD * 4;
constexpr int DL_L_OFF = DL_M_OFF + 1024;
__device__ __forceinline__ void dl_item(int item, const bf16_t* P, bf16_t* BR, int L, LAS unsigned char* lds) {
    const int tid = opaque_tid(), lane = tid & 63, wave = tid >> 6, fr = lane & 15, fq = lane >> 4;
    const int sp = item >> 2, h = item & 3;
    const int t0 = sp * 256, seq = t0 / L, seqbase = seq * L, p0 = t0 - seqbase;
    LAS bf16_t* vt = (LAS bf16_t*)(lds + wave * VT_BYTES);
    LAS float* OL = (LAS float*)(lds + DL_O_OFF); LAS float* ML = (LAS float*)(lds + DL_M_OFF); LAS float* LL = (LAS float*)(lds + DL_L_OFF);
    __syncthreads();
    for (int e = tid; e < 256 * DL_OLD; e += NTHR) OL[e] = 0.f;
    if (tid < 256) { ML[tid] = -1e30f; LL[tid] = 0.f; }
    __syncthreads();
    const float slope = (h == 0) ? 0.25f : (h == 1) ? 0.0625f : (h == 2) ? 0.015625f : 0.00390625f;
    for (int cfg = 0; cfg < 3; ++cfg) {
        const int dsh = 2 * cfg, dil = 1 << dsh, n = L >> dsh;
        for (int qi = 0; qi < 2; ++qi) {
            const int qt = 2 * wave + qi;
            const int r = (cfg == 0) ? 0 : (cfg == 1) ? (qt >> 2) : qt;
            const int sub = (cfg == 0) ? qt : (cfg == 1) ? (qt & 3) : 0;
            const int j0 = (p0 >> dsh) + 16 * sub, qj = j0 + fr;
            const int qtok = seqbase + (qj << dsh) + r;
            bf16x8 qf[2];
#pragma unroll
            for (int ks = 0; ks < 2; ++ks) qf[ks] = *(const bf16x8*)(P + (size_t)qtok * NIN + P_DQ + 64 * h + 32 * ks + 8 * fq);
            AttnState st;
#pragma unroll
            for (int dt = 0; dt < 4; ++dt) st.o[dt] = (f32x4){0.f, 0.f, 0.f, 0.f};
            st.m = -1e30f; st.l = 0.f;
            for (int sx = 0; sx < 5; ++sx) {
                const int kb = j0 - 64 + 32 * sx;
                if (kb + 32 <= 0 || kb >= n) continue;
                attn_stage_v(vt, P, P_DV + 64 * h, lane, [&](int key) { const int kj = min(max(kb + key, 0), n - 1); return seqbase + (kj << dsh) + r; });
                f32x4 sacc[2];
#pragma unroll
                for (int t = 0; t < 2; ++t) { sacc[t] = (f32x4){0.f, 0.f, 0.f, 0.f};
                    const int kj = min(max(kb + 16 * t + fr, 0), n - 1); const int ktok = seqbase + (kj << dsh) + r;
#pragma unroll
                    for (int ks = 0; ks < 2; ++ks) { const bf16x8 kf = *(const bf16x8*)(P + (size_t)ktok * NIN + P_DK + 64 * h + 32 * ks + 8 * fq);
                        sacc[t] = MFMA16(kf, qf[ks], sacc[t]); } }
                float s[2][4]; bool valid[2][4];
#pragma unroll
                for (int t = 0; t < 2; ++t)
#pragma unroll
                    for (int g = 0; g < 4; ++g) { const int kj = kb + 16 * t + 4 * fq + g; const int dist = abs(kj - qj);
                        const bool v = (dist <= 64) && (kj >= 0) && (kj < n);
                        valid[t][g] = v; s[t][g] = v ? sacc[t][g] * 0.125f - slope * (float)(dist << dsh) : -1e30f; }
                attn_update(st, s, valid, vt, fr, fq);
            }
            float l = st.l; l += __shfl_xor(l, 16); l += __shfl_xor(l, 32);
            const int ql = ((16 * sub + fr) << dsh) + r;
            const float mo = ML[ql], lo = LL[ql], mn = fmaxf(mo, st.m), a = __expf(mo - mn), b = __expf(st.m - mn);
            LAS float* orow = OL + ql * DL_OLD + 4 * fq;
#pragma unroll
            for (int dt = 0; dt < 4; ++dt) { f32x4 ov = *(LAS f32x4*)(orow + 16 * dt); ov = ov * a + st.o[dt] * b; *(LAS f32x4*)(orow + 16 * dt) = ov; }
            __builtin_amdgcn_wave_barrier();
            if (fq == 0) { ML[ql] = mn; LL[ql] = lo * a + l * b; }
        }
        __syncthreads();
    }
    for (int e = tid; e < 256 * 8; e += NTHR) { const int ql = e >> 3, c8 = e & 7;
        const float inv = 1.f / LL[ql]; const LAS float* orow = OL + ql * DL_OLD + 8 * c8;
        const f32x4 a = *(const LAS f32x4*)orow, b = *(const LAS f32x4*)(orow + 4);
        u32x4 o; o.x = pk2(a[0] * inv, a[1] * inv); o.y = pk2(a[2] * inv, a[3] * inv); o.z = pk2(b[0] * inv, b[1] * inv); o.w = pk2(b[2] * inv, b[3] * inv);
        *(u32x4*)(BR + (size_t)(t0 + ql) * DM + 768 + 64 * h + 8 * c8) = o; }
}

constexpr int SG_WLD = 136, SG_VLD = 136;
constexpr int SG_V_OFF = 128 * SG_WLD * 2;
__device__ __forceinline__ void sg_item(int item, const bf16_t* P, bf16_t* BR, const bf16_t* sgw  , const float* ln_g, const float* ln_b, const float* sgb  , LAS unsigned char* lds) {
    const int tid = opaque_tid(), lane = tid & 63, wave = tid >> 6, fr = lane & 15, fq = lane >> 4;
    const int nc = item >> 2, g = item & 3, t0 = nc * 128;
    LAS bf16_t* WL = (LAS bf16_t*)lds; LAS bf16_t* VT = (LAS bf16_t*)(lds + SG_V_OFF);
    __syncthreads();
    for (int e = tid; e < 128 * 16; e += NTHR) { const int row = e >> 4, c8 = e & 15;
        *(LAS u32x4*)(WL + row * SG_WLD + 8 * c8) = *(const u32x4*)(sgw + ((size_t)g * 128 + row) * 128 + 8 * c8); }
    {
        const int s = tid >> 2, qd = tid & 3;
        const bf16_t* vp = P + (size_t)(t0 + s) * NIN + P_SV + 64 * qd;
        float sum = 0.f, sq = 0.f;
#pragma unroll
        for (int i = 0; i < 8; ++i) { const u32x4 w = *(const u32x4*)(vp + 8 * i);
            const unsigned ww[4] = {w.x, w.y, w.z, w.w};
#pragma unroll
            for (int j = 0; j < 4; ++j) { const float a = gelu_tanh(bflo(ww[j])), b = gelu_tanh(bfhi(ww[j])); sum += a + b; sq += a * a + b * b; } }
        sum += __shfl_xor(sum, 1); sum += __shfl_xor(sum, 2); sq += __shfl_xor(sq, 1); sq += __shfl_xor(sq, 2);
        const float mean = sum * (1.f / 256.f), var = fmaxf(sq * (1.f / 256.f) - mean * mean, 0.f), rstd = rsqrtf(var + EPSV);
        const bf16_t* gp = P + (size_t)(t0 + s) * NIN + P_SV + 64 * g + 16 * qd;
#pragma unroll
        for (int i = 0; i < 2; ++i) { const u32x4 w = *(const u32x4*)(gp + 8 * i);
            const unsigned ww[4] = {w.x, w.y, w.z, w.w};
#pragma unroll
            for (int j = 0; j < 4; ++j) {
                const int c = 16 * qd + 8 * i + 2 * j, ch = 64 * g + c;
                const float a = (gelu_tanh(bflo(ww[j])) - mean) * rstd * ln_g[ch] + ln_b[ch], b = (gelu_tanh(bfhi(ww[j])) - mean) * rstd * ln_g[ch + 1] + ln_b[ch + 1];
                VT[c * SG_VLD + s] = f2bf(a); VT[(c + 1) * SG_VLD + s] = f2bf(b); } }
    }
    __syncthreads();
    f32x4 acc[4];
#pragma unroll
    for (int ni = 0; ni < 4; ++ni) acc[ni] = (f32x4){0.f, 0.f, 0.f, 0.f};
#pragma unroll
    for (int ks = 0; ks < 4; ++ks) { const bf16x8 a = *(const LAS bf16x8*)(WL + (16 * wave + fr) * SG_WLD + 32 * ks + 8 * fq);
#pragma unroll
        for (int ni = 0; ni < 4; ++ni) { const bf16x8 b = *(const LAS bf16x8*)(VT + (16 * ni + fr) * SG_VLD + 32 * ks + 8 * fq); acc[ni] = MFMA16(a, b, acc[ni]); } }
#pragma unroll
    for (int reg = 0; reg < 4; ++reg) { const int t = 16 * wave + 4 * fq + reg; const float bs = sgb[g * 128 + t];
        const bf16_t* up = P + (size_t)(t0 + t) * NIN + P_SU + 64 * g; bf16_t* op = BR + (size_t)(t0 + t) * DM + 512 + 64 * g;
#pragma unroll
        for (int ni = 0; ni < 4; ++ni) { const int c = 16 * ni + fr; const float u = gelu_tanh(bf2f(up[c])); op[c] = f2bf(u * (acc[ni][reg] + bs)); } }
}

constexpr int HG_LF_OFF = 0;
constexpr int HG_T_OFF = 32768;
constexpr int HG_TLD = 72, HG_TB = 64 * HG_TLD * 2;
__device__ __forceinline__ float hg_lb(const float* hg_lb_in, int dir, int l, int ch) {
    const float* q = hg_lb_in + (size_t)dir * NLAYER * 256 + ch;
    const float a0 = q[0], a1 = q[256], a2 = q[512], a3 = q[768];
    const float mx = fmaxf(fmaxf(a0, a1), fmaxf(a2, a3));
    const float e0 = __expf(a0 - mx), e1 = __expf(a1 - mx), e2 = __expf(a2 - mx), e3 = __expf(a3 - mx);
    const float num = (l >= 1 ? e1 : 0.f) + (l >= 2 ? e2 : 0.f) + (l >= 3 ? e3 : 0.f);
    return num / (e0 + e1 + e2 + e3);
}
__device__ __forceinline__ void hg_front(const bf16_t* P, int t0, int h, int l, const float* hg_lb_in, LAS unsigned char* lds) {
    const int tid = opaque_tid();
    LAS float* LF = (LAS float*)(lds + HG_LF_OFF);
    {
        const int s = tid >> 3, i0 = 8 * (tid & 7);
#pragma unroll
        for (int dir = 0; dir < 2; ++dir) {
            const u32x4 w = *(const u32x4*)(P + (size_t)(t0 + s) * NIN + (dir ? P_FB : P_FF) + 64 * h + i0);
            const unsigned ww[4] = {w.x, w.y, w.z, w.w};
#pragma unroll
            for (int j = 0; j < 4; ++j) {
                const float lb0 = hg_lb(hg_lb_in, dir, l, 64 * h + i0 + 2 * j), lb1 = hg_lb(hg_lb_in, dir, l, 64 * h + i0 + 2 * j + 1);
                const float f0 = lb0 + (1.f - lb0) * sigmoidf_(bflo(ww[j])), f1 = lb1 + (1.f - lb1) * sigmoidf_(bfhi(ww[j]));
                LF[dir * 4096 + s * 64 + i0 + 2 * j] = __logf(f0); LF[dir * 4096 + s * 64 + i0 + 2 * j + 1] = __logf(f1); }
        }
    }
    __syncthreads();
    if (tid < 128) { const int dir = tid >> 6, i = tid & 63; LAS float* a = LF + dir * 4096 + i; float run = 0.f;
        if (dir == 0) { for (int s = 0; s < 64; ++s) { run += a[s * 64]; a[s * 64] = run; } }
        else { for (int s = 63; s >= 0; --s) { run += a[s * 64]; a[s * 64] = run; } } }
    __syncthreads();
}
__device__ __forceinline__ float hg_kk(const float* hg_lb_in, int dir, int l, int ch, float x) { const float lb = hg_lb(hg_lb_in, dir, l, ch); return (1.f - lb) * sigmoidf_(-x); }

__device__ __forceinline__ void hgA_item(int item, const bf16_t* P, float* HGST, float* HGD, int l, const float* hg_lb_in, LAS unsigned char* lds) {
    const int tid = opaque_tid(), lane = tid & 63, wave = tid >> 6, fr = lane & 15, fq = lane >> 4;
    const int cc = item >> 2, h = item & 3, t0 = cc * 64;
    __syncthreads();
    hg_front(P, t0, h, l, hg_lb_in, lds);
    LAS float* LF = (LAS float*)(lds + HG_LF_OFF);
    LAS bf16_t* KD0 = (LAS bf16_t*)(lds + HG_T_OFF); LAS bf16_t* KD1 = (LAS bf16_t*)(lds + HG_T_OFF + HG_TB); LAS bf16_t* VT = (LAS bf16_t*)(lds + HG_T_OFF + 2 * HG_TB);
    {
        const int s = tid >> 3, i0 = 8 * (tid & 7);
#pragma unroll
        for (int dir = 0; dir < 2; ++dir) {
            const u32x4 w = *(const u32x4*)(P + (size_t)(t0 + s) * NIN + (dir ? P_FB : P_FF) + 64 * h + i0);
            const unsigned ww[4] = {w.x, w.y, w.z, w.w};
            LAS bf16_t* KD = dir ? KD1 : KD0; const LAS float* A = LF + dir * 4096; const int slast = dir ? 0 : 63;
#pragma unroll
            for (int j = 0; j < 8; ++j) { const int i = i0 + j; const float x = (j & 1) ? bfhi(ww[j >> 1]) : bflo(ww[j >> 1]);
                const float kd = hg_kk(hg_lb_in, dir, l, 64 * h + i, x) * __expf(A[slast * 64 + i] - A[s * 64 + i]);
                KD[i * HG_TLD + s] = f2bf(kd); }
        }
        const u32x4 w = *(const u32x4*)(P + (size_t)(t0 + s) * NIN + P_HI + 64 * h + i0);
        const unsigned ww[4] = {w.x, w.y, w.z, w.w};
#pragma unroll
        for (int j = 0; j < 8; ++j) VT[(i0 + j) * HG_TLD + s] = (bf16_t)((j & 1) ? (ww[j >> 1] >> 16) : (ww[j >> 1] & 0xffffu));
        if (tid < 128) { const int dir = tid >> 6, i = tid & 63; HGD[((size_t)(cc * 4 + h) * 2 + dir) * 64 + i] = __expf(LF[dir * 4096 + (dir ? 0 : 63) * 64 + i]); }
    }
    __syncthreads();
    {
        const int dir = wave >> 2, mt = wave & 3; const LAS bf16_t* KD = dir ? KD1 : KD0;
        f32x4 acc[4];
#pragma unroll
        for (int ni = 0; ni < 4; ++ni) acc[ni] = (f32x4){0.f, 0.f, 0.f, 0.f};
#pragma unroll
        for (int ks = 0; ks < 2; ++ks) { const bf16x8 a = *(const LAS bf16x8*)(VT + (16 * mt + fr) * HG_TLD + 32 * ks + 8 * fq);
#pragma unroll
            for (int ni = 0; ni < 4; ++ni) { const bf16x8 b = *(const LAS bf16x8*)(KD + (16 * ni + fr) * HG_TLD + 32 * ks + 8 * fq); acc[ni] = MFMA16(a, b, acc[ni]); } }
        float* dst = HGST + ((size_t)(cc * 4 + h) * 2 + dir) * 4096;
#pragma unroll
        for (int ni = 0; ni < 4; ++ni)
#pragma unroll
            for (int reg = 0; reg < 4; ++reg) dst[(16 * mt + 4 * fq + reg) * 64 + 16 * ni + fr] = acc[ni][reg];
    }
}
__device__ __forceinline__ void hgB_phase(float* HGST, const float* HGD, int L) {
    const int ncs = L >> 6, nseq = TC / L, total = nseq * 8 * 4096;
    for (int e = blockIdx.x * NTHR + opaque_tid(); e < total; e += gridDim.x * NTHR) {
        const int ji = e & 4095, dir = (e >> 12) & 1, h = (e >> 13) & 3, seq = e >> 15, i = ji & 63;
        float S = 0.f;
        for (int c = 0; c < ncs; ++c) { const int cc = seq * ncs + (dir ? (ncs - 1 - c) : c);
            const size_t o = ((size_t)(cc * 4 + h) * 2 + dir);
            const float u = HGST[o * 4096 + ji], d = HGD[o * 64 + i];
            HGST[o * 4096 + ji] = S; S = S * d + u; }
    }
}
__device__ __forceinline__ void hgC_item(int item, const bf16_t* P, bf16_t* BR, const float* HGST, int l, const float* hg_lb_in, const float* gnorm  , LAS unsigned char* lds) {
    const int tid = opaque_tid(), lane = tid & 63, wave = tid >> 6, fr = lane & 15, fq = lane >> 4;
    const int cc = item >> 2, h = item & 3, t0 = cc * 64;
    __syncthreads();
    hg_front(P, t0, h, l, hg_lb_in, lds);
    LAS float* LF = (LAS float*)(lds + HG_LF_OFF);
#define HGT(k) ((LAS bf16_t*)(lds + HG_T_OFF + (k) * HG_TB))
    {
        const int s = tid >> 3, i0 = 8 * (tid & 7);
        const u32x4 wq = *(const u32x4*)(P + (size_t)(t0 + s) * NIN + P_HQ + 64 * h + i0);
        const unsigned wqq[4] = {wq.x, wq.y, wq.z, wq.w};
#pragma unroll
        for (int dir = 0; dir < 2; ++dir) {
            const u32x4 w = *(const u32x4*)(P + (size_t)(t0 + s) * NIN + (dir ? P_FB : P_FF) + 64 * h + i0);
            const unsigned ww[4] = {w.x, w.y, w.z, w.w};
            const LAS float* A = LF + dir * 4096;
            u32x4 oq, ok, oe; unsigned* oqp = (unsigned*)&oq; unsigned* okp = (unsigned*)&ok; unsigned* oep = (unsigned*)&oe;
#pragma unroll
            for (int j2 = 0; j2 < 4; ++j2) { float qt[2], kt[2], qe[2];
#pragma unroll
                for (int e = 0; e < 2; ++e) { const int i = i0 + 2 * j2 + e; const float x = e ? bfhi(ww[j2]) : bflo(ww[j2]); const float qs = siluf_(e ? bfhi(wqq[j2]) : bflo(wqq[j2]));
                    const float a = A[s * 64 + i], ref = A[32 * 64 + i];
                    const float d1 = fminf(fmaxf(a - ref, -80.f), 80.f);
                    qt[e] = qs * __expf(d1); kt[e] = hg_kk(hg_lb_in, dir, l, 64 * h + i, x) * __expf(-d1); qe[e] = qs * __expf(a); }
                oqp[j2] = pk2(qt[0], qt[1]); okp[j2] = pk2(kt[0], kt[1]); oep[j2] = pk2(qe[0], qe[1]); }
            *(LAS u32x4*)(HGT(0 + dir) + s * HG_TLD + i0) = oq; *(LAS u32x4*)(HGT(2 + dir) + s * HG_TLD + i0) = ok; *(LAS u32x4*)(HGT(4 + dir) + s * HG_TLD + i0) = oe;
        }
        const u32x4 w = *(const u32x4*)(P + (size_t)(t0 + s) * NIN + P_HI + 64 * h + i0);
        const unsigned ww[4] = {w.x, w.y, w.z, w.w};
        LAS bf16_t* VT = HGT(6);
#pragma unroll
        for (int j = 0; j < 8; ++j) VT[(i0 + j) * HG_TLD + s] = (bf16_t)((j & 1) ? (ww[j >> 1] >> 16) : (ww[j >> 1] & 0xffffu));
        { const int dir = tid >> 8, j = (tid >> 2) & 63, i4 = 16 * (tid & 3);
          const float* src = HGST + ((size_t)(cc * 4 + h) * 2 + dir) * 4096 + j * 64 + i4; LAS bf16_t* dstp = HGT(8 + dir) + j * HG_TLD + i4;
#pragma unroll
          for (int q = 0; q < 2; ++q) { const f32x4 a = *(const f32x4*)(src + 8 * q), b = *(const f32x4*)(src + 8 * q + 4);
              u32x4 o; o.x = pk2(a[0], a[1]); o.y = pk2(a[2], a[3]); o.z = pk2(b[0], b[1]); o.w = pk2(b[2], b[3]); *(LAS u32x4*)(dstp + 8 * q) = o; } }
    }
    __syncthreads();
    {
        const int mt = wave >> 1;
#pragma unroll
        for (int q = 0; q < 2; ++q) { const int nt = 2 * (wave & 1) + q;
            f32x4 af = (f32x4){0.f, 0.f, 0.f, 0.f}, ab = (f32x4){0.f, 0.f, 0.f, 0.f};
            if (nt <= mt) {
#pragma unroll
                for (int ks = 0; ks < 2; ++ks) af = MFMA16(*(const LAS bf16x8*)(HGT(0) + (16 * mt + fr) * HG_TLD + 32 * ks + 8 * fq), *(const LAS bf16x8*)(HGT(2) + (16 * nt + fr) * HG_TLD + 32 * ks + 8 * fq), af); }
            if (nt >= mt) {
#pragma unroll
                for (int ks = 0; ks < 2; ++ks) ab = MFMA16(*(const LAS bf16x8*)(HGT(1) + (16 * mt + fr) * HG_TLD + 32 * ks + 8 * fq), *(const LAS bf16x8*)(HGT(3) + (16 * nt + fr) * HG_TLD + 32 * ks + 8 * fq), ab); }
            const int s = 16 * nt + fr;
#pragma unroll
            for (int reg = 0; reg < 4; ++reg) { const int t = 16 * mt + 4 * fq + reg;
                const float v = ((s <= t) ? af[reg] : 0.f) + ((s >= t) ? ab[reg] : 0.f);
                HGT(7)[t * HG_TLD + s] = f2bf(v); } }
    }
    __syncthreads();
    if (wave < 4) {
        const int mt = wave;
        f32x4 acc[4];
#pragma unroll
        for (int ni = 0; ni < 4; ++ni) acc[ni] = (f32x4){0.f, 0.f, 0.f, 0.f};
#pragma unroll
        for (int pr = 0; pr < 3; ++pr) { const LAS bf16_t* Am = (pr == 0) ? HGT(7) : (pr == 1) ? HGT(4) : HGT(5); const LAS bf16_t* Bm = (pr == 0) ? HGT(6) : (pr == 1) ? HGT(8) : HGT(9);
#pragma unroll
            for (int ks = 0; ks < 2; ++ks) { const bf16x8 a = *(const LAS bf16x8*)(Am + (16 * mt + fr) * HG_TLD + 32 * ks + 8 * fq);
#pragma unroll
                for (int ni = 0; ni < 4; ++ni) acc[ni] = MFMA16(a, *(const LAS bf16x8*)(Bm + (16 * ni + fr) * HG_TLD + 32 * ks + 8 * fq), acc[ni]); } }
#pragma unroll
        for (int reg = 0; reg < 4; ++reg) { const int t = 16 * mt + 4 * fq + reg;
            float ss = acc[0][reg] * acc[0][reg] + acc[1][reg] * acc[1][reg] + acc[2][reg] * acc[2][reg] + acc[3][reg] * acc[3][reg];
            ss += __shfl_xor(ss, 1); ss += __shfl_xor(ss, 2); ss += __shfl_xor(ss, 4); ss += __shfl_xor(ss, 8);
            const float rn = rsqrtf(ss * (1.f / 64.f) + EPSV);
            const bf16_t* gp = P + (size_t)(t0 + t) * NIN + P_HGATE + 64 * h; bf16_t* op = BR + (size_t)(t0 + t) * DM + 256 + 64 * h;
#pragma unroll
            for (int ni = 0; ni < 4; ++ni) { const int j = 16 * ni + fr; op[j] = f2bf(acc[ni][reg] * rn * gnorm[64 * h + j] * siluf_(bf2f(gp[j]))); } }
    }
#undef HGT
}

#define GRID_SYNC() grid.sync()

__global__ void __launch_bounds__(512, 2) fwd_megakernel(Params p) {
    extern __shared__ __attribute__((aligned(16))) unsigned char smem[];
    LAS unsigned char* lds = (LAS unsigned char*)smem;
    cg::grid_group grid = cg::this_grid();
    unsigned char* ws = p.ws;
    const int G = gridDim.x, c = blockIdx.x;
    float* MOD = (float*)(ws + OFF_MOD);
    bf16_t* H = (bf16_t*)(ws + OFF_H); bf16_t* P = (bf16_t*)(ws + OFF_P); bf16_t* BR = (bf16_t*)(ws + OFF_BR); bf16_t* MG = (bf16_t*)(ws + OFF_MG);
    bf16_t* ACT = P;
    float* HGST = (float*)(ws + OFF_HGST); float* HGD = (float*)(ws + OFF_HGD);

#ifndef SKIP_PRO
    phase_prologue(p, lds);
#endif
                GRID_SYNC();
    phase_mod_reduce(p);
    GRID_SYNC();

    for (int ck = 0; ck < NCHUNK; ++ck) {
        const int L = chunk_L(ck), bbase = chunk_bbase(ck);
        float* X = p.out + (size_t)ck * TC * DM;
        const float* xin = (ck < 2) ? p.in[0] + (size_t)ck * TC * DM : p.in[1];
        for (int l = 0; l < NLAYER; ++l) {
            const float* modl = MOD + (size_t)l * 6144;
            phase_norm_mod(l == 0 ? xin : X, l == 0 ? X : nullptr, H, p.in[6] + l * DM, modl + 0, modl + 1024, L, bbase);
            GRID_SYNC();
#ifndef SKIP_G1
            { SchedStd S; S.to.init(TC / 256, NIN / 256, G, c); S.A = (const char*)H; S.B = (const char*)(ws + OFF_WIN) + (size_t)l * NIN * DM * 2; S.atile = 256 * DM * 2; S.btile = 256 * DM * 2; S.nt = DM / 64;
              EpiProj E; E.O = P; E.ldc = NIN;
              pg8::gemm_phase(lds, DM, DM, S, E); }
            #endif
            GRID_SYNC();
#ifndef SKIP_MIX1
            for (int it = c; it < 256 + 1024; it += G) {
                if (it < 256) dl_item(it, P, BR, L, lds);
                else hgA_item(it - 256, P, HGST, HGD, l, p.in[14], lds);
            }
            #endif
            GRID_SYNC();
#ifndef SKIP_MIX2
            hgB_phase(HGST, HGD, L);
            for (int it = c; it < 512 + 512; it += G) {
                if (it < 512) { __syncthreads(); na_item(it, P, BR, p.in[13] + (size_t)l * 4 * 15 * 31, L, lds); }
                else sg_item(it - 512, P, BR, (const bf16_t*)(ws + OFF_SGW) + (size_t)l * 4 * 128 * 128, p.in[16] + l * 256, p.in[17] + l * 256, p.in[19] + l * 512, lds);
            }
            #endif
            GRID_SYNC();
#ifndef SKIP_MIX3
            for (int it = c; it < 1024; it += G) hgC_item(it, P, BR, HGST, l, p.in[14], p.in[15] + l * 256, lds);
            #endif
            GRID_SYNC();
#ifndef SKIP_MERGE
            { SchedMerge S; S.to.init(TC / 256, DM / 256, G, c); S.H = (const char*)H; S.BR = (const char*)BR; S.WG = (const char*)(ws + OFF_WG) + (size_t)l * 4 * DM * DM * 2; S.WB = (const char*)(ws + OFF_WB) + (size_t)l * DM * DM * 2;
              EpiMerge E; E.MG = MG; E.bgate = p.in[10] + (size_t)l * 4 * DM; E.scr = (unsigned char*)P + (size_t)c * MERGE_SCR_PER_BLOCK;
              pg8::gemm_phase(lds, DM, DM, S, E); }
            #endif
            GRID_SYNC();
#ifndef SKIP_WO
            { SchedStd S; S.to.init(TC / 256, DM / 256, G, c); S.A = (const char*)MG; S.B = (const char*)(ws + OFF_WO) + (size_t)l * DM * DM * 2; S.atile = 256 * DM * 2; S.btile = 256 * DM * 2; S.nt = DM / 64;
              EpiRes E; E.X = X; E.gm = modl + 2048; E.L = L; E.bbase = bbase;
              pg8::gemm_phase(lds, DM, DM, S, E); }
            #endif
            GRID_SYNC();
            phase_norm_mod(X, nullptr, H, p.in[7] + l * DM, modl + 3072, modl + 4096, L, bbase);
            GRID_SYNC();
#ifndef SKIP_F1
            { SchedStd S; S.to.init(TC / 256, 2 * DFF / 256, G, c); S.A = (const char*)H; S.B = (const char*)(ws + OFF_WGU) + (size_t)l * 2 * DFF * DM * 2; S.atile = 256 * DM * 2; S.btile = 256 * DM * 2; S.nt = DM / 64;
              EpiAct E; E.O = ACT;
              pg8::gemm_phase(lds, DM, DM, S, E); }
            #endif
            GRID_SYNC();
#ifndef SKIP_F2
            { SchedStd S; S.to.init(TC / 256, DM / 256, G, c); S.A = (const char*)ACT; S.B = (const char*)(ws + OFF_WD) + (size_t)l * DM * DFF * 2; S.atile = (size_t)256 * DFF * 2; S.btile = (size_t)256 * DFF * 2; S.nt = DFF / 64;
              EpiRes E; E.X = X; E.gm = modl + 5120; E.L = L; E.bbase = bbase;
              pg8::gemm_phase(lds, DFF, DFF, S, E); }
            #endif
            GRID_SYNC();
        }
        phase_final_norm(X, p.in[23]);
    }
}

extern "C" void kernel_launch(void* const* d_in, const int* in_sizes, int n_in, void* d_out, int out_size, void* d_ws, size_t ws_size, hipStream_t stream) {
    static int grid = 0;
    if (grid == 0) {
        if (n_in != 24 || ws_size < WS_END) { fprintf(stderr, "kernel_launch: unexpected n_in %d or ws_size %zu (need %zu)\n", n_in, ws_size, (size_t)WS_END); grid = -1; return; }
        int dev = 0, cus = 0, per_cu = 0;
        hipGetDevice(&dev);
        hipDeviceGetAttribute(&cus, hipDeviceAttributeMultiprocessorCount, dev);
        if (hipFuncSetAttribute((const void*)fwd_megakernel, hipFuncAttributeMaxDynamicSharedMemorySize, LDS_BYTES) != hipSuccess) { fprintf(stderr, "kernel_launch: hipFuncSetAttribute failed\n"); grid = -1; return; }
        hipOccupancyMaxActiveBlocksPerMultiprocessor(&per_cu, (const void*)fwd_megakernel, NTHR, LDS_BYTES);
        if (per_cu < 1) { fprintf(stderr, "kernel_launch: occupancy query says %d blocks per CU\n", per_cu); per_cu = 1; }
        (void)hipGetLastError();
        grid = cus;
        if (grid > 272) grid = 272;
    }
    if (grid < 0) return;
    Params p{};
    for (int i = 0; i < 24; ++i) p.in[i] = (const float*)d_in[i];
    p.out = (float*)d_out; p.ws = (unsigned char*)d_ws;
    void* args[] = {&p};
    hipError_t e = hipLaunchCooperativeKernel((const void*)fwd_megakernel, dim3(grid), dim3(NTHR), args, LDS_BYTES, stream);
    if (e != hipSuccess) fprintf(stderr, "cooperative launch failed: %s (grid %d)\n", hipGetErrorString(e), grid);
}
```

```cpp
#include <hip/hip_runtime.h>
#include <hip/hip_cooperative_groups.h>
#include <cstdio>
#include <cstdint>
namespace cg = cooperative_groups;

#define LAS __attribute__((address_space(3)))
typedef unsigned short bf16_t;
typedef short bf16x8 __attribute__((ext_vector_type(8)));
typedef float f32x4 __attribute__((ext_vector_type(4)));
typedef unsigned u32x4 __attribute__((ext_vector_type(4)));
typedef unsigned u32x2 __attribute__((ext_vector_type(2)));

constexpr int DM = 1024, TC = 16384, NCHUNK = 3, NIN = 3328, DFF = 2816, NLAYER = 4, NB = 20;
constexpr int P_NAQ = 0, P_NAK = 256, P_NAV = 512, P_FF = 768, P_FB = 1024, P_HQ = 1280, P_HI = 1536, P_HGATE = 1792, P_SU = 2048, P_SV = 2304, P_DQ = 2560, P_DK = 2816, P_DV = 3072;
constexpr float EPSV = 1e-6f;
constexpr int LDS_BYTES = 147456;
constexpr int NTHR = 512;

constexpr size_t OFF_CTL = 0;
constexpr size_t OFF_MOD = 16384;
constexpr size_t SZ_MOD = (size_t)NB * NLAYER * 6144 * 4;
constexpr size_t OFF_MODP = OFF_MOD + SZ_MOD;
constexpr size_t OFF_WIN = OFF_MODP + 8 * SZ_MOD;
constexpr size_t OFF_WG = OFF_WIN + (size_t)NLAYER * NIN * DM * 2;
constexpr size_t OFF_WB = OFF_WG + (size_t)NLAYER * 4 * DM * DM * 2;
constexpr size_t OFF_WO = OFF_WB + (size_t)NLAYER * DM * DM * 2;
constexpr size_t OFF_WGU = OFF_WO + (size_t)NLAYER * DM * DM * 2;
constexpr size_t OFF_WD = OFF_WGU + (size_t)NLAYER * 2 * DFF * DM * 2;
constexpr size_t OFF_SGW = OFF_WD + (size_t)NLAYER * DM * DFF * 2;
constexpr size_t OFF_H = OFF_SGW + (size_t)NLAYER * 4 * 128 * 128 * 2;
constexpr size_t OFF_P = OFF_H + (size_t)TC * DM * 2;
constexpr size_t OFF_BR = OFF_P + (size_t)TC * NIN * 2;
constexpr size_t OFF_MG = OFF_BR + (size_t)TC * DM * 2;
constexpr size_t OFF_HGST = OFF_MG + (size_t)TC * DM * 2;
constexpr size_t OFF_HGD = OFF_HGST + (size_t)256 * 8 * 4096 * 4;
constexpr size_t WS_END = OFF_HGD + (size_t)256 * 8 * 64 * 4;
constexpr size_t MERGE_SCR_PER_BLOCK = 131072 + 262144;

struct Params {
    const float* in[24];
    float* out;
    unsigned char* ws;
};

__device__ __forceinline__ unsigned pk2(float lo, float hi) { unsigned r; asm("v_cvt_pk_bf16_f32 %0, %1, %2" : "=v"(r) : "v"(lo), "v"(hi)); return r; }
__device__ __forceinline__ bf16_t f2bf(float f) { return (bf16_t)(pk2(f, 0.f) & 0xffffu); }
__device__ __forceinline__ float bf2f(unsigned b) { return __uint_as_float(b << 16); }
__device__ __forceinline__ float bflo(unsigned w) { return __uint_as_float(w << 16); }
__device__ __forceinline__ float bfhi(unsigned w) { return __uint_as_float(w & 0xffff0000u); }
__device__ __forceinline__ float sigmoidf_(float x) { return 1.f / (1.f + __expf(-x)); }
__device__ __forceinline__ float siluf_(float x) { return x * sigmoidf_(x); }
__device__ __forceinline__ float gelu_tanh(float x) { return x * sigmoidf_(1.5957691216f * (x + 0.044715f * x * x * x)); }
__device__ __forceinline__ float wave_sum(float v) {
#pragma unroll
    for (int o = 1; o < 64; o <<= 1) v += __shfl_xor(v, o);
    return v;
}
__device__ __forceinline__ int opaque_tid() { int t = threadIdx.x; asm volatile("" : "+v"(t)); return t; }
#define MFMA16(a, b, c) __builtin_amdgcn_mfma_f32_16x16x32_bf16((a), (b), (c), 0, 0, 0)

__device__ __forceinline__ int chunk_L(int ck) { return ck < 2 ? 2048 : 4096; }
__device__ __forceinline__ int chunk_bbase(int ck) { return ck * 8; }

namespace pg8 {
constexpr int BM = 256, BK = 64, HALF = 128, HTB = HALF * BK * 2, STAGE_BYTES = 8 * HTB, NXCD = 8, WGM = 8;
__host__ __device__ __forceinline__ int lds_byte(int r, int c) { const int st = (r >> 4) * 2 + (c >> 5), rr = r & 15, cc = c & 31, ob = rr * 64 + cc * 2; return st * 1024 + (ob ^ (((ob >> 9) & 1) << 5)); }
__host__ __device__ __forceinline__ void stage_rc(int b, int& R, int& C) { const int st = b / 1024, sb = b % 1024, swz = sb ^ (((sb >> 9) & 1) << 5); R = (st >> 1) * 16 + swz / 64; C = (st & 1) * 32 + (swz % 64) / 2; }
__host__ __device__ __forceinline__ int perm32(int rho) { const int n = rho >> 4, i = rho & 15; return 8 * (i >> 2) + 4 * n + (i & 3); }

struct Unit { const char* a; const char* b; int nt; int pm, pn, kind; };

struct TileOrder {
    int nM, nN, nwg, G, c;
    __device__ __forceinline__ void init(int nM_, int nN_, int G_, int c_) { nM = nM_; nN = nN_; nwg = nM * nN; G = G_; c = c_; }
    __device__ __forceinline__ bool tile(int i, int& pm, int& pn) const {
        const long L = (long)i * G + c; if (L >= nwg) return false;
        int wgid = (int)L; { const int q = nwg / NXCD, r = nwg % NXCD, xcd = wgid % NXCD, off = wgid / NXCD; wgid = (xcd < r ? xcd * (q + 1) : r * (q + 1) + (xcd - r) * q) + off; }
        const int nig = WGM * nN, gid = wgid / nig, fm = gid * WGM, gsz = (nM - fm) < WGM ? (nM - fm) : WGM;
        pm = fm + ((wgid % nig) % gsz); pn = (wgid % nig) / gsz; return true;
    }
};

template <class Epi, class Sched>
__device__ __forceinline__ void gemm_phase(LAS unsigned char* lds, const int lda, const int ldb, const Sched& S, const Epi& E) {
    const int tid = opaque_tid(), wid = __builtin_amdgcn_readfirstlane(tid >> 6), lane = tid & 63, wr = wid >> 2, wc = wid & 3, fr = lane & 15, fq = lane >> 4;
    unsigned voffA[2], voffB[2];
#pragma unroll
    for (int i = 0; i < 2; ++i) { int R, C; stage_rc(tid * 16 + i * 8192, R, C); const int Rb = Epi::PERM ? ((R & ~31) + perm32(R & 31)) : R;
        voffA[i] = (unsigned)(R * lda + C) * 2u; voffB[i] = (unsigned)(Rb * ldb + C) * 2u; }
    const size_t kstep = (size_t)(BK * 2);
    const size_t hstepA = (size_t)HALF * lda * 2, hstepB = (size_t)HALF * ldb * 2;
    const unsigned ldsw = (unsigned)wid * 1024u;
    const int aoff = lds_byte(wr * 64 + fr, fq * 8), boff = lds_byte(wc * 32 + fr, fq * 8);
#define PG8_SA(b, h) (((b) * 2 + (h)) * HTB)
#define PG8_SB(b, h) ((4 + (b) * 2 + (h)) * HTB)
#define PG8_STAGE(bufoff, gbase, voff) do { _Pragma("unroll") for (int _i = 0; _i < 2; ++_i) \
        __builtin_amdgcn_global_load_lds((const unsigned*)((const char*)(gbase) + (voff)[_i]), (LAS unsigned*)(lds + (bufoff) + ldsw + _i * 8192), 16, 0, 0); } while (0)
#define PG8_LDA(dst, b, h) do { _Pragma("unroll") for (int m = 0; m < 4; ++m) _Pragma("unroll") for (int k = 0; k < 2; ++k) dst[m][k] = *(const LAS bf16x8*)(lds + PG8_SA(b, h) + aoff + m * 2048 + k * 1024); } while (0)
#define PG8_LDB(dst, b, h) do { _Pragma("unroll") for (int n = 0; n < 2; ++n) _Pragma("unroll") for (int k = 0; k < 2; ++k) dst[n][k] = *(const LAS bf16x8*)(lds + PG8_SB(b, h) + boff + n * 2048 + k * 1024); } while (0)
#define PG8_MMA(ai, bj, At, Bt) do { __builtin_amdgcn_s_setprio(1); _Pragma("unroll") for (int m = 0; m < 4; ++m) _Pragma("unroll") for (int n = 0; n < 2; ++n) _Pragma("unroll") for (int k = 0; k < 2; ++k) \
        acc[ai][bj][m][n] = __builtin_amdgcn_mfma_f32_16x16x32_bf16(Bt[n][k], At[m][k], acc[ai][bj][m][n], 0, 0, 0); __builtin_amdgcn_s_setprio(0); } while (0)
#define PG8_WAIT_V(n) asm volatile("s_waitcnt vmcnt(" #n ")" ::: "memory")
#define PG8_WAIT_L(n) asm volatile("s_waitcnt lgkmcnt(" #n ")" ::: "memory")
#define PG8_BAR __builtin_amdgcn_s_barrier()
#define PG8_SCHED __builtin_amdgcn_sched_barrier(0)
    Unit cur, nxt; int ui = 0;
    if (!S.next(0, cur)) return;
    f32x4 acc[2][2][4][2];
#pragma unroll
    for (int a = 0; a < 2; ++a)
#pragma unroll
        for (int b = 0; b < 2; ++b)
#pragma unroll
            for (int m = 0; m < 4; ++m)
#pragma unroll
                for (int n = 0; n < 2; ++n) acc[a][b][m][n] = (f32x4){0.f, 0.f, 0.f, 0.f};
    bf16x8 At[4][2], B0[2][2], B1[2][2];
    const char* cA = cur.a; const char* cB = cur.b;
    PG8_STAGE(PG8_SB(0, 0), cB, voffB); PG8_STAGE(PG8_SA(0, 0), cA, voffA); PG8_STAGE(PG8_SB(0, 1), cB + hstepB, voffB); PG8_STAGE(PG8_SA(0, 1), cA + hstepA, voffA);
    if (wr == 1) PG8_BAR;
    PG8_WAIT_V(4); PG8_BAR;
    PG8_STAGE(PG8_SB(1, 0), cB + kstep, voffB); PG8_STAGE(PG8_SA(1, 0), cA + kstep, voffA); PG8_STAGE(PG8_SB(1, 1), cB + hstepB + kstep, voffB);
    PG8_WAIT_V(6); PG8_BAR;
    for (;;) {
        const bool has_next = S.next(ui + 1, nxt);
        const char* nA = has_next ? nxt.a : cA; const char* nB = has_next ? nxt.b : cB;
        const int nt = cur.nt;
        for (int t = 0; t < nt; t += 2) {
            const bool last = (t == nt - 2);
            const char* a1 = cA + (size_t)(t + 1) * kstep;
            const char* a2 = last ? nA : cA + (size_t)(t + 2) * kstep; const char* b2 = last ? nB : cB + (size_t)(t + 2) * kstep;
            const char* a3 = a2 + kstep; const char* b3 = b2 + kstep;
            PG8_LDB(B0, 0, 0); PG8_SCHED; PG8_LDA(At, 0, 0); PG8_STAGE(PG8_SA(1, 1), a1 + hstepA, voffA);
            PG8_WAIT_L(8); PG8_BAR; PG8_WAIT_L(0); PG8_MMA(0, 0, At, B0); PG8_BAR; PG8_SCHED;
            PG8_LDB(B1, 0, 1); PG8_STAGE(PG8_SB(0, 0), b2, voffB);
            PG8_BAR; PG8_WAIT_L(0); PG8_MMA(0, 1, At, B1); PG8_BAR;
            PG8_LDA(At, 0, 1); PG8_STAGE(PG8_SA(0, 0), a2, voffA);
            PG8_BAR; PG8_WAIT_L(0); PG8_MMA(1, 0, At, B0); PG8_BAR; PG8_SCHED;
            PG8_STAGE(PG8_SB(0, 1), b2 + hstepB, voffB);
            PG8_WAIT_V(6); PG8_BAR; PG8_MMA(1, 1, At, B1); PG8_BAR;
            PG8_LDB(B0, 1, 0); PG8_SCHED; PG8_LDA(At, 1, 0); PG8_STAGE(PG8_SA(0, 1), a2 + hstepA, voffA);
            PG8_WAIT_L(8); PG8_BAR; PG8_WAIT_L(0); PG8_MMA(0, 0, At, B0); PG8_BAR; PG8_SCHED;
            PG8_LDB(B1, 1, 1); PG8_STAGE(PG8_SB(1, 0), b3, voffB);
            PG8_BAR; PG8_WAIT_L(0); PG8_MMA(0, 1, At, B1); PG8_BAR;
            PG8_LDA(At, 1, 1); PG8_STAGE(PG8_SA(1, 0), a3, voffA);
            PG8_BAR; PG8_WAIT_L(0); PG8_MMA(1, 0, At, B0); PG8_BAR; PG8_SCHED;
            PG8_STAGE(PG8_SB(1, 1), b3 + hstepB, voffB);
            PG8_WAIT_V(6); PG8_BAR; PG8_MMA(1, 1, At, B1); PG8_BAR;
        }
        E(acc, cur, wr, wc, fr, fq);
        if (!has_next) break;
#pragma unroll
        for (int a = 0; a < 2; ++a)
#pragma unroll
            for (int b = 0; b < 2; ++b)
#pragma unroll
                for (int m = 0; m < 4; ++m)
#pragma unroll
                    for (int n = 0; n < 2; ++n) acc[a][b][m][n] = (f32x4){0.f, 0.f, 0.f, 0.f};
        cur = nxt; cA = nA; cB = nB; ++ui;
    }
    PG8_WAIT_V(0);
    if (wr == 0) PG8_BAR;
    PG8_BAR;
#undef PG8_SA
#undef PG8_SB
#undef PG8_STAGE
#undef PG8_LDA
#undef PG8_LDB
#undef PG8_MMA
#undef PG8_WAIT_V
#undef PG8_WAIT_L
#undef PG8_BAR
#undef PG8_SCHED
}
}
using pg8::Unit;

struct SchedStd {
    pg8::TileOrder to; const char* A; const char* B; size_t atile, btile; int nt;
    __device__ __forceinline__ bool next(int i, Unit& u) const {
        int pm, pn; if (!to.tile(i, pm, pn)) return false;
        u.pm = pm; u.pn = pn; u.kind = 0; u.nt = nt; u.a = A + (size_t)pm * atile; u.b = B + (size_t)pn * btile; return true;
    }
};
struct SchedMerge {
    pg8::TileOrder to; const char* H; const char* BR; const char* WG; const char* WB;
    __device__ __forceinline__ bool next(int i, Unit& u) const {
        int pm, pn; if (!to.tile(i >> 3, pm, pn)) return false;
        const int sub = i & 7, bi = sub >> 1;
        u.pm = pm; u.pn = pn; u.kind = sub;
        if (sub & 1) { u.nt = 16; u.a = H + (size_t)pm * (256 * DM * 2); u.b = WG + (size_t)bi * (DM * DM * 2) + (size_t)pn * (256 * DM * 2); }
        else { u.nt = 4; u.a = BR + (size_t)pm * (256 * DM * 2) + bi * 512; u.b = WB + (size_t)pn * (256 * DM * 2) + bi * 512; }
        return true;
    }
};

struct EpiProj {
    static constexpr bool PERM = true;
    bf16_t* O; int ldc;
    __device__ __forceinline__ void operator()(const f32x4 (&acc)[2][2][4][2], const Unit& u, int wr, int wc, int fr, int fq) const {
        const int row0 = u.pm * 256 + wr * 64 + fr, col0 = u.pn * 256 + wc * 32 + 8 * fq;
#pragma unroll
        for (int ai = 0; ai < 2; ++ai)
#pragma unroll
            for (int m = 0; m < 4; ++m) { bf16_t* rowp = O + (size_t)(row0 + ai * 128 + m * 16) * ldc + col0;
#pragma unroll
                for (int bj = 0; bj < 2; ++bj) { const f32x4 v0 = acc[ai][bj][m][0], v1 = acc[ai][bj][m][1];
                    u32x4 o; o.x = pk2(v0[0], v0[1]); o.y = pk2(v0[2], v0[3]); o.z = pk2(v1[0], v1[1]); o.w = pk2(v1[2], v1[3]);
                    *(u32x4*)(rowp + bj * 128) = o; } }
    }
};
struct EpiAct {
    static constexpr bool PERM = true;
    bf16_t* O;
    __device__ __forceinline__ void operator()(const f32x4 (&acc)[2][2][4][2], const Unit& u, int wr, int wc, int fr, int fq) const {
        const int row0 = u.pm * 256 + wr * 64 + fr, col0 = u.pn * 128 + wc * 32 + 8 * fq;
#pragma unroll
        for (int ai = 0; ai < 2; ++ai)
#pragma unroll
            for (int m = 0; m < 4; ++m) { bf16_t* rowp = O + (size_t)(row0 + ai * 128 + m * 16) * DFF + col0;
                float r[8];
#pragma unroll
                for (int n = 0; n < 2; ++n)
#pragma unroll
                    for (int j = 0; j < 4; ++j) { const float g = acc[ai][0][m][n][j], up = acc[ai][1][m][n][j]; r[n * 4 + j] = siluf_(g) * up; }
                u32x4 o; o.x = pk2(r[0], r[1]); o.y = pk2(r[2], r[3]); o.z = pk2(r[4], r[5]); o.w = pk2(r[6], r[7]);
                *(u32x4*)rowp = o; }
    }
};
struct EpiRes {
    static constexpr bool PERM = false;
    float* X; const float* gm; int L; int bbase;
    __device__ __forceinline__ void operator()(const f32x4 (&acc)[2][2][4][2], const Unit& u, int wr, int wc, int fr, int fq) const {
        const int row0 = u.pm * 256 + wr * 64 + fr, col0 = u.pn * 256 + wc * 32 + 4 * fq;
        const int b = bbase + (u.pm * 256) / L;
        const float* g = gm + (size_t)b * (NLAYER * 6144) + col0;
        f32x4 gv[2][2];
#pragma unroll
        for (int bj = 0; bj < 2; ++bj)
#pragma unroll
            for (int n = 0; n < 2; ++n) gv[bj][n] = *(const f32x4*)(g + bj * 128 + n * 16);
#pragma unroll
        for (int ai = 0; ai < 2; ++ai)
#pragma unroll
            for (int m = 0; m < 4; ++m) { float* rowp = X + (size_t)(row0 + ai * 128 + m * 16) * DM + col0;
#pragma unroll
                for (int bj = 0; bj < 2; ++bj)
#pragma unroll
                    for (int n = 0; n < 2; ++n) { f32x4* p = (f32x4*)(rowp + bj * 128 + n * 16); const f32x4 x = *p; *p = x + gv[bj][n] * acc[ai][bj][m][n]; } }
    }
};
struct EpiMerge {
    static constexpr bool PERM = true;
    bf16_t* MG; const float* bgate;
    unsigned char* scr;
    __device__ __forceinline__ void operator()(const f32x4 (&acc)[2][2][4][2], const Unit& u, int wr, int wc, int fr, int fq) const {
        const int tid = opaque_tid(), bi = u.kind >> 1;
        unsigned char* pbp = scr + tid * 16;
        unsigned char* pmp = scr + 131072 + tid * 16;
        if ((u.kind & 1) == 0) {
#pragma unroll
            for (int bj = 0; bj < 2; ++bj)
#pragma unroll
                for (int ai = 0; ai < 2; ++ai)
#pragma unroll
                    for (int m = 0; m < 4; ++m) { const f32x4 v0 = acc[ai][bj][m][0], v1 = acc[ai][bj][m][1];
                        u32x4 o; o.x = pk2(v0[0], v0[1]); o.y = pk2(v0[2], v0[3]); o.z = pk2(v1[0], v1[1]); o.w = pk2(v1[2], v1[3]);
                        *(u32x4*)pbp = o; pbp += 8192; asm volatile("" : "+v"(pbp)); }
        } else {
            const int row0 = u.pm * 256 + wr * 64 + fr, col0 = u.pn * 256 + wc * 32 + 8 * fq;
            const float* bg = bgate + bi * DM + col0;
            bf16_t* mgp = MG + (size_t)row0 * DM + col0;
#pragma unroll
            for (int bj = 0; bj < 2; ++bj) {
                const f32x4 b0 = *(const f32x4*)(bg + bj * 128), b1 = *(const f32x4*)(bg + bj * 128 + 4);
#pragma unroll
                for (int ai = 0; ai < 2; ++ai)
#pragma unroll
                    for (int m = 0; m < 4; ++m) {
                        const u32x4 pv = *(const u32x4*)pbp; pbp += 8192; asm volatile("" : "+v"(pbp));
                        const f32x4 a0 = acc[ai][bj][m][0] + b0, a1 = acc[ai][bj][m][1] + b1;
                        f32x4 r0, r1;
                        r0[0] = sigmoidf_(a0[0]) * bflo(pv.x); r0[1] = sigmoidf_(a0[1]) * bfhi(pv.x); r0[2] = sigmoidf_(a0[2]) * bflo(pv.y); r0[3] = sigmoidf_(a0[3]) * bfhi(pv.y);
                        r1[0] = sigmoidf_(a1[0]) * bflo(pv.z); r1[1] = sigmoidf_(a1[1]) * bfhi(pv.z); r1[2] = sigmoidf_(a1[2]) * bflo(pv.w); r1[3] = sigmoidf_(a1[3]) * bfhi(pv.w);
                        if (bi > 0) { r0 += *(const f32x4*)pmp; r1 += *(const f32x4*)(pmp + 8192); }
                        if (bi < 3) { *(f32x4*)pmp = r0; *(f32x4*)(pmp + 8192) = r1; }
                        else { u32x4 o; o.x = pk2(r0[0], r0[1]); o.y = pk2(r0[2], r0[3]); o.z = pk2(r1[0], r1[1]); o.w = pk2(r1[2], r1[3]);
                            bf16_t* q = mgp + (size_t)(ai * 128 + m * 16) * DM + bj * 128; asm volatile("" : "+v"(q));
                            *(u32x4*)q = o; }
                        pmp += 16384; asm volatile("" : "+v"(pmp)); }
            }
        }
    }
};

__device__ __forceinline__ void transpose_item(const float* W, int N, int k0, int n0, bf16_t* dst  , int ldwt, LAS float* scr, int lane) {
#pragma unroll 8
    for (int i = 0; i < 32; ++i) { const int kk = 2 * i + (lane >> 5); scr[kk * 33 + (lane & 31)] = W[(size_t)(k0 + kk) * N + n0 + (lane & 31)]; }
    __builtin_amdgcn_wave_barrier();
    const int c = lane & 7;
#pragma unroll
    for (int j = 0; j < 4; ++j) { const int n = (lane >> 3) + 8 * j; const LAS float* s = scr + (8 * c) * 33 + n;
        u32x4 o; o.x = pk2(s[0 * 33], s[1 * 33]); o.y = pk2(s[2 * 33], s[3 * 33]); o.z = pk2(s[4 * 33], s[5 * 33]); o.w = pk2(s[6 * 33], s[7 * 33]);
        *(u32x4*)(dst + (size_t)n * ldwt + 8 * c) = o; }
    __builtin_amdgcn_wave_barrier();
}

__device__ __forceinline__ void phase_prologue(const Params& p, LAS unsigned char* lds) {
    const int tid = opaque_tid(), lane = tid & 63, wave = tid >> 6;
    unsigned char* ws = p.ws;
    {
        LAS float* scr = (LAS float*)(lds + wave * 8704);
        const int gw = blockIdx.x * 8 + wave, NGW = gridDim.x * 8;
        constexpr int I_IN = 16 * (NIN / 32), I_G = 4 * 16 * 32, I_B = 4 * 4 * 32, I_O = 16 * 32, I_F = 16 * (DFF / 32), I_D = (DFF / 64) * 32;
        constexpr int PER_LAYER = I_IN + I_G + I_B + I_O + 2 * I_F + I_D;
        for (int it = gw; it < NLAYER * PER_LAYER; it += NGW) {
            const int l = it / PER_LAYER; int r = it % PER_LAYER;
            if (r < I_IN) { const int nb = r % (NIN / 32), kb = r / (NIN / 32);
                transpose_item(p.in[8] + (size_t)l * DM * NIN, NIN, 64 * kb, 32 * nb, (bf16_t*)(ws + OFF_WIN) + ((size_t)l * NIN + 32 * nb) * DM + 64 * kb, DM, scr, lane); continue; }
            r -= I_IN;
            if (r < I_G) { const int bi = r / 512, rr = r % 512, nb = rr % 32, kb = rr / 32;
                transpose_item(p.in[9] + ((size_t)l * 4 + bi) * DM * DM, DM, 64 * kb, 32 * nb, (bf16_t*)(ws + OFF_WG) + (((size_t)l * 4 + bi) * DM + 32 * nb) * DM + 64 * kb, DM, scr, lane); continue; }
            r -= I_G;
            if (r < I_B) { const int bi = r / 128, rr = r % 128, nb = rr % 32, kb = rr / 32;
                transpose_item(p.in[11] + ((size_t)l * 4 + bi) * 256 * DM, DM, 64 * kb, 32 * nb, (bf16_t*)(ws + OFF_WB) + ((size_t)l * DM + 32 * nb) * DM + bi * 256 + 64 * kb, DM, scr, lane); continue; }
            r -= I_B;
            if (r < I_O) { const int nb = r % 32, kb = r / 32;
                transpose_item(p.in[12] + (size_t)l * DM * DM, DM, 64 * kb, 32 * nb, (bf16_t*)(ws + OFF_WO) + ((size_t)l * DM + 32 * nb) * DM + 64 * kb, DM, scr, lane); continue; }
            r -= I_O;
            if (r < 2 * I_F) { const int which = r / I_F, rr = r % I_F, nb = rr % (DFF / 32), kb = rr / (DFF / 32);
                const int n0 = 32 * nb, row = (n0 >> 7) * 256 + (n0 & 127) + which * 128;
                transpose_item(p.in[which ? 21 : 20] + (size_t)l * DM * DFF, DFF, 64 * kb, n0, (bf16_t*)(ws + OFF_WGU) + ((size_t)l * 2 * DFF + row) * DM + 64 * kb, DM, scr, lane); continue; }
            r -= 2 * I_F;
            { const int nb = r % 32, kb = r / 32;
                transpose_item(p.in[22] + (size_t)l * DFF * DM, DM, 64 * kb, 32 * nb, (bf16_t*)(ws + OFF_WD) + ((size_t)l * DM + 32 * nb) * DFF + 64 * kb, DFF, scr, lane); }
        }
    }
    {
        const float* src = p.in[18]; bf16_t* dst = (bf16_t*)(ws + OFF_SGW);
        for (int i = blockIdx.x * NTHR + tid; i < NLAYER * 4 * 128 * 128 / 4; i += gridDim.x * NTHR) {
            const f32x4 v = *(const f32x4*)(src + 4 * (size_t)i); u32x2 o; o.x = pk2(v[0], v[1]); o.y = pk2(v[2], v[3]); *(u32x2*)(dst + 4 * (size_t)i) = o; }
    }
    __syncthreads();
    {
        LAS float* cs = (LAS float*)lds;
        float* modp = (float*)(ws + OFF_MODP);
        for (int it = blockIdx.x; it < NLAYER * 12 * 8; it += gridDim.x) {
            const int ks = it & 7, nb = (it >> 3) % 12, l = it / 96;
            __syncthreads();
            for (int e = tid; e < 128 * NB; e += NTHR) { const int kk = e / NB, b = e % NB;
                const float c = b < 16 ? p.in[2][b * DM + 128 * ks + kk] : p.in[3][(b - 16) * DM + 128 * ks + kk];
                cs[kk * NB + b] = siluf_(c); }
            __syncthreads();
            const int n = nb * 512 + tid;
            const float* w = p.in[4] + ((size_t)l * DM + 128 * ks) * 6144 + n;
            float a[NB];
#pragma unroll
            for (int b = 0; b < NB; ++b) a[b] = 0.f;
#pragma unroll 4
            for (int kk = 0; kk < 128; ++kk) { const float wv = w[(size_t)kk * 6144];
#pragma unroll
                for (int b4 = 0; b4 < NB / 4; ++b4) { const f32x4 c4 = *(const LAS f32x4*)(cs + kk * NB + 4 * b4);
                    a[4 * b4 + 0] += c4[0] * wv; a[4 * b4 + 1] += c4[1] * wv; a[4 * b4 + 2] += c4[2] * wv; a[4 * b4 + 3] += c4[3] * wv; } }
#pragma unroll
            for (int b = 0; b < NB; ++b) modp[(((size_t)ks * NB + b) * NLAYER + l) * 6144 + n] = a[b];
        }
    }
}
__device__ __forceinline__ void phase_mod_reduce(const Params& p) {
    const float* modp = (const float*)(p.ws + OFF_MODP); float* mod = (float*)(p.ws + OFF_MOD);
    constexpr int NMOD = NB * NLAYER * 6144;
    for (int i = blockIdx.x * NTHR + opaque_tid(); i < NMOD; i += gridDim.x * NTHR) {
        const int n = i % 6144, l = (i / 6144) % NLAYER;
        float s = p.in[5][l * 6144 + n];
#pragma unroll
        for (int ks = 0; ks < 8; ++ks) s += modp[(size_t)ks * NMOD + i];
        mod[i] = s;
    }
}

__device__ __forceinline__ void phase_norm_mod(const float* xsrc, float* copy_to, bf16_t* H, const float* g, const float* mod_sh, const float* mod_sc, int L, int bbase) {
    const int tid = opaque_tid(), lane = tid & 63, gw = blockIdx.x * 8 + (tid >> 6), NGW = gridDim.x * 8;
    for (int row = gw; row < TC; row += NGW) {
        const int b = bbase + row / L;
        const f32x4* xr = (const f32x4*)(xsrc + (size_t)row * DM) + lane;
        f32x4 v[4]; float s = 0.f;
#pragma unroll
        for (int j = 0; j < 4; ++j) { v[j] = xr[64 * j]; s += (v[j][0] * v[j][0] + v[j][1] * v[j][1]) + (v[j][2] * v[j][2] + v[j][3] * v[j][3]); }
        const float rstd = rsqrtf(wave_sum(s) * (1.f / DM) + EPSV);
        if (copy_to) { f32x4* cr = (f32x4*)(copy_to + (size_t)row * DM) + lane;
#pragma unroll
            for (int j = 0; j < 4; ++j) cr[64 * j] = v[j]; }
        const f32x4* gr = (const f32x4*)g + lane;
        const f32x4* shr = (const f32x4*)(mod_sh + (size_t)b * (NLAYER * 6144)) + lane;
        const f32x4* scr = (const f32x4*)(mod_sc + (size_t)b * (NLAYER * 6144)) + lane;
        u32x2* o = (u32x2*)(H + (size_t)row * DM) + lane;
#pragma unroll
        for (int j = 0; j < 4; ++j) { const f32x4 gg = gr[64 * j], sh = shr[64 * j], sc = scr[64 * j];
            const f32x4 y = v[j] * rstd * gg * (sc + 1.f) + sh;
            u32x2 w; w.x = pk2(y[0], y[1]); w.y = pk2(y[2], y[3]); o[64 * j] = w; }
    }
}
__device__ __forceinline__ void phase_final_norm(float* X, const float* g) {
    const int tid = opaque_tid(), lane = tid & 63, gw = blockIdx.x * 8 + (tid >> 6), NGW = gridDim.x * 8;
    for (int row = gw; row < TC; row += NGW) {
        f32x4* xr = (f32x4*)(X + (size_t)row * DM) + lane;
        f32x4 v[4]; float s = 0.f;
#pragma unroll
        for (int j = 0; j < 4; ++j) { v[j] = xr[64 * j]; s += (v[j][0] * v[j][0] + v[j][1] * v[j][1]) + (v[j][2] * v[j][2] + v[j][3] * v[j][3]); }
        const float rstd = rsqrtf(wave_sum(s) * (1.f / DM) + EPSV);
        const f32x4* gr = (const f32x4*)g + lane;
#pragma unroll
        for (int j = 0; j < 4; ++j) xr[64 * j] = v[j] * rstd * gr[64 * j];
    }
}

struct AttnState { f32x4 o[4]; float m, l; };
constexpr int VT_LD = 40;
constexpr int VT_BYTES = 64 * VT_LD * 2;
template <class TokOfKey>
__device__ __forceinline__ void attn_stage_v(LAS bf16_t* vt, const bf16_t* P, int vcol, int lane, const TokOfKey& tok_of_key) {
#pragma unroll
    for (int i = 0; i < 4; ++i) { const int pc = lane + 64 * i, key = pc >> 3, ch = pc & 7;
        const u32x4 v = *(const u32x4*)(P + (size_t)tok_of_key(key) * NIN + vcol + 8 * ch);
        const int slot = 8 * ((key & 15) >> 2) + 4 * (key >> 4) + (key & 3);
        LAS bf16_t* d = vt + ch * VT_LD + slot;
        d[0 * 8 * VT_LD] = (bf16_t)(v.x & 0xffffu); d[1 * 8 * VT_LD] = (bf16_t)(v.x >> 16);
        d[2 * 8 * VT_LD] = (bf16_t)(v.y & 0xffffu); d[3 * 8 * VT_LD] = (bf16_t)(v.y >> 16);
        d[4 * 8 * VT_LD] = (bf16_t)(v.z & 0xffffu); d[5 * 8 * VT_LD] = (bf16_t)(v.z >> 16);
        d[6 * 8 * VT_LD] = (bf16_t)(v.w & 0xffffu); d[7 * 8 * VT_LD] = (bf16_t)(v.w >> 16); }
}
__device__ __forceinline__ void attn_update(AttnState& st, const float (&s)[2][4], const bool (&valid)[2][4], LAS bf16_t* vt, int fr, int fq) {
    float mx = fmaxf(fmaxf(fmaxf(s[0][0], s[0][1]), fmaxf(s[0][2], s[0][3])), fmaxf(fmaxf(s[1][0], s[1][1]), fmaxf(s[1][2], s[1][3])));
    mx = fmaxf(mx, __shfl_xor(mx, 16)); mx = fmaxf(mx, __shfl_xor(mx, 32));
    const float mn = fmaxf(st.m, mx), alpha = __expf(st.m - mn);
    float pv[2][4]; float ps = 0.f;
#pragma unroll
    for (int t = 0; t < 2; ++t)
#pragma unroll
        for (int r = 0; r < 4; ++r) { pv[t][r] = valid[t][r] ? __expf(s[t][r] - mn) : 0.f; ps += pv[t][r]; }
    st.m = mn; st.l = st.l * alpha + ps;
    union { bf16x8 v; unsigned u[4]; } pf;
    pf.u[0] = pk2(pv[0][0], pv[0][1]); pf.u[1] = pk2(pv[0][2], pv[0][3]); pf.u[2] = pk2(pv[1][0], pv[1][1]); pf.u[3] = pk2(pv[1][2], pv[1][3]);
    __builtin_amdgcn_wave_barrier();
#pragma unroll
    for (int dt = 0; dt < 4; ++dt) {
        const bf16x8 vf = *(const LAS bf16x8*)(vt + ((fr & 7) * 8 + 2 * dt + (fr >> 3)) * VT_LD + 8 * fq);
        st.o[dt] = st.o[dt] * alpha;
        st.o[dt] = MFMA16(vf, pf.v, st.o[dt]);
    }
    __builtin_amdgcn_wave_barrier();
}

__device__ __forceinline__ void na_item(int item, const bf16_t* P, bf16_t* BR, const float* rpb  , int L, LAS unsigned char* lds) {
    const int tid = opaque_tid(), lane = tid & 63, wave = tid >> 6, fr = lane & 15, fq = lane >> 4;
    const int rr = item >> 1, h = (item & 1) * 2 + (wave >> 2), n = wave & 3;
    const int rows = L >> 6, seq = rr / rows, r = rr % rows, seqbase = seq * L;
    const int r0 = min(max(r - 4, 0), rows - 8);
    LAS bf16_t* vt = (LAS bf16_t*)(lds + wave * VT_BYTES);
    const int qtok = seqbase + r * 64 + 16 * n + fr;
    bf16x8 qf[2];
#pragma unroll
    for (int ks = 0; ks < 2; ++ks) qf[ks] = *(const bf16x8*)(P + (size_t)qtok * NIN + P_NAQ + 64 * h + 32 * ks + 8 * fq);
    const int col0 = min(max(16 * n - 8, 0), 32), qcol = 16 * n + fr, win0 = min(max(qcol - 8, 0), 48);
    AttnState st;
#pragma unroll
    for (int dt = 0; dt < 4; ++dt) st.o[dt] = (f32x4){0.f, 0.f, 0.f, 0.f};
    st.m = -1e30f; st.l = 0.f;
    const float* rp = rpb + h * (15 * 31);
    for (int kr = 0; kr < 8; ++kr) {
        const int krow = r0 + kr, rowtok = seqbase + krow * 64 + col0;
        attn_stage_v(vt, P, P_NAV + 64 * h, lane, [&](int key) { return rowtok + key; });
        f32x4 sacc[2];
#pragma unroll
        for (int t = 0; t < 2; ++t) { sacc[t] = (f32x4){0.f, 0.f, 0.f, 0.f};
#pragma unroll
            for (int ks = 0; ks < 2; ++ks) { const bf16x8 kf = *(const bf16x8*)(P + (size_t)(rowtok + 16 * t + fr) * NIN + P_NAK + 64 * h + 32 * ks + 8 * fq);
                sacc[t] = MFMA16(kf, qf[ks], sacc[t]); } }
        const float* rrow = rp + (krow - r + 7) * 31;
        float s[2][4]; bool valid[2][4];
#pragma unroll
        for (int t = 0; t < 2; ++t)
#pragma unroll
            for (int g = 0; g < 4; ++g) { const int kc = col0 + 16 * t + 4 * fq + g; const bool v = (kc >= win0) && (kc < win0 + 16);
                const int ci = min(max(kc - qcol + 15, 0), 30);
                valid[t][g] = v; s[t][g] = v ? sacc[t][g] * 0.125f + rrow[ci] : -1e30f; }
        attn_update(st, s, valid, vt, fr, fq);
    }
    float l = st.l; l += __shfl_xor(l, 16); l += __shfl_xor(l, 32);
    const float inv = 1.f / l;
    bf16_t* orow = BR + (size_t)qtok * DM + 0 + 64 * h + 4 * fq;
#pragma unroll
    for (int dt = 0; dt < 4; ++dt) { u32x2 o; o.x = pk2(st.o[dt][0] * inv, st.o[dt][1] * inv); o.y = pk2(st.o[dt][2] * inv, st.o[dt][3] * inv); *(u32x2*)(orow + 16 * dt) = o; }
}

constexpr int DL_OLD = 68;
constexpr int DL_O_OFF = 8 * VT_BYTES;
constexpr int DL_M_OFF = DL_O_OFF + 256 * DL_OLD * 4;
constexpr int DL_L_OFF = DL_M_OFF + 1024;
__device__ __forceinline__ void dl_item(int item, const bf16_t* P, bf16_t* BR, int L, LAS unsigned char* lds) {
    const int tid = opaque_tid(), lane = tid & 63, wave = tid >> 6, fr = lane & 15, fq = lane >> 4;
    const int sp = item >> 2, h = item & 3;
    const int t0 = sp * 256, seq = t0 / L, seqbase = seq * L, p0 = t0 - seqbase;
    LAS bf16_t* vt = (LAS bf16_t*)(lds + wave * VT_BYTES);
    LAS float* OL = (LAS float*)(lds + DL_O_OFF); LAS float* ML = (LAS float*)(lds + DL_M_OFF); LAS float* LL = (LAS float*)(lds + DL_L_OFF);
    __syncthreads();
    for (int e = tid; e < 256 * DL_OLD; e += NTHR) OL[e] = 0.f;
    if (tid < 256) { ML[tid] = -1e30f; LL[tid] = 0.f; }
    __syncthreads();
    const float slope = (h == 0) ? 0.25f : (h == 1) ? 0.0625f : (h == 2) ? 0.015625f : 0.00390625f;
    for (int cfg = 0; cfg < 3; ++cfg) {
        const int dsh = 2 * cfg, dil = 1 << dsh, n = L >> dsh;
        for (int qi = 0; qi < 2; ++qi) {
            const int qt = 2 * wave + qi;
            const int r = (cfg == 0) ? 0 : (cfg == 1) ? (qt >> 2) : qt;
            const int sub = (cfg == 0) ? qt : (cfg == 1) ? (qt & 3) : 0;
            const int j0 = (p0 >> dsh) + 16 * sub, qj = j0 + fr;
            const int qtok = seqbase + (qj << dsh) + r;
            bf16x8 qf[2];
#pragma unroll
            for (int ks = 0; ks < 2; ++ks) qf[ks] = *(const bf16x8*)(P + (size_t)qtok * NIN + P_DQ + 64 * h + 32 * ks + 8 * fq);
            AttnState st;
#pragma unroll
            for (int dt = 0; dt < 4; ++dt) st.o[dt] = (f32x4){0.f, 0.f, 0.f, 0.f};
            st.m = -1e30f; st.l = 0.f;
            for (int sx = 0; sx < 5; ++sx) {
                const int kb = j0 - 64 + 32 * sx;
                if (kb + 32 <= 0 || kb >= n) continue;
                attn_stage_v(vt, P, P_DV + 64 * h, lane, [&](int key) { const int kj = min(max(kb + key, 0), n - 1); return seqbase + (kj << dsh) + r; });
                f32x4 sacc[2];
#pragma unroll
                for (int t = 0; t < 2; ++t) { sacc[t] = (f32x4){0.f, 0.f, 0.f, 0.f};
                    const int kj = min(max(kb + 16 * t + fr, 0), n - 1); const int ktok = seqbase + (kj << dsh) + r;
#pragma unroll
                    for (int ks = 0; ks < 2; ++ks) { const bf16x8 kf = *(const bf16x8*)(P + (size_t)ktok * NIN + P_DK + 64 * h + 32 * ks + 8 * fq);
                        sacc[t] = MFMA16(kf, qf[ks], sacc[t]); } }
                float s[2][4]; bool valid[2][4];
#pragma unroll
                for (int t = 0; t < 2; ++t)
#pragma unroll
                    for (int g = 0; g < 4; ++g) { const int kj = kb + 16 * t + 4 * fq + g; const int dist = abs(kj - qj);
                        const bool v = (dist <= 64) && (kj >= 0) && (kj < n);
                        valid[t][g] = v; s[t][g] = v ? sacc[t][g] * 0.125f - slope * (float)(dist << dsh) : -1e30f; }
                attn_update(st, s, valid, vt, fr, fq);
            }
            float l = st.l; l += __shfl_xor(l, 16); l += __shfl_xor(l, 32);
            const int ql = ((16 * sub + fr) << dsh) + r;
            const float mo = ML[ql], lo = LL[ql], mn = fmaxf(mo, st.m), a = __expf(mo - mn), b = __expf(st.m - mn);
            LAS float* orow = OL + ql * DL_OLD + 4 * fq;
#pragma unroll
            for (int dt = 0; dt < 4; ++dt) { f32x4 ov = *(LAS f32x4*)(orow + 16 * dt); ov = ov * a + st.o[dt] * b; *(LAS f32x4*)(orow + 16 * dt) = ov; }
            __builtin_amdgcn_wave_barrier();
            if (fq == 0) { ML[ql] = mn; LL[ql] = lo * a + l * b; }
        }
        __syncthreads();
    }
    for (int e = tid; e < 256 * 8; e += NTHR) { const int ql = e >> 3, c8 = e & 7;
        const float inv = 1.f / LL[ql]; const LAS float* orow = OL + ql * DL_OLD + 8 * c8;
        const f32x4 a = *(const LAS f32x4*)orow, b = *(const LAS f32x4*)(orow + 4);
        u32x4 o; o.x = pk2(a[0] * inv, a[1] * inv); o.y = pk2(a[2] * inv, a[3] * inv); o.z = pk2(b[0] * inv, b[1] * inv); o.w = pk2(b[2] * inv, b[3] * inv);
        *(u32x4*)(BR + (size_t)(t0 + ql) * DM + 768 + 64 * h + 8 * c8) = o; }
}

constexpr int SG_WLD = 136, SG_VLD = 136;
constexpr int SG_V_OFF = 128 * SG_WLD * 2;
__device__ __forceinline__ void sg_item(int item, const bf16_t* P, bf16_t* BR, const bf16_t* sgw  , const float* ln_g, const float* ln_b, const float* sgb  , LAS unsigned char* lds) {
    const int tid = opaque_tid(), lane = tid & 63, wave = tid >> 6, fr = lane & 15, fq = lane >> 4;
    const int nc = item >> 2, g = item & 3, t0 = nc * 128;
    LAS bf16_t* WL = (LAS bf16_t*)lds; LAS bf16_t* VT = (LAS bf16_t*)(lds + SG_V_OFF);
    __syncthreads();
    for (int e = tid; e < 128 * 16; e += NTHR) { const int row = e >> 4, c8 = e & 15;
        *(LAS u32x4*)(WL + row * SG_WLD + 8 * c8) = *(const u32x4*)(sgw + ((size_t)g * 128 + row) * 128 + 8 * c8); }
    {
        const int s = tid >> 2, qd = tid & 3;
        const bf16_t* vp = P + (size_t)(t0 + s) * NIN + P_SV + 64 * qd;
        float sum = 0.f, sq = 0.f;
#pragma unroll
        for (int i = 0; i < 8; ++i) { const u32x4 w = *(const u32x4*)(vp + 8 * i);
            const unsigned ww[4] = {w.x, w.y, w.z, w.w};
#pragma unroll
            for (int j = 0; j < 4; ++j) { const float a = gelu_tanh(bflo(ww[j])), b = gelu_tanh(bfhi(ww[j])); sum += a + b; sq += a * a + b * b; } }
        sum += __shfl_xor(sum, 1); sum += __shfl_xor(sum, 2); sq += __shfl_xor(sq, 1); sq += __shfl_xor(sq, 2);
        const float mean = sum * (1.f / 256.f), var = fmaxf(sq * (1.f / 256.f) - mean * mean, 0.f), rstd = rsqrtf(var + EPSV);
        const bf16_t* gp = P + (size_t)(t0 + s) * NIN + P_SV + 64 * g + 16 * qd;
#pragma unroll
        for (int i = 0; i < 2; ++i) { const u32x4 w = *(const u32x4*)(gp + 8 * i);
            const unsigned ww[4] = {w.x, w.y, w.z, w.w};
#pragma unroll
            for (int j = 0; j < 4; ++j) {
                const int c = 16 * qd + 8 * i + 2 * j, ch = 64 * g + c;
                const float a = (gelu_tanh(bflo(ww[j])) - mean) * rstd * ln_g[ch] + ln_b[ch], b = (gelu_tanh(bfhi(ww[j])) - mean) * rstd * ln_g[ch + 1] + ln_b[ch + 1];
                VT[c * SG_VLD + s] = f2bf(a); VT[(c + 1) * SG_VLD + s] = f2bf(b); } }
    }
    __syncthreads();
    f32x4 acc[4];
#pragma unroll
    for (int ni = 0; ni < 4; ++ni) acc[ni] = (f32x4){0.f, 0.f, 0.f, 0.f};
#pragma unroll
    for (int ks = 0; ks < 4; ++ks) { const bf16x8 a = *(const LAS bf16x8*)(WL + (16 * wave + fr) * SG_WLD + 32 * ks + 8 * fq);
#pragma unroll
        for (int ni = 0; ni < 4; ++ni) { const bf16x8 b = *(const LAS bf16x8*)(VT + (16 * ni + fr) * SG_VLD + 32 * ks + 8 * fq); acc[ni] = MFMA16(a, b, acc[ni]); } }
#pragma unroll
    for (int reg = 0; reg < 4; ++reg) { const int t = 16 * wave + 4 * fq + reg; const float bs = sgb[g * 128 + t];
        const bf16_t* up = P + (size_t)(t0 + t) * NIN + P_SU + 64 * g; bf16_t* op = BR + (size_t)(t0 + t) * DM + 512 + 64 * g;
#pragma unroll
        for (int ni = 0; ni < 4; ++ni) { const int c = 16 * ni + fr; const float u = gelu_tanh(bf2f(up[c])); op[c] = f2bf(u * (acc[ni][reg] + bs)); } }
}

constexpr int HG_LF_OFF = 0;
constexpr int HG_T_OFF = 32768;
constexpr int HG_TLD = 72, HG_TB = 64 * HG_TLD * 2;
__device__ __forceinline__ float hg_lb(const float* hg_lb_in, int dir, int l, int ch) {
    const float* q = hg_lb_in + (size_t)dir * NLAYER * 256 + ch;
    const float a0 = q[0], a1 = q[256], a2 = q[512], a3 = q[768];
    const float mx = fmaxf(fmaxf(a0, a1), fmaxf(a2, a3));
    const float e0 = __expf(a0 - mx), e1 = __expf(a1 - mx), e2 = __expf(a2 - mx), e3 = __expf(a3 - mx);
    const float num = (l >= 1 ? e1 : 0.f) + (l >= 2 ? e2 : 0.f) + (l >= 3 ? e3 : 0.f);
    return num / (e0 + e1 + e2 + e3);
}
__device__ __forceinline__ void hg_front(const bf16_t* P, int t0, int h, int l, const float* hg_lb_in, LAS unsigned char* lds) {
    const int tid = opaque_tid();
    LAS float* LF = (LAS float*)(lds + HG_LF_OFF);
    {
        const int s = tid >> 3, i0 = 8 * (tid & 7);
#pragma unroll
        for (int dir = 0; dir < 2; ++dir) {
            const u32x4 w = *(const u32x4*)(P + (size_t)(t0 + s) * NIN + (dir ? P_FB : P_FF) + 64 * h + i0);
            const unsigned ww[4] = {w.x, w.y, w.z, w.w};
#pragma unroll
            for (int j = 0; j < 4; ++j) {
                const float lb0 = hg_lb(hg_lb_in, dir, l, 64 * h + i0 + 2 * j), lb1 = hg_lb(hg_lb_in, dir, l, 64 * h + i0 + 2 * j + 1);
                const float f0 = lb0 + (1.f - lb0) * sigmoidf_(bflo(ww[j])), f1 = lb1 + (1.f - lb1) * sigmoidf_(bfhi(ww[j]));
                LF[dir * 4096 + s * 64 + i0 + 2 * j] = __logf(f0); LF[dir * 4096 + s * 64 + i0 + 2 * j + 1] = __logf(f1); }
        }
    }
    __syncthreads();
    if (tid < 128) { const int dir = tid >> 6, i = tid & 63; LAS float* a = LF + dir * 4096 + i; float run = 0.f;
        if (dir == 0) { for (int s = 0; s < 64; ++s) { run += a[s * 64]; a[s * 64] = run; } }
        else { for (int s = 63; s >= 0; --s) { run += a[s * 64]; a[s * 64] = run; } } }
    __syncthreads();
}
__device__ __forceinline__ float hg_kk(const float* hg_lb_in, int dir, int l, int ch, float x) { const float lb = hg_lb(hg_lb_in, dir, l, ch); return (1.f - lb) * sigmoidf_(-x); }

__device__ __forceinline__ void hgA_item(int item, const bf16_t* P, float* HGST, float* HGD, int l, const float* hg_lb_in, LAS unsigned char* lds) {
    const int tid = opaque_tid(), lane = tid & 63, wave = tid >> 6, fr = lane & 15, fq = lane >> 4;
    const int cc = item >> 2, h = item & 3, t0 = cc * 64;
    __syncthreads();
    hg_front(P, t0, h, l, hg_lb_in, lds);
    LAS float* LF = (LAS float*)(lds + HG_LF_OFF);
    LAS bf16_t* KD0 = (LAS bf16_t*)(lds + HG_T_OFF); LAS bf16_t* KD1 = (LAS bf16_t*)(lds + HG_T_OFF + HG_TB); LAS bf16_t* VT = (LAS bf16_t*)(lds + HG_T_OFF + 2 * HG_TB);
    {
        const int s = tid >> 3, i0 = 8 * (tid & 7);
#pragma unroll
        for (int dir = 0; dir < 2; ++dir) {
            const u32x4 w = *(const u32x4*)(P + (size_t)(t0 + s) * NIN + (dir ? P_FB : P_FF) + 64 * h + i0);
            const unsigned ww[4] = {w.x, w.y, w.z, w.w};
            LAS bf16_t* KD = dir ? KD1 : KD0; const LAS float* A = LF + dir * 4096; const int slast = dir ? 0 : 63;
#pragma unroll
            for (int j = 0; j < 8; ++j) { const int i = i0 + j; const float x = (j & 1) ? bfhi(ww[j >> 1]) : bflo(ww[j >> 1]);
                const float kd = hg_kk(hg_lb_in, dir, l, 64 * h + i, x) * __expf(A[slast * 64 + i] - A[s * 64 + i]);
                KD[i * HG_TLD + s] = f2bf(kd); }
        }
        const u32x4 w = *(const u32x4*)(P + (size_t)(t0 + s) * NIN + P_HI + 64 * h + i0);
        const unsigned ww[4] = {w.x, w.y, w.z, w.w};
#pragma unroll
        for (int j = 0; j < 8; ++j) VT[(i0 + j) * HG_TLD + s] = (bf16_t)((j & 1) ? (ww[j >> 1] >> 16) : (ww[j >> 1] & 0xffffu));
        if (tid < 128) { const int dir = tid >> 6, i = tid & 63; HGD[((size_t)(cc * 4 + h) * 2 + dir) * 64 + i] = __expf(LF[dir * 4096 + (dir ? 0 : 63) * 64 + i]); }
    }
    __syncthreads();
    {
        const int dir = wave >> 2, mt = wave & 3; const LAS bf16_t* KD = dir ? KD1 : KD0;
        f32x4 acc[4];
#pragma unroll
        for (int ni = 0; ni < 4; ++ni) acc[ni] = (f32x4){0.f, 0.f, 0.f, 0.f};
#pragma unroll
        for (int ks = 0; ks < 2; ++ks) { const bf16x8 a = *(const LAS bf16x8*)(VT + (16 * mt + fr) * HG_TLD + 32 * ks + 8 * fq);
#pragma unroll
            for (int ni = 0; ni < 4; ++ni) { const bf16x8 b = *(const LAS bf16x8*)(KD + (16 * ni + fr) * HG_TLD + 32 * ks + 8 * fq); acc[ni] = MFMA16(a, b, acc[ni]); } }
        float* dst = HGST + ((size_t)(cc * 4 + h) * 2 + dir) * 4096;
#pragma unroll
        for (int ni = 0; ni < 4; ++ni)
#pragma unroll
            for (int reg = 0; reg < 4; ++reg) dst[(16 * mt + 4 * fq + reg) * 64 + 16 * ni + fr] = acc[ni][reg];
    }
}
__device__ __forceinline__ void hgB_phase(float* HGST, const float* HGD, int L) {
    const int ncs = L >> 6, nseq = TC / L, total = nseq * 8 * 4096;
    for (int e = blockIdx.x * NTHR + opaque_tid(); e < total; e += gridDim.x * NTHR) {
        const int ji = e & 4095, dir = (e >> 12) & 1, h = (e >> 13) & 3, seq = e >> 15, i = ji & 63;
        float S = 0.f;
        for (int c = 0; c < ncs; ++c) { const int cc = seq * ncs + (dir ? (ncs - 1 - c) : c);
            const size_t o = ((size_t)(cc * 4 + h) * 2 + dir);
            const float u = HGST[o * 4096 + ji], d = HGD[o * 64 + i];
            HGST[o * 4096 + ji] = S; S = S * d + u; }
    }
}
__device__ __forceinline__ void hgC_item(int item, const bf16_t* P, bf16_t* BR, const float* HGST, int l, const float* hg_lb_in, const float* gnorm  , LAS unsigned char* lds) {
    const int tid = opaque_tid(), lane = tid & 63, wave = tid >> 6, fr = lane & 15, fq = lane >> 4;
    const int cc = item >> 2, h = item & 3, t0 = cc * 64;
    __syncthreads();
    hg_front(P, t0, h, l, hg_lb_in, lds);
    LAS float* LF = (LAS float*)(lds + HG_LF_OFF);
#define HGT(k) ((LAS bf16_t*)(lds + HG_T_OFF + (k) * HG_TB))
    {
        const int s = tid >> 3, i0 = 8 * (tid & 7);
        const u32x4 wq = *(const u32x4*)(P + (size_t)(t0 + s) * NIN + P_HQ + 64 * h + i0);
        const unsigned wqq[4] = {wq.x, wq.y, wq.z, wq.w};
#pragma unroll
        for (int dir = 0; dir < 2; ++dir) {
            const u32x4 w = *(const u32x4*)(P + (size_t)(t0 + s) * NIN + (dir ? P_FB : P_FF) + 64 * h + i0);
            const unsigned ww[4] = {w.x, w.y, w.z, w.w};
            const LAS float* A = LF + dir * 4096;
            u32x4 oq, ok, oe; unsigned* oqp = (unsigned*)&oq; unsigned* okp = (unsigned*)&ok; unsigned* oep = (unsigned*)&oe;
#pragma unroll
            for (int j2 = 0; j2 < 4; ++j2) { float qt[2], kt[2], qe[2];
#pragma unroll
                for (int e = 0; e < 2; ++e) { const int i = i0 + 2 * j2 + e; const float x = e ? bfhi(ww[j2]) : bflo(ww[j2]); const float qs = siluf_(e ? bfhi(wqq[j2]) : bflo(wqq[j2]));
                    const float a = A[s * 64 + i], ref = A[32 * 64 + i];
                    const float d1 = fminf(fmaxf(a - ref, -80.f), 80.f);
                    qt[e] = qs * __expf(d1); kt[e] = hg_kk(hg_lb_in, dir, l, 64 * h + i, x) * __expf(-d1); qe[e] = qs * __expf(a); }
                oqp[j2] = pk2(qt[0], qt[1]); okp[j2] = pk2(kt[0], kt[1]); oep[j2] = pk2(qe[0], qe[1]); }
            *(LAS u32x4*)(HGT(0 + dir) + s * HG_TLD + i0) = oq; *(LAS u32x4*)(HGT(2 + dir) + s * HG_TLD + i0) = ok; *(LAS u32x4*)(HGT(4 + dir) + s * HG_TLD + i0) = oe;
        }
        const u32x4 w = *(const u32x4*)(P + (size_t)(t0 + s) * NIN + P_HI + 64 * h + i0);
        const unsigned ww[4] = {w.x, w.y, w.z, w.w};
        LAS bf16_t* VT = HGT(6);
#pragma unroll
        for (int j = 0; j < 8; ++j) VT[(i0 + j) * HG_TLD + s] = (bf16_t)((j & 1) ? (ww[j >> 1] >> 16) : (ww[j >> 1] & 0xffffu));
        { const int dir = tid >> 8, j = (tid >> 2) & 63, i4 = 16 * (tid & 3);
          const float* src = HGST + ((size_t)(cc * 4 + h) * 2 + dir) * 4096 + j * 64 + i4; LAS bf16_t* dstp = HGT(8 + dir) + j * HG_TLD + i4;
#pragma unroll
          for (int q = 0; q < 2; ++q) { const f32x4 a = *(const f32x4*)(src + 8 * q), b = *(const f32x4*)(src + 8 * q + 4);
              u32x4 o; o.x = pk2(a[0], a[1]); o.y = pk2(a[2], a[3]); o.z = pk2(b[0], b[1]); o.w = pk2(b[2], b[3]); *(LAS u32x4*)(dstp + 8 * q) = o; } }
    }
    __syncthreads();
    {
        const int mt = wave >> 1;
#pragma unroll
        for (int q = 0; q < 2; ++q) { const int nt = 2 * (wave & 1) + q;
            f32x4 af = (f32x4){0.f, 0.f, 0.f, 0.f}, ab = (f32x4){0.f, 0.f, 0.f, 0.f};
            if (nt <= mt) {
#pragma unroll
                for (int ks = 0; ks < 2; ++ks) af = MFMA16(*(const LAS bf16x8*)(HGT(0) + (16 * mt + fr) * HG_TLD + 32 * ks + 8 * fq), *(const LAS bf16x8*)(HGT(2) + (16 * nt + fr) * HG_TLD + 32 * ks + 8 * fq), af); }
            if (nt >= mt) {
#pragma unroll
                for (int ks = 0; ks < 2; ++ks) ab = MFMA16(*(const LAS bf16x8*)(HGT(1) + (16 * mt + fr) * HG_TLD + 32 * ks + 8 * fq), *(const LAS bf16x8*)(HGT(3) + (16 * nt + fr) * HG_TLD + 32 * ks + 8 * fq), ab); }
            const int s = 16 * nt + fr;
#pragma unroll
            for (int reg = 0; reg < 4; ++reg) { const int t = 16 * mt + 4 * fq + reg;
                const float v = ((s <= t) ? af[reg] : 0.f) + ((s >= t) ? ab[reg] : 0.f);
                HGT(7)[t * HG_TLD + s] = f2bf(v); } }
    }
    __syncthreads();
    if (wave < 4) {
        const int mt = wave;
        f32x4 acc[4];
#pragma unroll
        for (int ni = 0; ni < 4; ++ni) acc[ni] = (f32x4){0.f, 0.f, 0.f, 0.f};
#pragma unroll
        for (int pr = 0; pr < 3; ++pr) { const LAS bf16_t* Am = (pr == 0) ? HGT(7) : (pr == 1) ? HGT(4) : HGT(5); const LAS bf16_t* Bm = (pr == 0) ? HGT(6) : (pr == 1) ? HGT(8) : HGT(9);
#pragma unroll
            for (int ks = 0; ks < 2; ++ks) { const bf16x8 a = *(const LAS bf16x8*)(Am + (16 * mt + fr) * HG_TLD + 32 * ks + 8 * fq);
#pragma unroll
                for (int ni = 0; ni < 4; ++ni) acc[ni] = MFMA16(a, *(const LAS bf16x8*)(Bm + (16 * ni + fr) * HG_TLD + 32 * ks + 8 * fq), acc[ni]); } }
#pragma unroll
        for (int reg = 0; reg < 4; ++reg) { const int t = 16 * mt + 4 * fq + reg;
            float ss = acc[0][reg] * acc[0][reg] + acc[1][reg] * acc[1][reg] + acc[2][reg] * acc[2][reg] + acc[3][reg] * acc[3][reg];
            ss += __shfl_xor(ss, 1); ss += __shfl_xor(ss, 2); ss += __shfl_xor(ss, 4); ss += __shfl_xor(ss, 8);
            const float rn = rsqrtf(ss * (1.f / 64.f) + EPSV);
            const bf16_t* gp = P + (size_t)(t0 + t) * NIN + P_HGATE + 64 * h; bf16_t* op = BR + (size_t)(t0 + t) * DM + 256 + 64 * h;
#pragma unroll
            for (int ni = 0; ni < 4; ++ni) { const int j = 16 * ni + fr; op[j] = f2bf(acc[ni][reg] * rn * gnorm[64 * h + j] * siluf_(bf2f(gp[j]))); } }
    }
#undef HGT
}

#define XB_TMO      128
#define XB_XCNT(j)  (256  + 64 * (j))
#define XB_XSUB(j)  (1280 + 64 * (j))
#define XB_XGEN(j)  (2304 + 64 * (j))
#define XB_TOP      3328
#define XB_TOPGEN   3392
#define XCD_BAR_WORDS 3456
#define XB_SPIN_CAP (1u << 22)
__device__ __forceinline__ unsigned xb_ld(unsigned* p)              { return __hip_atomic_load(p, __ATOMIC_RELAXED, __HIP_MEMORY_SCOPE_AGENT); }
__device__ __forceinline__ unsigned xb_add(unsigned* p, unsigned v) { return __hip_atomic_fetch_add(p, v, __ATOMIC_RELAXED, __HIP_MEMORY_SCOPE_AGENT); }
__device__ __forceinline__ unsigned xb_xcc_id() { return (unsigned)__builtin_amdgcn_s_getreg((3 << 11) | 20) & 0xFu; }
#define XB_SPIN(cond, bar) do { unsigned _sp = 0; while (cond) { __builtin_amdgcn_s_sleep(1); \
    if ((++_sp & 255u) == 0u) { if (xb_ld(&(bar)[XB_TMO])) break; if (_sp > XB_SPIN_CAP) { atomicAdd(&(bar)[XB_TMO], 1u); break; } } } } while (0)
struct XcdBarrier { unsigned* bar; unsigned x; volatile LAS unsigned* st; };
__device__ __forceinline__ XcdBarrier xcd_barrier_post(unsigned* bar, volatile LAS unsigned* st) {
    XcdBarrier b; b.bar = bar; b.x = xb_xcc_id(); b.st = st;
    if (threadIdx.x == 0) (void)xb_add(&bar[XB_XCNT(b.x)], 1u);
    return b;
}
__device__ __forceinline__ void xcd_barrier_complete(unsigned* bar, unsigned x, unsigned& nloc, unsigned& nx) {
    const unsigned G = gridDim.x * gridDim.y * gridDim.z;
    unsigned sum, cnt, mine, sp = 0u;
    for (;;) {
        sum = 0u; cnt = 0u; mine = 0u;
#pragma unroll
        for (unsigned j = 0; j < 16; ++j) { const unsigned c = xb_ld(&bar[XB_XCNT(j)]); sum += c; cnt += (c > 0u) ? 1u : 0u; mine = (j == x) ? c : mine; }
        if (sum == G) break;
        __builtin_amdgcn_s_sleep(1);
        if ((++sp & 255u) == 0u) { if (xb_ld(&bar[XB_TMO])) break; if (sp > XB_SPIN_CAP) { atomicAdd(&bar[XB_TMO], 1u); break; } }
    }
    nloc = mine > 0u ? mine : 1u; nx = cnt > 0u ? cnt : 1u;
}
__device__ __forceinline__ void xcd_barrier(const XcdBarrier& b) {
    asm volatile("s_waitcnt vmcnt(0)" ::: "memory");
    __syncthreads();
    if (threadIdx.x == 0) {
        unsigned* bar = b.bar;
        __builtin_amdgcn_s_waitcnt(0);
        unsigned nloc = b.st[0], nx = b.st[1];
        if (nloc == 0u) { xcd_barrier_complete(bar, b.x, nloc, nx); b.st[0] = nloc; b.st[1] = nx; }
        const unsigned old = xb_add(&bar[XB_XSUB(b.x)], 1u);
        const unsigned gen = old / nloc;
        if (old + 1u == (gen + 1u) * nloc) {
            __builtin_amdgcn_fence(__ATOMIC_RELEASE, "agent");
            asm volatile("s_waitcnt vmcnt(0)" ::: "memory");
            const unsigned og = xb_add(&bar[XB_TOP], 1u);
            const unsigned tg = og / nx;
            if (og + 1u == (tg + 1u) * nx) xb_add(&bar[XB_TOPGEN], 1u);
            else XB_SPIN(xb_ld(&bar[XB_TOPGEN]) == tg, bar);
            __builtin_amdgcn_fence(__ATOMIC_ACQUIRE, "agent");
            xb_add(&bar[XB_XGEN(b.x)], 1u);
            asm volatile("s_waitcnt vmcnt(0)" ::: "memory");
        } else {
            XB_SPIN(xb_ld(&bar[XB_XGEN(b.x)]) == gen, bar);
            __builtin_amdgcn_fence(__ATOMIC_ACQUIRE, "agent");
            asm volatile("s_waitcnt vmcnt(0)" ::: "memory");
        }
    }
    __syncthreads();
}

#define GRID_SYNC() xcd_barrier(xbar)

__global__ void __launch_bounds__(512, 2) fwd_megakernel(Params p) {
    extern __shared__ __attribute__((aligned(16))) unsigned char smem[];
    LAS unsigned char* lds = (LAS unsigned char*)smem;
    cg::grid_group grid = cg::this_grid();
    unsigned char* ws = p.ws;
    const int G = gridDim.x, c = blockIdx.x;
    float* MOD = (float*)(ws + OFF_MOD);
    bf16_t* H = (bf16_t*)(ws + OFF_H); bf16_t* P = (bf16_t*)(ws + OFF_P); bf16_t* BR = (bf16_t*)(ws + OFF_BR); bf16_t* MG = (bf16_t*)(ws + OFF_MG);
    bf16_t* ACT = P;
    float* HGST = (float*)(ws + OFF_HGST); float* HGD = (float*)(ws + OFF_HGD);

    volatile LAS unsigned* xst = (volatile LAS unsigned*)(lds + LDS_BYTES - 16);
    if (threadIdx.x == 0) { xst[0] = 0u; xst[1] = 0u; }
    __syncthreads();
    const XcdBarrier xbar = xcd_barrier_post((unsigned*)(ws + OFF_CTL), xst);
#ifndef SKIP_PRO
    phase_prologue(p, lds);
#endif
    grid.sync();
    phase_mod_reduce(p);
    GRID_SYNC();

    for (int ck = 0; ck < NCHUNK; ++ck) {
        const int L = chunk_L(ck), bbase = chunk_bbase(ck);
        float* X = p.out + (size_t)ck * TC * DM;
        const float* xin = (ck < 2) ? p.in[0] + (size_t)ck * TC * DM : p.in[1];
        for (int l = 0; l < NLAYER; ++l) {
            const float* modl = MOD + (size_t)l * 6144;
            phase_norm_mod(l == 0 ? xin : X, l == 0 ? X : nullptr, H, p.in[6] + l * DM, modl + 0, modl + 1024, L, bbase);
            GRID_SYNC();
#ifndef SKIP_G1
            { SchedStd S; S.to.init(TC / 256, NIN / 256, G, c); S.A = (const char*)H; S.B = (const char*)(ws + OFF_WIN) + (size_t)l * NIN * DM * 2; S.atile = 256 * DM * 2; S.btile = 256 * DM * 2; S.nt = DM / 64;
              EpiProj E; E.O = P; E.ldc = NIN;
              pg8::gemm_phase(lds, DM, DM, S, E); }
            #endif
            GRID_SYNC();
#ifndef SKIP_MIX1
            for (int it = c; it < 256 + 1024; it += G) {
                if (it < 256) dl_item(it, P, BR, L, lds);
                else hgA_item(it - 256, P, HGST, HGD, l, p.in[14], lds);
            }
            #endif
            GRID_SYNC();
#ifndef SKIP_MIX2
            hgB_phase(HGST, HGD, L);
            for (int it = c; it < 512 + 512; it += G) {
                if (it < 512) { __syncthreads(); na_item(it, P, BR, p.in[13] + (size_t)l * 4 * 15 * 31, L, lds); }
                else sg_item(it - 512, P, BR, (const bf16_t*)(ws + OFF_SGW) + (size_t)l * 4 * 128 * 128, p.in[16] + l * 256, p.in[17] + l * 256, p.in[19] + l * 512, lds);
            }
            #endif
            GRID_SYNC();
#ifndef SKIP_MIX3
            for (int it = c; it < 1024; it += G) hgC_item(it, P, BR, HGST, l, p.in[14], p.in[15] + l * 256, lds);
            #endif
            GRID_SYNC();
#ifndef SKIP_MERGE
            { SchedMerge S; S.to.init(TC / 256, DM / 256, G, c); S.H = (const char*)H; S.BR = (const char*)BR; S.WG = (const char*)(ws + OFF_WG) + (size_t)l * 4 * DM * DM * 2; S.WB = (const char*)(ws + OFF_WB) + (size_t)l * DM * DM * 2;
              EpiMerge E; E.MG = MG; E.bgate = p.in[10] + (size_t)l * 4 * DM; E.scr = (unsigned char*)P + (size_t)c * MERGE_SCR_PER_BLOCK;
              pg8::gemm_phase(lds, DM, DM, S, E); }
            #endif
            GRID_SYNC();
#ifndef SKIP_WO
            { SchedStd S; S.to.init(TC / 256, DM / 256, G, c); S.A = (const char*)MG; S.B = (const char*)(ws + OFF_WO) + (size_t)l * DM * DM * 2; S.atile = 256 * DM * 2; S.btile = 256 * DM * 2; S.nt = DM / 64;
              EpiRes E; E.X = X; E.gm = modl + 2048; E.L = L; E.bbase = bbase;
              pg8::gemm_phase(lds, DM, DM, S, E); }
            #endif
            GRID_SYNC();
            phase_norm_mod(X, nullptr, H, p.in[7] + l * DM, modl + 3072, modl + 4096, L, bbase);
            GRID_SYNC();
#ifndef SKIP_F1
            { SchedStd S; S.to.init(TC / 256, 2 * DFF / 256, G, c); S.A = (const char*)H; S.B = (const char*)(ws + OFF_WGU) + (size_t)l * 2 * DFF * DM * 2; S.atile = 256 * DM * 2; S.btile = 256 * DM * 2; S.nt = DM / 64;
              EpiAct E; E.O = ACT;
              pg8::gemm_phase(lds, DM, DM, S, E); }
            #endif
            GRID_SYNC();
#ifndef SKIP_F2
            { SchedStd S; S.to.init(TC / 256, DM / 256, G, c); S.A = (const char*)ACT; S.B = (const char*)(ws + OFF_WD) + (size_t)l * DM * DFF * 2; S.atile = (size_t)256 * DFF * 2; S.btile = (size_t)256 * DFF * 2; S.nt = DFF / 64;
              EpiRes E; E.X = X; E.gm = modl + 5120; E.L = L; E.bbase = bbase;
              pg8::gemm_phase(lds, DFF, DFF, S, E); }
            #endif
            GRID_SYNC();
        }
        phase_final_norm(X, p.in[23]);
    }
}

extern "C" void kernel_launch(void* const* d_in, const int* in_sizes, int n_in, void* d_out, int out_size, void* d_ws, size_t ws_size, hipStream_t stream) {
    static int grid = 0;
    if (grid == 0) {
        if (n_in != 24 || ws_size < WS_END) { fprintf(stderr, "kernel_launch: unexpected n_in %d or ws_size %zu (need %zu)\n", n_in, ws_size, (size_t)WS_END); grid = -1; return; }
        int dev = 0, cus = 0, per_cu = 0;
        hipGetDevice(&dev);
        hipDeviceGetAttribute(&cus, hipDeviceAttributeMultiprocessorCount, dev);
        if (hipFuncSetAttribute((const void*)fwd_megakernel, hipFuncAttributeMaxDynamicSharedMemorySize, LDS_BYTES) != hipSuccess) { fprintf(stderr, "kernel_launch: hipFuncSetAttribute failed\n"); grid = -1; return; }
        hipOccupancyMaxActiveBlocksPerMultiprocessor(&per_cu, (const void*)fwd_megakernel, NTHR, LDS_BYTES);
        if (per_cu < 1) { fprintf(stderr, "kernel_launch: occupancy query says %d blocks per CU\n", per_cu); per_cu = 1; }
        (void)hipGetLastError();
        grid = cus;
        if (grid > 272) grid = 272;
    }
    if (grid < 0) return;
    if (hipMemsetAsync((char*)d_ws + OFF_CTL, 0, 16384, stream) != hipSuccess) { fprintf(stderr, "kernel_launch: memset of control words failed\n"); return; }
    Params p{};
    for (int i = 0; i < 24; ++i) p.in[i] = (const float*)d_in[i];
    p.out = (float*)d_out; p.ws = (unsigned char*)d_ws;
    void* args[] = {&p};
    hipError_t e = hipLaunchCooperativeKernel((const void*)fwd_megakernel, dim3(grid), dim3(NTHR), args, LDS_BYTES, stream);
    if (e != hipSuccess) fprintf(stderr, "cooperative launch failed: %s (grid %d)\n", hipGetErrorString(e), grid);
}
```

```cpp
#include <hip/hip_runtime.h>
#include <hip/hip_cooperative_groups.h>
#include <cstdio>
#include <cstdint>
namespace cg = cooperative_groups;

#define LAS __attribute__((address_space(3)))
typedef unsigned short bf16_t;
typedef short bf16x8 __attribute__((ext_vector_type(8)));
typedef float f32x4 __attribute__((ext_vector_type(4)));
typedef unsigned u32x4 __attribute__((ext_vector_type(4)));
typedef unsigned u32x2 __attribute__((ext_vector_type(2)));

constexpr int DM = 1024, TC = 16384, NCHUNK = 3, NIN = 3328, DFF = 2816, NLAYER = 4, NB = 20;
constexpr int P_NAQ = 0, P_NAK = 256, P_NAV = 512, P_FF = 768, P_FB = 1024, P_HQ = 1280, P_HI = 1536, P_HGATE = 1792, P_SU = 2048, P_SV = 2304, P_DQ = 2560, P_DK = 2816, P_DV = 3072;
constexpr float EPSV = 1e-6f;
constexpr int LDS_BYTES = 147456;
constexpr int NTHR = 512;

constexpr size_t OFF_CTL = 0;
constexpr size_t OFF_MOD = 16384;
constexpr size_t SZ_MOD = (size_t)NB * NLAYER * 6144 * 4;
constexpr size_t OFF_MODP = OFF_MOD + SZ_MOD;
constexpr size_t OFF_WIN = OFF_MODP + 8 * SZ_MOD;
constexpr size_t OFF_WG = OFF_WIN + (size_t)NLAYER * NIN * DM * 2;
constexpr size_t OFF_WB = OFF_WG + (size_t)NLAYER * 4 * DM * DM * 2;
constexpr size_t OFF_WO = OFF_WB + (size_t)NLAYER * DM * DM * 2;
constexpr size_t OFF_WGU = OFF_WO + (size_t)NLAYER * DM * DM * 2;
constexpr size_t OFF_WD = OFF_WGU + (size_t)NLAYER * 2 * DFF * DM * 2;
constexpr size_t OFF_SGW = OFF_WD + (size_t)NLAYER * DM * DFF * 2;
constexpr size_t OFF_H = OFF_SGW + (size_t)NLAYER * 4 * 128 * 128 * 2;
constexpr size_t OFF_P = OFF_H + (size_t)TC * DM * 2;
constexpr size_t OFF_BR = OFF_P + (size_t)TC * NIN * 2;
constexpr size_t OFF_MG = OFF_BR + (size_t)TC * DM * 2;
constexpr size_t OFF_HGST = OFF_MG + (size_t)TC * DM * 2;
constexpr size_t OFF_HGD = OFF_HGST + (size_t)256 * 8 * 4096 * 4;
constexpr size_t WS_END = OFF_HGD + (size_t)256 * 8 * 64 * 4;
constexpr size_t MERGE_SCR_PER_BLOCK = 131072 + 262144;

struct Params {
    const float* in[24];
    float* out;
    unsigned char* ws;
};

__device__ __forceinline__ unsigned pk2(float lo, float hi) { unsigned r; asm("v_cvt_pk_bf16_f32 %0, %1, %2" : "=v"(r) : "v"(lo), "v"(hi)); return r; }
__device__ __forceinline__ bf16_t f2bf(float f) { return (bf16_t)(pk2(f, 0.f) & 0xffffu); }
__device__ __forceinline__ float bf2f(unsigned b) { return __uint_as_float(b << 16); }
__device__ __forceinline__ float bflo(unsigned w) { return __uint_as_float(w << 16); }
__device__ __forceinline__ float bfhi(unsigned w) { return __uint_as_float(w & 0xffff0000u); }
__device__ __forceinline__ float sigmoidf_(float x) { return 1.f / (1.f + __expf(-x)); }
__device__ __forceinline__ float siluf_(float x) { return x * sigmoidf_(x); }
__device__ __forceinline__ float gelu_tanh(float x) { return x * sigmoidf_(1.5957691216f * (x + 0.044715f * x * x * x)); }
__device__ __forceinline__ float wave_sum(float v) {
#pragma unroll
    for (int o = 1; o < 64; o <<= 1) v += __shfl_xor(v, o);
    return v;
}
__device__ __forceinline__ int opaque_tid() { int t = threadIdx.x; asm volatile("" : "+v"(t)); return t; }
#define MFMA16(a, b, c) __builtin_amdgcn_mfma_f32_16x16x32_bf16((a), (b), (c), 0, 0, 0)

__device__ __forceinline__ int chunk_L(int ck) { return ck < 2 ? 2048 : 4096; }
__device__ __forceinline__ int chunk_bbase(int ck) { return ck * 8; }

namespace pg8 {
constexpr int BM = 256, BK = 64, HALF = 128, HTB = HALF * BK * 2, STAGE_BYTES = 8 * HTB, NXCD = 8, WGM = 8;
__host__ __device__ __forceinline__ int lds_byte(int r, int c) { const int st = (r >> 4) * 2 + (c >> 5), rr = r & 15, cc = c & 31, ob = rr * 64 + cc * 2; return st * 1024 + (ob ^ (((ob >> 9) & 1) << 5)); }
__host__ __device__ __forceinline__ void stage_rc(int b, int& R, int& C) { const int st = b / 1024, sb = b % 1024, swz = sb ^ (((sb >> 9) & 1) << 5); R = (st >> 1) * 16 + swz / 64; C = (st & 1) * 32 + (swz % 64) / 2; }
__host__ __device__ __forceinline__ int perm32(int rho) { const int n = rho >> 4, i = rho & 15; return 8 * (i >> 2) + 4 * n + (i & 3); }

struct Unit { const char* a; const char* b; int nt; int pm, pn, kind; };

struct TileOrder {
    int nM, nN, nwg, G, c;
    __device__ __forceinline__ void init(int nM_, int nN_, int G_, int c_) { nM = nM_; nN = nN_; nwg = nM * nN; G = G_; c = c_; }
    __device__ __forceinline__ bool tile(int i, int& pm, int& pn) const {
        const long L = (long)i * G + c; if (L >= nwg) return false;
        int wgid = (int)L; { const int q = nwg / NXCD, r = nwg % NXCD, xcd = wgid % NXCD, off = wgid / NXCD; wgid = (xcd < r ? xcd * (q + 1) : r * (q + 1) + (xcd - r) * q) + off; }
        const int nig = WGM * nN, gid = wgid / nig, fm = gid * WGM, gsz = (nM - fm) < WGM ? (nM - fm) : WGM;
        pm = fm + ((wgid % nig) % gsz); pn = (wgid % nig) / gsz; return true;
    }
};

template <class Epi, class Sched>
__device__ __forceinline__ void gemm_phase(LAS unsigned char* lds, const int lda, const int ldb, const Sched& S, const Epi& E) {
    const int tid = opaque_tid(), wid = __builtin_amdgcn_readfirstlane(tid >> 6), lane = tid & 63, wr = wid >> 2, wc = wid & 3, fr = lane & 15, fq = lane >> 4;
    unsigned voffA[2], voffB[2];
#pragma unroll
    for (int i = 0; i < 2; ++i) { int R, C; stage_rc(tid * 16 + i * 8192, R, C); const int Rb = Epi::PERM ? ((R & ~31) + perm32(R & 31)) : R;
        voffA[i] = (unsigned)(R * lda + C) * 2u; voffB[i] = (unsigned)(Rb * ldb + C) * 2u; }
    const size_t kstep = (size_t)(BK * 2);
    const size_t hstepA = (size_t)HALF * lda * 2, hstepB = (size_t)HALF * ldb * 2;
    const unsigned ldsw = (unsigned)wid * 1024u;
    const int aoff = lds_byte(wr * 64 + fr, fq * 8), boff = lds_byte(wc * 32 + fr, fq * 8);
#define PG8_SA(b, h) (((b) * 2 + (h)) * HTB)
#define PG8_SB(b, h) ((4 + (b) * 2 + (h)) * HTB)
#define PG8_STAGE(bufoff, gbase, voff) do { _Pragma("unroll") for (int _i = 0; _i < 2; ++_i) \
        __builtin_amdgcn_global_load_lds((const unsigned*)((const char*)(gbase) + (voff)[_i]), (LAS unsigned*)(lds + (bufoff) + ldsw + _i * 8192), 16, 0, 0); } while (0)
#define PG8_LDA(dst, b, h) do { _Pragma("unroll") for (int m = 0; m < 4; ++m) _Pragma("unroll") for (int k = 0; k < 2; ++k) dst[m][k] = *(const LAS bf16x8*)(lds + PG8_SA(b, h) + aoff + m * 2048 + k * 1024); } while (0)
#define PG8_LDB(dst, b, h) do { _Pragma("unroll") for (int n = 0; n < 2; ++n) _Pragma("unroll") for (int k = 0; k < 2; ++k) dst[n][k] = *(const LAS bf16x8*)(lds + PG8_SB(b, h) + boff + n * 2048 + k * 1024); } while (0)
#define PG8_MMA(ai, bj, At, Bt) do { __builtin_amdgcn_s_setprio(1); _Pragma("unroll") for (int m = 0; m < 4; ++m) _Pragma("unroll") for (int n = 0; n < 2; ++n) _Pragma("unroll") for (int k = 0; k < 2; ++k) \
        acc[ai][bj][m][n] = __builtin_amdgcn_mfma_f32_16x16x32_bf16(Bt[n][k], At[m][k], acc[ai][bj][m][n], 0, 0, 0); __builtin_amdgcn_s_setprio(0); } while (0)
#define PG8_WAIT_V(n) asm volatile("s_waitcnt vmcnt(" #n ")" ::: "memory")
#define PG8_WAIT_L(n) asm volatile("s_waitcnt lgkmcnt(" #n ")" ::: "memory")
#define PG8_BAR __builtin_amdgcn_s_barrier()
#define PG8_SCHED __builtin_amdgcn_sched_barrier(0)
    Unit cur, nxt; int ui = 0;
    if (!S.next(0, cur)) return;
    f32x4 acc[2][2][4][2];
#pragma unroll
    for (int a = 0; a < 2; ++a)
#pragma unroll
        for (int b = 0; b < 2; ++b)
#pragma unroll
            for (int m = 0; m < 4; ++m)
#pragma unroll
                for (int n = 0; n < 2; ++n) acc[a][b][m][n] = (f32x4){0.f, 0.f, 0.f, 0.f};
    bf16x8 At[4][2], B0[2][2], B1[2][2];
    const char* cA = cur.a; const char* cB = cur.b;
    PG8_STAGE(PG8_SB(0, 0), cB, voffB); PG8_STAGE(PG8_SA(0, 0), cA, voffA); PG8_STAGE(PG8_SB(0, 1), cB + hstepB, voffB); PG8_STAGE(PG8_SA(0, 1), cA + hstepA, voffA);
    if (wr == 1) PG8_BAR;
    PG8_WAIT_V(4); PG8_BAR;
    PG8_STAGE(PG8_SB(1, 0), cB + kstep, voffB); PG8_STAGE(PG8_SA(1, 0), cA + kstep, voffA); PG8_STAGE(PG8_SB(1, 1), cB + hstepB + kstep, voffB);
    PG8_WAIT_V(6); PG8_BAR;
    for (;;) {
        const bool has_next = S.next(ui + 1, nxt);
        const char* nA = has_next ? nxt.a : cA; const char* nB = has_next ? nxt.b : cB;
        const int nt = cur.nt;
        for (int t = 0; t < nt; t += 2) {
            const bool last = (t == nt - 2);
            const char* a1 = cA + (size_t)(t + 1) * kstep;
            const char* a2 = last ? nA : cA + (size_t)(t + 2) * kstep; const char* b2 = last ? nB : cB + (size_t)(t + 2) * kstep;
            const char* a3 = a2 + kstep; const char* b3 = b2 + kstep;
            PG8_LDB(B0, 0, 0); PG8_SCHED; PG8_LDA(At, 0, 0); PG8_STAGE(PG8_SA(1, 1), a1 + hstepA, voffA);
            PG8_WAIT_L(8); PG8_BAR; PG8_WAIT_L(0); PG8_MMA(0, 0, At, B0); PG8_BAR; PG8_SCHED;
            PG8_LDB(B1, 0, 1); PG8_STAGE(PG8_SB(0, 0), b2, voffB);
            PG8_BAR; PG8_WAIT_L(0); PG8_MMA(0, 1, At, B1); PG8_BAR;
            PG8_LDA(At, 0, 1); PG8_STAGE(PG8_SA(0, 0), a2, voffA);
            PG8_BAR; PG8_WAIT_L(0); PG8_MMA(1, 0, At, B0); PG8_BAR; PG8_SCHED;
            PG8_STAGE(PG8_SB(0, 1), b2 + hstepB, voffB);
            PG8_WAIT_V(6); PG8_BAR; PG8_MMA(1, 1, At, B1); PG8_BAR;
            PG8_LDB(B0, 1, 0); PG8_SCHED; PG8_LDA(At, 1, 0); PG8_STAGE(PG8_SA(0, 1), a2 + hstepA, voffA);
            PG8_WAIT_L(8); PG8_BAR; PG8_WAIT_L(0); PG8_MMA(0, 0, At, B0); PG8_BAR; PG8_SCHED;
            PG8_LDB(B1, 1, 1); PG8_STAGE(PG8_SB(1, 0), b3, voffB);
            PG8_BAR; PG8_WAIT_L(0); PG8_MMA(0, 1, At, B1); PG8_BAR;
            PG8_LDA(At, 1, 1); PG8_STAGE(PG8_SA(1, 0), a3, voffA);
            PG8_BAR; PG8_WAIT_L(0); PG8_MMA(1, 0, At, B0); PG8_BAR; PG8_SCHED;
            PG8_STAGE(PG8_SB(1, 1), b3 + hstepB, voffB);
            PG8_WAIT_V(6); PG8_BAR; PG8_MMA(1, 1, At, B1); PG8_BAR;
        }
        E(acc, cur, wr, wc, fr, fq);
        if (!has_next) break;
#pragma unroll
        for (int a = 0; a < 2; ++a)
#pragma unroll
            for (int b = 0; b < 2; ++b)
#pragma unroll
                for (int m = 0; m < 4; ++m)
#pragma unroll
                    for (int n = 0; n < 2; ++n) acc[a][b][m][n] = (f32x4){0.f, 0.f, 0.f, 0.f};
        cur = nxt; cA = nA; cB = nB; ++ui;
    }
    PG8_WAIT_V(0);
    if (wr == 0) PG8_BAR;
    PG8_BAR;
#undef PG8_SA
#undef PG8_SB
#undef PG8_STAGE
#undef PG8_LDA
#undef PG8_LDB
#undef PG8_MMA
#undef PG8_WAIT_V
#undef PG8_WAIT_L
#undef PG8_BAR
#undef PG8_SCHED
}
}
using pg8::Unit;

struct SchedStd {
    pg8::TileOrder to; const char* A; const char* B; size_t atile, btile; int nt;
    __device__ __forceinline__ bool next(int i, Unit& u) const {
        int pm, pn; if (!to.tile(i, pm, pn)) return false;
        u.pm = pm; u.pn = pn; u.kind = 0; u.nt = nt; u.a = A + (size_t)pm * atile; u.b = B + (size_t)pn * btile; return true;
    }
};
struct SchedMerge {
    pg8::TileOrder to; const char* H; const char* BR; const char* WG; const char* WB;
    __device__ __forceinline__ bool next(int i, Unit& u) const {
        int pm, pn; if (!to.tile(i >> 3, pm, pn)) return false;
        const int sub = i & 7, bi = sub >> 1;
        u.pm = pm; u.pn = pn; u.kind = sub;
        if (sub & 1) { u.nt = 16; u.a = H + (size_t)pm * (256 * DM * 2); u.b = WG + (size_t)bi * (DM * DM * 2) + (size_t)pn * (256 * DM * 2); }
        else { u.nt = 4; u.a = BR + (size_t)pm * (256 * DM * 2) + bi * 512; u.b = WB + (size_t)pn * (256 * DM * 2) + bi * 512; }
        return true;
    }
};

struct EpiProj {
    static constexpr bool PERM = true;
    bf16_t* O; int ldc;
    __device__ __forceinline__ void operator()(const f32x4 (&acc)[2][2][4][2], const Unit& u, int wr, int wc, int fr, int fq) const {
        const int row0 = u.pm * 256 + wr * 64 + fr, col0 = u.pn * 256 + wc * 32 + 8 * fq;
#pragma unroll
        for (int ai = 0; ai < 2; ++ai)
#pragma unroll
            for (int m = 0; m < 4; ++m) { bf16_t* rowp = O + (size_t)(row0 + ai * 128 + m * 16) * ldc + col0;
#pragma unroll
                for (int bj = 0; bj < 2; ++bj) { const f32x4 v0 = acc[ai][bj][m][0], v1 = acc[ai][bj][m][1];
                    u32x4 o; o.x = pk2(v0[0], v0[1]); o.y = pk2(v0[2], v0[3]); o.z = pk2(v1[0], v1[1]); o.w = pk2(v1[2], v1[3]);
                    *(u32x4*)(rowp + bj * 128) = o; } }
    }
};
struct EpiAct {
    static constexpr bool PERM = true;
    bf16_t* O;
    __device__ __forceinline__ void operator()(const f32x4 (&acc)[2][2][4][2], const Unit& u, int wr, int wc, int fr, int fq) const {
        const int row0 = u.pm * 256 + wr * 64 + fr, col0 = u.pn * 128 + wc * 32 + 8 * fq;
#pragma unroll
        for (int ai = 0; ai < 2; ++ai)
#pragma unroll
            for (int m = 0; m < 4; ++m) { bf16_t* rowp = O + (size_t)(row0 + ai * 128 + m * 16) * DFF + col0;
                float r[8];
#pragma unroll
                for (int n = 0; n < 2; ++n)
#pragma unroll
                    for (int j = 0; j < 4; ++j) { const float g = acc[ai][0][m][n][j], up = acc[ai][1][m][n][j]; r[n * 4 + j] = siluf_(g) * up; }
                u32x4 o; o.x = pk2(r[0], r[1]); o.y = pk2(r[2], r[3]); o.z = pk2(r[4], r[5]); o.w = pk2(r[6], r[7]);
                *(u32x4*)rowp = o; }
    }
};
struct EpiRes {
    static constexpr bool PERM = false;
    float* X; const float* gm; int L; int bbase;
    __device__ __forceinline__ void operator()(const f32x4 (&acc)[2][2][4][2], const Unit& u, int wr, int wc, int fr, int fq) const {
        const int row0 = u.pm * 256 + wr * 64 + fr, col0 = u.pn * 256 + wc * 32 + 4 * fq;
        const int b = bbase + (u.pm * 256) / L;
        const float* g = gm + (size_t)b * (NLAYER * 6144) + col0;
        f32x4 gv[2][2];
#pragma unroll
        for (int bj = 0; bj < 2; ++bj)
#pragma unroll
            for (int n = 0; n < 2; ++n) gv[bj][n] = *(const f32x4*)(g + bj * 128 + n * 16);
#pragma unroll
        for (int ai = 0; ai < 2; ++ai)
#pragma unroll
            for (int m = 0; m < 4; ++m) { float* rowp = X + (size_t)(row0 + ai * 128 + m * 16) * DM + col0;
#pragma unroll
                for (int bj = 0; bj < 2; ++bj)
#pragma unroll
                    for (int n = 0; n < 2; ++n) { f32x4* p = (f32x4*)(rowp + bj * 128 + n * 16); const f32x4 x = *p; *p = x + gv[bj][n] * acc[ai][bj][m][n]; } }
    }
};
struct EpiMerge {
    static constexpr bool PERM = true;
    bf16_t* MG; const float* bgate;
    unsigned char* scr;
    __device__ __forceinline__ void operator()(const f32x4 (&acc)[2][2][4][2], const Unit& u, int wr, int wc, int fr, int fq) const {
        const int tid = opaque_tid(), bi = u.kind >> 1;
        unsigned char* pbp = scr + tid * 16;
        unsigned char* pmp = scr + 131072 + tid * 16;
        if ((u.kind & 1) == 0) {
#pragma unroll
            for (int bj = 0; bj < 2; ++bj)
#pragma unroll
                for (int ai = 0; ai < 2; ++ai)
#pragma unroll
                    for (int m = 0; m < 4; ++m) { const f32x4 v0 = acc[ai][bj][m][0], v1 = acc[ai][bj][m][1];
                        u32x4 o; o.x = pk2(v0[0], v0[1]); o.y = pk2(v0[2], v0[3]); o.z = pk2(v1[0], v1[1]); o.w = pk2(v1[2], v1[3]);
                        *(u32x4*)pbp = o; pbp += 8192; asm volatile("" : "+v"(pbp)); }
        } else {
            const int row0 = u.pm * 256 + wr * 64 + fr, col0 = u.pn * 256 + wc * 32 + 8 * fq;
            const float* bg = bgate + bi * DM + col0;
            bf16_t* mgp = MG + (size_t)row0 * DM + col0;
#pragma unroll
            for (int bj = 0; bj < 2; ++bj) {
                const f32x4 b0 = *(const f32x4*)(bg + bj * 128), b1 = *(const f32x4*)(bg + bj * 128 + 4);
#pragma unroll
                for (int ai = 0; ai < 2; ++ai)
#pragma unroll
                    for (int m = 0; m < 4; ++m) {
                        const u32x4 pv = *(const u32x4*)pbp; pbp += 8192; asm volatile("" : "+v"(pbp));
                        const f32x4 a0 = acc[ai][bj][m][0] + b0, a1 = acc[ai][bj][m][1] + b1;
                        f32x4 r0, r1;
                        r0[0] = sigmoidf_(a0[0]) * bflo(pv.x); r0[1] = sigmoidf_(a0[1]) * bfhi(pv.x); r0[2] = sigmoidf_(a0[2]) * bflo(pv.y); r0[3] = sigmoidf_(a0[3]) * bfhi(pv.y);
                        r1[0] = sigmoidf_(a1[0]) * bflo(pv.z); r1[1] = sigmoidf_(a1[1]) * bfhi(pv.z); r1[2] = sigmoidf_(a1[2]) * bflo(pv.w); r1[3] = sigmoidf_(a1[3]) * bfhi(pv.w);
                        if (bi > 0) { r0 += *(const f32x4*)pmp; r1 += *(const f32x4*)(pmp + 8192); }
                        if (bi < 3) { *(f32x4*)pmp = r0; *(f32x4*)(pmp + 8192) = r1; }
                        else { u32x4 o; o.x = pk2(r0[0], r0[1]); o.y = pk2(r0[2], r0[3]); o.z = pk2(r1[0], r1[1]); o.w = pk2(r1[2], r1[3]);
                            bf16_t* q = mgp + (size_t)(ai * 128 + m * 16) * DM + bj * 128; asm volatile("" : "+v"(q));
                            *(u32x4*)q = o; }
                        pmp += 16384; asm volatile("" : "+v"(pmp)); }
            }
        }
    }
};

__device__ __forceinline__ void transpose_item(const float* W, int N, int k0, int n0, bf16_t* dst  , int ldwt, LAS float* scr, int lane) {
#pragma unroll 8
    for (int i = 0; i < 32; ++i) { const int kk = 2 * i + (lane >> 5); scr[kk * 33 + (lane & 31)] = W[(size_t)(k0 + kk) * N + n0 + (lane & 31)]; }
    __builtin_amdgcn_wave_barrier();
    const int c = lane & 7;
#pragma unroll
    for (int j = 0; j < 4; ++j) { const int n = (lane >> 3) + 8 * j; const LAS float* s = scr + (8 * c) * 33 + n;
        u32x4 o; o.x = pk2(s[0 * 33], s[1 * 33]); o.y = pk2(s[2 * 33], s[3 * 33]); o.z = pk2(s[4 * 33], s[5 * 33]); o.w = pk2(s[6 * 33], s[7 * 33]);
        *(u32x4*)(dst + (size_t)n * ldwt + 8 * c) = o; }
    __builtin_amdgcn_wave_barrier();
}

__device__ __forceinline__ void phase_prologue(const Params& p, LAS unsigned char* lds) {
    const int tid = opaque_tid(), lane = tid & 63, wave = tid >> 6;
    unsigned char* ws = p.ws;
    {
        LAS float* scr = (LAS float*)(lds + wave * 8704);
        const int gw = blockIdx.x * 8 + wave, NGW = gridDim.x * 8;
        constexpr int I_IN = 16 * (NIN / 32), I_G = 4 * 16 * 32, I_B = 4 * 4 * 32, I_O = 16 * 32, I_F = 16 * (DFF / 32), I_D = (DFF / 64) * 32;
        constexpr int PER_LAYER = I_IN + I_G + I_B + I_O + 2 * I_F + I_D;
        for (int it = gw; it < NLAYER * PER_LAYER; it += NGW) {
            const int l = it / PER_LAYER; int r = it % PER_LAYER;
            if (r < I_IN) { const int nb = r % (NIN / 32), kb = r / (NIN / 32);
                transpose_item(p.in[8] + (size_t)l * DM * NIN, NIN, 64 * kb, 32 * nb, (bf16_t*)(ws + OFF_WIN) + ((size_t)l * NIN + 32 * nb) * DM + 64 * kb, DM, scr, lane); continue; }
            r -= I_IN;
            if (r < I_G) { const int bi = r / 512, rr = r % 512, nb = rr % 32, kb = rr / 32;
                transpose_item(p.in[9] + ((size_t)l * 4 + bi) * DM * DM, DM, 64 * kb, 32 * nb, (bf16_t*)(ws + OFF_WG) + (((size_t)l * 4 + bi) * DM + 32 * nb) * DM + 64 * kb, DM, scr, lane); continue; }
            r -= I_G;
            if (r < I_B) { const int bi = r / 128, rr = r % 128, nb = rr % 32, kb = rr / 32;
                transpose_item(p.in[11] + ((size_t)l * 4 + bi) * 256 * DM, DM, 64 * kb, 32 * nb, (bf16_t*)(ws + OFF_WB) + ((size_t)l * DM + 32 * nb) * DM + bi * 256 + 64 * kb, DM, scr, lane); continue; }
            r -= I_B;
            if (r < I_O) { const int nb = r % 32, kb = r / 32;
                transpose_item(p.in[12] + (size_t)l * DM * DM, DM, 64 * kb, 32 * nb, (bf16_t*)(ws + OFF_WO) + ((size_t)l * DM + 32 * nb) * DM + 64 * kb, DM, scr, lane); continue; }
            r -= I_O;
            if (r < 2 * I_F) { const int which = r / I_F, rr = r % I_F, nb = rr % (DFF / 32), kb = rr / (DFF / 32);
                const int n0 = 32 * nb, row = (n0 >> 7) * 256 + (n0 & 127) + which * 128;
                transpose_item(p.in[which ? 21 : 20] + (size_t)l * DM * DFF, DFF, 64 * kb, n0, (bf16_t*)(ws + OFF_WGU) + ((size_t)l * 2 * DFF + row) * DM + 64 * kb, DM, scr, lane); continue; }
            r -= 2 * I_F;
            { const int nb = r % 32, kb = r / 32;
                transpose_item(p.in[22] + (size_t)l * DFF * DM, DM, 64 * kb, 32 * nb, (bf16_t*)(ws + OFF_WD) + ((size_t)l * DM + 32 * nb) * DFF + 64 * kb, DFF, scr, lane); }
        }
    }
    {
        const float* src = p.in[18]; bf16_t* dst = (bf16_t*)(ws + OFF_SGW);
        for (int i = blockIdx.x * NTHR + tid; i < NLAYER * 4 * 128 * 128 / 4; i += gridDim.x * NTHR) {
            const f32x4 v = *(const f32x4*)(src + 4 * (size_t)i); u32x2 o; o.x = pk2(v[0], v[1]); o.y = pk2(v[2], v[3]); *(u32x2*)(dst + 4 * (size_t)i) = o; }
    }
    __syncthreads();
    {
        LAS float* cs = (LAS float*)lds;
        float* modp = (float*)(ws + OFF_MODP);
        for (int it = blockIdx.x; it < NLAYER * 12 * 8; it += gridDim.x) {
            const int ks = it & 7, nb = (it >> 3) % 12, l = it / 96;
            __syncthreads();
            for (int e = tid; e < 128 * NB; e += NTHR) { const int kk = e / NB, b = e % NB;
                const float c = b < 16 ? p.in[2][b * DM + 128 * ks + kk] : p.in[3][(b - 16) * DM + 128 * ks + kk];
                cs[kk * NB + b] = siluf_(c); }
            __syncthreads();
            const int n = nb * 512 + tid;
            const float* w = p.in[4] + ((size_t)l * DM + 128 * ks) * 6144 + n;
            float a[NB];
#pragma unroll
            for (int b = 0; b < NB; ++b) a[b] = 0.f;
#pragma unroll 4
            for (int kk = 0; kk < 128; ++kk) { const float wv = w[(size_t)kk * 6144];
#pragma unroll
                for (int b4 = 0; b4 < NB / 4; ++b4) { const f32x4 c4 = *(const LAS f32x4*)(cs + kk * NB + 4 * b4);
                    a[4 * b4 + 0] += c4[0] * wv; a[4 * b4 + 1] += c4[1] * wv; a[4 * b4 + 2] += c4[2] * wv; a[4 * b4 + 3] += c4[3] * wv; } }
#pragma unroll
            for (int b = 0; b < NB; ++b) modp[(((size_t)ks * NB + b) * NLAYER + l) * 6144 + n] = a[b];
        }
    }
}
__device__ __forceinline__ void phase_mod_reduce(const Params& p) {
    const float* modp = (const float*)(p.ws + OFF_MODP); float* mod = (float*)(p.ws + OFF_MOD);
    constexpr int NMOD = NB * NLAYER * 6144;
    for (int i = blockIdx.x * NTHR + opaque_tid(); i < NMOD; i += gridDim.x * NTHR) {
        const int n = i % 6144, l = (i / 6144) % NLAYER;
        float s = p.in[5][l * 6144 + n];
#pragma unroll
        for (int ks = 0; ks < 8; ++ks) s += modp[(size_t)ks * NMOD + i];
        mod[i] = s;
    }
}

__device__ __forceinline__ void phase_norm_mod(const float* xsrc, float* copy_to, bf16_t* H, const float* g, const float* mod_sh, const float* mod_sc, int L, int bbase) {
    const int tid = opaque_tid(), lane = tid & 63, gw = blockIdx.x * 8 + (tid >> 6), NGW = gridDim.x * 8;
    for (int row = gw; row < TC; row += NGW) {
        const int b = bbase + row / L;
        const f32x4* xr = (const f32x4*)(xsrc + (size_t)row * DM) + lane;
        f32x4 v[4]; float s = 0.f;
#pragma unroll
        for (int j = 0; j < 4; ++j) { v[j] = xr[64 * j]; s += (v[j][0] * v[j][0] + v[j][1] * v[j][1]) + (v[j][2] * v[j][2] + v[j][3] * v[j][3]); }
        const float rstd = rsqrtf(wave_sum(s) * (1.f / DM) + EPSV);
        if (copy_to) { f32x4* cr = (f32x4*)(copy_to + (size_t)row * DM) + lane;
#pragma unroll
            for (int j = 0; j < 4; ++j) cr[64 * j] = v[j]; }
        const f32x4* gr = (const f32x4*)g + lane;
        const f32x4* shr = (const f32x4*)(mod_sh + (size_t)b * (NLAYER * 6144)) + lane;
        const f32x4* scr = (const f32x4*)(mod_sc + (size_t)b * (NLAYER * 6144)) + lane;
        u32x2* o = (u32x2*)(H + (size_t)row * DM) + lane;
#pragma unroll
        for (int j = 0; j < 4; ++j) { const f32x4 gg = gr[64 * j], sh = shr[64 * j], sc = scr[64 * j];
            const f32x4 y = v[j] * rstd * gg * (sc + 1.f) + sh;
            u32x2 w; w.x = pk2(y[0], y[1]); w.y = pk2(y[2], y[3]); o[64 * j] = w; }
    }
}
__device__ __forceinline__ void phase_final_norm(float* X, const float* g) {
    const int tid = opaque_tid(), lane = tid & 63, gw = blockIdx.x * 8 + (tid >> 6), NGW = gridDim.x * 8;
    for (int row = gw; row < TC; row += NGW) {
        f32x4* xr = (f32x4*)(X + (size_t)row * DM) + lane;
        f32x4 v[4]; float s = 0.f;
#pragma unroll
        for (int j = 0; j < 4; ++j) { v[j] = xr[64 * j]; s += (v[j][0] * v[j][0] + v[j][1] * v[j][1]) + (v[j][2] * v[j][2] + v[j][3] * v[j][3]); }
        const float rstd = rsqrtf(wave_sum(s) * (1.f / DM) + EPSV);
        const f32x4* gr = (const f32x4*)g + lane;
#pragma unroll
        for (int j = 0; j < 4; ++j) xr[64 * j] = v[j] * rstd * gr[64 * j];
    }
}

struct AttnState { f32x4 o[4]; float m, l; };
constexpr int VT_LD = 40;
constexpr int VT_BYTES = 64 * VT_LD * 2;
struct KVRegs { bf16x8 k[2][2]; u32x4 v[4]; };
template <class TokK, class TokV>
__device__ __forceinline__ void kv_load(KVRegs& kv, const bf16_t* P, int kcol, int vcol, int lane, int fq, const TokK& tok_k, const TokV& tok_v) {
#pragma unroll
    for (int t = 0; t < 2; ++t) { const bf16_t* kp = P + (size_t)tok_k(t) * NIN + kcol + 8 * fq; kv.k[t][0] = *(const bf16x8*)kp; kv.k[t][1] = *(const bf16x8*)(kp + 32); }
#pragma unroll
    for (int i = 0; i < 4; ++i) { const int pc = lane + 64 * i, key = pc >> 3, ch = pc & 7; kv.v[i] = *(const u32x4*)(P + (size_t)tok_v(key) * NIN + vcol + 8 * ch); }
}
__device__ __forceinline__ void attn_stage_v(LAS bf16_t* vt, const KVRegs& kv, int lane) {
#pragma unroll
    for (int i = 0; i < 4; ++i) { const int pc = lane + 64 * i, key = pc >> 3, ch = pc & 7;
        const u32x4 v = kv.v[i];
        const int slot = 8 * ((key & 15) >> 2) + 4 * (key >> 4) + (key & 3);
        LAS bf16_t* d = vt + ch * VT_LD + slot;
        d[0 * 8 * VT_LD] = (bf16_t)(v.x & 0xffffu); d[1 * 8 * VT_LD] = (bf16_t)(v.x >> 16);
        d[2 * 8 * VT_LD] = (bf16_t)(v.y & 0xffffu); d[3 * 8 * VT_LD] = (bf16_t)(v.y >> 16);
        d[4 * 8 * VT_LD] = (bf16_t)(v.z & 0xffffu); d[5 * 8 * VT_LD] = (bf16_t)(v.z >> 16);
        d[6 * 8 * VT_LD] = (bf16_t)(v.w & 0xffffu); d[7 * 8 * VT_LD] = (bf16_t)(v.w >> 16); }
}
__device__ __forceinline__ void attn_update(AttnState& st, const float (&s)[2][4], const bool (&valid)[2][4], LAS bf16_t* vt, int fr, int fq) {
    float mx = fmaxf(fmaxf(fmaxf(s[0][0], s[0][1]), fmaxf(s[0][2], s[0][3])), fmaxf(fmaxf(s[1][0], s[1][1]), fmaxf(s[1][2], s[1][3])));
    mx = fmaxf(mx, __shfl_xor(mx, 16)); mx = fmaxf(mx, __shfl_xor(mx, 32));
    const float mn = fmaxf(st.m, mx), alpha = __expf(st.m - mn);
    float pv[2][4]; float ps = 0.f;
#pragma unroll
    for (int t = 0; t < 2; ++t)
#pragma unroll
        for (int r = 0; r < 4; ++r) { pv[t][r] = valid[t][r] ? __expf(s[t][r] - mn) : 0.f; ps += pv[t][r]; }
    st.m = mn; st.l = st.l * alpha + ps;
    union { bf16x8 v; unsigned u[4]; } pf;
    pf.u[0] = pk2(pv[0][0], pv[0][1]); pf.u[1] = pk2(pv[0][2], pv[0][3]); pf.u[2] = pk2(pv[1][0], pv[1][1]); pf.u[3] = pk2(pv[1][2], pv[1][3]);
    __builtin_amdgcn_wave_barrier();
#pragma unroll
    for (int dt = 0; dt < 4; ++dt) {
        const bf16x8 vf = *(const LAS bf16x8*)(vt + ((fr & 7) * 8 + 2 * dt + (fr >> 3)) * VT_LD + 8 * fq);
        st.o[dt] = st.o[dt] * alpha;
        st.o[dt] = MFMA16(vf, pf.v, st.o[dt]);
    }
    __builtin_amdgcn_wave_barrier();
}

__device__ __forceinline__ void na_item(int item, const bf16_t* P, bf16_t* BR, const float* rpb  , int L, LAS unsigned char* lds) {
    const int tid = opaque_tid(), lane = tid & 63, wave = tid >> 6, fr = lane & 15, fq = lane >> 4;
    const int rr = item >> 1, h = (item & 1) * 2 + (wave >> 2), n = wave & 3;
    const int rows = L >> 6, seq = rr / rows, r = rr % rows, seqbase = seq * L;
    const int r0 = min(max(r - 4, 0), rows - 8);
    LAS bf16_t* vt = (LAS bf16_t*)(lds + wave * VT_BYTES);
    const int qtok = seqbase + r * 64 + 16 * n + fr;
    bf16x8 qf[2];
#pragma unroll
    for (int ks = 0; ks < 2; ++ks) qf[ks] = *(const bf16x8*)(P + (size_t)qtok * NIN + P_NAQ + 64 * h + 32 * ks + 8 * fq);
    const int col0 = min(max(16 * n - 8, 0), 32), qcol = 16 * n + fr, win0 = min(max(qcol - 8, 0), 48);
    AttnState st;
#pragma unroll
    for (int dt = 0; dt < 4; ++dt) st.o[dt] = (f32x4){0.f, 0.f, 0.f, 0.f};
    st.m = -1e30f; st.l = 0.f;
    const float* rp = rpb + h * (15 * 31);
    KVRegs cur;
    { const int rowtok = seqbase + r0 * 64 + col0; kv_load(cur, P, P_NAK + 64 * h, P_NAV + 64 * h, lane, fq, [&](int t) { return rowtok + 16 * t + fr; }, [&](int key) { return rowtok + key; }); }
#pragma unroll 2
    for (int kr = 0; kr < 8; ++kr) {
        const int krow = r0 + kr;
        KVRegs nxt;
        { const int rowtok = seqbase + min(krow + 1, r0 + 7) * 64 + col0;
          kv_load(nxt, P, P_NAK + 64 * h, P_NAV + 64 * h, lane, fq, [&](int t) { return rowtok + 16 * t + fr; }, [&](int key) { return rowtok + key; }); }
        const float* rrow = rp + (krow - r + 7) * 31;
        float bias[2][4]; bool valid[2][4];
#pragma unroll
        for (int t = 0; t < 2; ++t)
#pragma unroll
            for (int g = 0; g < 4; ++g) { const int kc = col0 + 16 * t + 4 * fq + g; valid[t][g] = (kc >= win0) && (kc < win0 + 16);
                bias[t][g] = rrow[min(max(kc - qcol + 15, 0), 30)]; }
        attn_stage_v(vt, cur, lane);
        f32x4 sacc[2];
#pragma unroll
        for (int t = 0; t < 2; ++t) { sacc[t] = (f32x4){0.f, 0.f, 0.f, 0.f};
#pragma unroll
            for (int ks = 0; ks < 2; ++ks) sacc[t] = MFMA16(cur.k[t][ks], qf[ks], sacc[t]); }
        float s[2][4];
#pragma unroll
        for (int t = 0; t < 2; ++t)
#pragma unroll
            for (int g = 0; g < 4; ++g) s[t][g] = valid[t][g] ? sacc[t][g] * 0.125f + bias[t][g] : -1e30f;
        attn_update(st, s, valid, vt, fr, fq);
        cur = nxt;
    }
    float l = st.l; l += __shfl_xor(l, 16); l += __shfl_xor(l, 32);
    const float inv = 1.f / l;
    bf16_t* orow = BR + (size_t)qtok * DM + 0 + 64 * h + 4 * fq;
#pragma unroll
    for (int dt = 0; dt < 4; ++dt) { u32x2 o; o.x = pk2(st.o[dt][0] * inv, st.o[dt][1] * inv); o.y = pk2(st.o[dt][2] * inv, st.o[dt][3] * inv); *(u32x2*)(orow + 16 * dt) = o; }
}

constexpr int DL_OLD = 68;
constexpr int DL_O_OFF = 8 * VT_BYTES;
constexpr int DL_M_OFF = DL_O_OFF + 256 * DL_OLD * 4;
constexpr int DL_L_OFF = DL_M_OFF + 1024;
__device__ __forceinline__ void dl_item(int item, const bf16_t* P, bf16_t* BR, int L, LAS unsigned char* lds) {
    const int tid = opaque_tid(), lane = tid & 63, wave = tid >> 6, fr = lane & 15, fq = lane >> 4;
    const int sp = item >> 2, h = item & 3;
    const int t0 = sp * 256, seq = t0 / L, seqbase = seq * L, p0 = t0 - seqbase;
    LAS bf16_t* vt = (LAS bf16_t*)(lds + wave * VT_BYTES);
    LAS float* OL = (LAS float*)(lds + DL_O_OFF); LAS float* ML = (LAS float*)(lds + DL_M_OFF); LAS float* LL = (LAS float*)(lds + DL_L_OFF);
    __syncthreads();
    for (int e = tid; e < 256 * DL_OLD; e += NTHR) OL[e] = 0.f;
    if (tid < 256) { ML[tid] = -1e30f; LL[tid] = 0.f; }
    __syncthreads();
    const float slope = (h == 0) ? 0.25f : (h == 1) ? 0.0625f : (h == 2) ? 0.015625f : 0.00390625f;
    for (int cfg = 0; cfg < 3; ++cfg) {
        const int dsh = 2 * cfg, dil = 1 << dsh, n = L >> dsh;
        for (int qi = 0; qi < 2; ++qi) {
            const int qt = 2 * wave + qi;
            const int r = (cfg == 0) ? 0 : (cfg == 1) ? (qt >> 2) : qt;
            const int sub = (cfg == 0) ? qt : (cfg == 1) ? (qt & 3) : 0;
            const int j0 = (p0 >> dsh) + 16 * sub, qj = j0 + fr;
            const int qtok = seqbase + (qj << dsh) + r;
            bf16x8 qf[2];
#pragma unroll
            for (int ks = 0; ks < 2; ++ks) qf[ks] = *(const bf16x8*)(P + (size_t)qtok * NIN + P_DQ + 64 * h + 32 * ks + 8 * fq);
            AttnState st;
#pragma unroll
            for (int dt = 0; dt < 4; ++dt) st.o[dt] = (f32x4){0.f, 0.f, 0.f, 0.f};
            st.m = -1e30f; st.l = 0.f;
            int s_lo = 0, s_hi = 5;
            while (s_lo < 5 && j0 - 64 + 32 * s_lo + 32 <= 0) ++s_lo;
            while (s_hi > s_lo && j0 - 64 + 32 * (s_hi - 1) >= n) --s_hi;
            KVRegs cur;
            { const int kb = j0 - 64 + 32 * s_lo;
              kv_load(cur, P, P_DK + 64 * h, P_DV + 64 * h, lane, fq, [&](int t) { const int kj = min(max(kb + 16 * t + fr, 0), n - 1); return seqbase + (kj << dsh) + r; },
                      [&](int key) { const int kj = min(max(kb + key, 0), n - 1); return seqbase + (kj << dsh) + r; }); }
            for (int sx = s_lo; sx < s_hi; ++sx) {
                const int kb = j0 - 64 + 32 * sx;
                KVRegs nxt;
                { const int kb2 = j0 - 64 + 32 * min(sx + 1, s_hi - 1);
                  kv_load(nxt, P, P_DK + 64 * h, P_DV + 64 * h, lane, fq, [&](int t) { const int kj = min(max(kb2 + 16 * t + fr, 0), n - 1); return seqbase + (kj << dsh) + r; },
                          [&](int key) { const int kj = min(max(kb2 + key, 0), n - 1); return seqbase + (kj << dsh) + r; }); }
                attn_stage_v(vt, cur, lane);
                f32x4 sacc[2];
#pragma unroll
                for (int t = 0; t < 2; ++t) { sacc[t] = (f32x4){0.f, 0.f, 0.f, 0.f};
#pragma unroll
                    for (int ks = 0; ks < 2; ++ks) sacc[t] = MFMA16(cur.k[t][ks], qf[ks], sacc[t]); }
                float s[2][4]; bool valid[2][4];
#pragma unroll
                for (int t = 0; t < 2; ++t)
#pragma unroll
                    for (int g = 0; g < 4; ++g) { const int kj = kb + 16 * t + 4 * fq + g; const int dist = abs(kj - qj);
                        const bool v = (dist <= 64) && (kj >= 0) && (kj < n);
                        valid[t][g] = v; s[t][g] = v ? sacc[t][g] * 0.125f - slope * (float)(dist << dsh) : -1e30f; }
                attn_update(st, s, valid, vt, fr, fq);
                cur = nxt;
            }
            float l = st.l; l += __shfl_xor(l, 16); l += __shfl_xor(l, 32);
            const int ql = ((16 * sub + fr) << dsh) + r;
            const float mo = ML[ql], lo = LL[ql], mn = fmaxf(mo, st.m), a = __expf(mo - mn), b = __expf(st.m - mn);
            LAS float* orow = OL + ql * DL_OLD + 4 * fq;
#pragma unroll
            for (int dt = 0; dt < 4; ++dt) { f32x4 ov = *(LAS f32x4*)(orow + 16 * dt); ov = ov * a + st.o[dt] * b; *(LAS f32x4*)(orow + 16 * dt) = ov; }
            __builtin_amdgcn_wave_barrier();
            if (fq == 0) { ML[ql] = mn; LL[ql] = lo * a + l * b; }
        }
        __syncthreads();
    }
    for (int e = tid; e < 256 * 8; e += NTHR) { const int ql = e >> 3, c8 = e & 7;
        const float inv = 1.f / LL[ql]; const LAS float* orow = OL + ql * DL_OLD + 8 * c8;
        const f32x4 a = *(const LAS f32x4*)orow, b = *(const LAS f32x4*)(orow + 4);
        u32x4 o; o.x = pk2(a[0] * inv, a[1] * inv); o.y = pk2(a[2] * inv, a[3] * inv); o.z = pk2(b[0] * inv, b[1] * inv); o.w = pk2(b[2] * inv, b[3] * inv);
        *(u32x4*)(BR + (size_t)(t0 + ql) * DM + 768 + 64 * h + 8 * c8) = o; }
}

constexpr int SG_WLD = 136, SG_VLD = 136;
constexpr int SG_V_OFF = 128 * SG_WLD * 2;
__device__ __forceinline__ void sg_item(int item, const bf16_t* P, bf16_t* BR, const bf16_t* sgw  , const float* ln_g, const float* ln_b, const float* sgb  , LAS unsigned char* lds) {
    const int tid = opaque_tid(), lane = tid & 63, wave = tid >> 6, fr = lane & 15, fq = lane >> 4;
    const int nc = item >> 2, g = item & 3, t0 = nc * 128;
    LAS bf16_t* WL = (LAS bf16_t*)lds; LAS bf16_t* VT = (LAS bf16_t*)(lds + SG_V_OFF);
    __syncthreads();
    for (int e = tid; e < 128 * 16; e += NTHR) { const int row = e >> 4, c8 = e & 15;
        *(LAS u32x4*)(WL + row * SG_WLD + 8 * c8) = *(const u32x4*)(sgw + ((size_t)g * 128 + row) * 128 + 8 * c8); }
    {
        const int s = tid >> 2, qd = tid & 3;
        const bf16_t* vp = P + (size_t)(t0 + s) * NIN + P_SV + 64 * qd;
        float sum = 0.f, sq = 0.f;
#pragma unroll
        for (int i = 0; i < 8; ++i) { const u32x4 w = *(const u32x4*)(vp + 8 * i);
            const unsigned ww[4] = {w.x, w.y, w.z, w.w};
#pragma unroll
            for (int j = 0; j < 4; ++j) { const float a = gelu_tanh(bflo(ww[j])), b = gelu_tanh(bfhi(ww[j])); sum += a + b; sq += a * a + b * b; } }
        sum += __shfl_xor(sum, 1); sum += __shfl_xor(sum, 2); sq += __shfl_xor(sq, 1); sq += __shfl_xor(sq, 2);
        const float mean = sum * (1.f / 256.f), var = fmaxf(sq * (1.f / 256.f) - mean * mean, 0.f), rstd = rsqrtf(var + EPSV);
        const bf16_t* gp = P + (size_t)(t0 + s) * NIN + P_SV + 64 * g + 16 * qd;
#pragma unroll
        for (int i = 0; i < 2; ++i) { const u32x4 w = *(const u32x4*)(gp + 8 * i);
            const unsigned ww[4] = {w.x, w.y, w.z, w.w};
#pragma unroll
            for (int j = 0; j < 4; ++j) {
                const int c = 16 * qd + 8 * i + 2 * j, ch = 64 * g + c;
                const float a = (gelu_tanh(bflo(ww[j])) - mean) * rstd * ln_g[ch] + ln_b[ch], b = (gelu_tanh(bfhi(ww[j])) - mean) * rstd * ln_g[ch + 1] + ln_b[ch + 1];
                VT[c * SG_VLD + s] = f2bf(a); VT[(c + 1) * SG_VLD + s] = f2bf(b); } }
    }
    __syncthreads();
    f32x4 acc[4];
#pragma unroll
    for (int ni = 0; ni < 4; ++ni) acc[ni] = (f32x4){0.f, 0.f, 0.f, 0.f};
#pragma unroll
    for (int ks = 0; ks < 4; ++ks) { const bf16x8 a = *(const LAS bf16x8*)(WL + (16 * wave + fr) * SG_WLD + 32 * ks + 8 * fq);
#pragma unroll
        for (int ni = 0; ni < 4; ++ni) { const bf16x8 b = *(const LAS bf16x8*)(VT + (16 * ni + fr) * SG_VLD + 32 * ks + 8 * fq); acc[ni] = MFMA16(a, b, acc[ni]); } }
#pragma unroll
    for (int reg = 0; reg < 4; ++reg) { const int t = 16 * wave + 4 * fq + reg; const float bs = sgb[g * 128 + t];
        const bf16_t* up = P + (size_t)(t0 + t) * NIN + P_SU + 64 * g; bf16_t* op = BR + (size_t)(t0 + t) * DM + 512 + 64 * g;
#pragma unroll
        for (int ni = 0; ni < 4; ++ni) { const int c = 16 * ni + fr; const float u = gelu_tanh(bf2f(up[c])); op[c] = f2bf(u * (acc[ni][reg] + bs)); } }
}

constexpr int HG_LF_OFF = 0;
constexpr int HG_T_OFF = 32768;
constexpr int HG_TLD = 72, HG_TB = 64 * HG_TLD * 2;
__device__ __forceinline__ float hg_lb(const float* hg_lb_in, int dir, int l, int ch) {
    const float* q = hg_lb_in + (size_t)dir * NLAYER * 256 + ch;
    const float a0 = q[0], a1 = q[256], a2 = q[512], a3 = q[768];
    const float mx = fmaxf(fmaxf(a0, a1), fmaxf(a2, a3));
    const float e0 = __expf(a0 - mx), e1 = __expf(a1 - mx), e2 = __expf(a2 - mx), e3 = __expf(a3 - mx);
    const float num = (l >= 1 ? e1 : 0.f) + (l >= 2 ? e2 : 0.f) + (l >= 3 ? e3 : 0.f);
    return num / (e0 + e1 + e2 + e3);
}
constexpr int HG_TOT_OFF = HG_T_OFF + 10 * HG_TB;
constexpr int HG_LB_OFF = HG_TOT_OFF + 2048;
__device__ __forceinline__ void hg_front(const bf16_t* P, int t0, int h, int l, const float* hg_lb_in, LAS unsigned char* lds) {
    const int tid = opaque_tid();
    LAS float* LF = (LAS float*)(lds + HG_LF_OFF); LAS float* TOT = (LAS float*)(lds + HG_TOT_OFF); LAS float* LBS = (LAS float*)(lds + HG_LB_OFF);
    if (tid < 128) LBS[tid] = hg_lb(hg_lb_in, tid >> 6, l, 64 * h + (tid & 63));
    __syncthreads();
    {
        const int s = tid >> 3, i0 = 8 * (tid & 7);
#pragma unroll
        for (int dir = 0; dir < 2; ++dir) {
            const u32x4 w = *(const u32x4*)(P + (size_t)(t0 + s) * NIN + (dir ? P_FB : P_FF) + 64 * h + i0);
            const unsigned ww[4] = {w.x, w.y, w.z, w.w};
#pragma unroll
            for (int j = 0; j < 4; ++j) {
                const float lb0 = LBS[dir * 64 + i0 + 2 * j], lb1 = LBS[dir * 64 + i0 + 2 * j + 1];
                const float f0 = lb0 + (1.f - lb0) * sigmoidf_(bflo(ww[j])), f1 = lb1 + (1.f - lb1) * sigmoidf_(bfhi(ww[j]));
                LF[dir * 4096 + s * 64 + i0 + 2 * j] = __logf(f0); LF[dir * 4096 + s * 64 + i0 + 2 * j + 1] = __logf(f1); }
        }
    }
    __syncthreads();
    {
        const int dir = tid >> 8, seg = (tid >> 6) & 3, i = tid & 63;
        LAS float* a = LF + dir * 4096 + i;
        float r[16]; float run = 0.f;
#pragma unroll
        for (int k = 0; k < 16; ++k) { const int sidx = dir ? (16 * seg + 15 - k) : (16 * seg + k); run += a[sidx * 64]; r[k] = run; }
        TOT[(dir * 4 + seg) * 64 + i] = run;
        __syncthreads();
        float off = 0.f;
#pragma unroll
        for (int q = 0; q < 4; ++q) { const float tq = TOT[(dir * 4 + q) * 64 + i]; off += (dir ? (q > seg) : (q < seg)) ? tq : 0.f; }
#pragma unroll
        for (int k = 0; k < 16; ++k) { const int sidx = dir ? (16 * seg + 15 - k) : (16 * seg + k); a[sidx * 64] = r[k] + off; }
    }
    __syncthreads();
}
__device__ __forceinline__ float hg_kk(LAS unsigned char* lds, int dir, int i, float x) { const float lb = ((LAS float*)(lds + HG_LB_OFF))[dir * 64 + i]; return (1.f - lb) * sigmoidf_(-x); }

__device__ __forceinline__ void hgA_item(int item, const bf16_t* P, float* HGST, float* HGD, int l, const float* hg_lb_in, LAS unsigned char* lds) {
    const int tid = opaque_tid(), lane = tid & 63, wave = tid >> 6, fr = lane & 15, fq = lane >> 4;
    const int cc = item >> 2, h = item & 3, t0 = cc * 64;
    __syncthreads();
    hg_front(P, t0, h, l, hg_lb_in, lds);
    LAS float* LF = (LAS float*)(lds + HG_LF_OFF);
    LAS bf16_t* KD0 = (LAS bf16_t*)(lds + HG_T_OFF); LAS bf16_t* KD1 = (LAS bf16_t*)(lds + HG_T_OFF + HG_TB); LAS bf16_t* VT = (LAS bf16_t*)(lds + HG_T_OFF + 2 * HG_TB);
    {
        const int s = tid >> 3, i0 = 8 * (tid & 7);
#pragma unroll
        for (int dir = 0; dir < 2; ++dir) {
            const u32x4 w = *(const u32x4*)(P + (size_t)(t0 + s) * NIN + (dir ? P_FB : P_FF) + 64 * h + i0);
            const unsigned ww[4] = {w.x, w.y, w.z, w.w};
            LAS bf16_t* KD = dir ? KD1 : KD0; const LAS float* A = LF + dir * 4096; const int slast = dir ? 0 : 63;
#pragma unroll
            for (int j = 0; j < 8; ++j) { const int i = i0 + j; const float x = (j & 1) ? bfhi(ww[j >> 1]) : bflo(ww[j >> 1]);
                const float kd = hg_kk(lds, dir, i, x) * __expf(A[slast * 64 + i] - A[s * 64 + i]);
                KD[i * HG_TLD + s] = f2bf(kd); }
        }
        const u32x4 w = *(const u32x4*)(P + (size_t)(t0 + s) * NIN + P_HI + 64 * h + i0);
        const unsigned ww[4] = {w.x, w.y, w.z, w.w};
#pragma unroll
        for (int j = 0; j < 8; ++j) VT[(i0 + j) * HG_TLD + s] = (bf16_t)((j & 1) ? (ww[j >> 1] >> 16) : (ww[j >> 1] & 0xffffu));
        if (tid < 128) { const int dir = tid >> 6, i = tid & 63; HGD[((size_t)(cc * 4 + h) * 2 + dir) * 64 + i] = __expf(LF[dir * 4096 + (dir ? 0 : 63) * 64 + i]); }
    }
    __syncthreads();
    {
        const int dir = wave >> 2, mt = wave & 3; const LAS bf16_t* KD = dir ? KD1 : KD0;
        f32x4 acc[4];
#pragma unroll
        for (int ni = 0; ni < 4; ++ni) acc[ni] = (f32x4){0.f, 0.f, 0.f, 0.f};
#pragma unroll
        for (int ks = 0; ks < 2; ++ks) { const bf16x8 a = *(const LAS bf16x8*)(VT + (16 * mt + fr) * HG_TLD + 32 * ks + 8 * fq);
#pragma unroll
            for (int ni = 0; ni < 4; ++ni) { const bf16x8 b = *(const LAS bf16x8*)(KD + (16 * ni + fr) * HG_TLD + 32 * ks + 8 * fq); acc[ni] = MFMA16(a, b, acc[ni]); } }
        float* dst = HGST + ((size_t)(cc * 4 + h) * 2 + dir) * 4096;
#pragma unroll
        for (int ni = 0; ni < 4; ++ni)
#pragma unroll
            for (int reg = 0; reg < 4; ++reg) dst[(16 * mt + 4 * fq + reg) * 64 + 16 * ni + fr] = acc[ni][reg];
    }
}
__device__ __forceinline__ void hgB_phase(float* HGST, const float* HGD, int L) {
    const int ncs = L >> 6, nseq = TC / L, total = nseq * 8 * 4096;
    for (int e = blockIdx.x * NTHR + opaque_tid(); e < total; e += gridDim.x * NTHR) {
        const int ji = e & 4095, dir = (e >> 12) & 1, h = (e >> 13) & 3, seq = e >> 15, i = ji & 63;
        float S = 0.f;
        for (int c0 = 0; c0 < ncs; c0 += 8) {
            float u[8], d[8];
#pragma unroll
            for (int k = 0; k < 8; ++k) { const int cc = seq * ncs + (dir ? (ncs - 1 - (c0 + k)) : (c0 + k)); const size_t o = ((size_t)(cc * 4 + h) * 2 + dir);
                u[k] = HGST[o * 4096 + ji]; d[k] = HGD[o * 64 + i]; }
#pragma unroll
            for (int k = 0; k < 8; ++k) { const int cc = seq * ncs + (dir ? (ncs - 1 - (c0 + k)) : (c0 + k)); const size_t o = ((size_t)(cc * 4 + h) * 2 + dir);
                HGST[o * 4096 + ji] = S; S = S * d[k] + u[k]; }
        }
    }
}
__device__ __forceinline__ void hgC_item(int item, const bf16_t* P, bf16_t* BR, const float* HGST, int l, const float* hg_lb_in, const float* gnorm  , LAS unsigned char* lds) {
    const int tid = opaque_tid(), lane = tid & 63, wave = tid >> 6, fr = lane & 15, fq = lane >> 4;
    const int cc = item >> 2, h = item & 3, t0 = cc * 64;
    __syncthreads();
    hg_front(P, t0, h, l, hg_lb_in, lds);
    LAS float* LF = (LAS float*)(lds + HG_LF_OFF);
#define HGT(k) ((LAS bf16_t*)(lds + HG_T_OFF + (k) * HG_TB))
    {
        const int s = tid >> 3, i0 = 8 * (tid & 7);
        const u32x4 wq = *(const u32x4*)(P + (size_t)(t0 + s) * NIN + P_HQ + 64 * h + i0);
        const unsigned wqq[4] = {wq.x, wq.y, wq.z, wq.w};
#pragma unroll
        for (int dir = 0; dir < 2; ++dir) {
            const u32x4 w = *(const u32x4*)(P + (size_t)(t0 + s) * NIN + (dir ? P_FB : P_FF) + 64 * h + i0);
            const unsigned ww[4] = {w.x, w.y, w.z, w.w};
            const LAS float* A = LF + dir * 4096;
            u32x4 oq, ok, oe; unsigned* oqp = (unsigned*)&oq; unsigned* okp = (unsigned*)&ok; unsigned* oep = (unsigned*)&oe;
#pragma unroll
            for (int j2 = 0; j2 < 4; ++j2) { float qt[2], kt[2], qe[2];
#pragma unroll
                for (int e = 0; e < 2; ++e) { const int i = i0 + 2 * j2 + e; const float x = e ? bfhi(ww[j2]) : bflo(ww[j2]); const float qs = siluf_(e ? bfhi(wqq[j2]) : bflo(wqq[j2]));
                    const float a = A[s * 64 + i], ref = A[32 * 64 + i];
                    const float d1 = fminf(fmaxf(a - ref, -80.f), 80.f);
                    qt[e] = qs * __expf(d1); kt[e] = hg_kk(lds, dir, i, x) * __expf(-d1); qe[e] = qs * __expf(a); }
                oqp[j2] = pk2(qt[0], qt[1]); okp[j2] = pk2(kt[0], kt[1]); oep[j2] = pk2(qe[0], qe[1]); }
            *(LAS u32x4*)(HGT(0 + dir) + s * HG_TLD + i0) = oq; *(LAS u32x4*)(HGT(2 + dir) + s * HG_TLD + i0) = ok; *(LAS u32x4*)(HGT(4 + dir) + s * HG_TLD + i0) = oe;
        }
        const u32x4 w = *(const u32x4*)(P + (size_t)(t0 + s) * NIN + P_HI + 64 * h + i0);
        const unsigned ww[4] = {w.x, w.y, w.z, w.w};
        LAS bf16_t* VT = HGT(6);
#pragma unroll
        for (int j = 0; j < 8; ++j) VT[(i0 + j) * HG_TLD + s] = (bf16_t)((j & 1) ? (ww[j >> 1] >> 16) : (ww[j >> 1] & 0xffffu));
        { const int dir = tid >> 8, j = (tid >> 2) & 63, i4 = 16 * (tid & 3);
          const float* src = HGST + ((size_t)(cc * 4 + h) * 2 + dir) * 4096 + j * 64 + i4; LAS bf16_t* dstp = HGT(8 + dir) + j * HG_TLD + i4;
#pragma unroll
          for (int q = 0; q < 2; ++q) { const f32x4 a = *(const f32x4*)(src + 8 * q), b = *(const f32x4*)(src + 8 * q + 4);
              u32x4 o; o.x = pk2(a[0], a[1]); o.y = pk2(a[2], a[3]); o.z = pk2(b[0], b[1]); o.w = pk2(b[2], b[3]); *(LAS u32x4*)(dstp + 8 * q) = o; } }
    }
    __syncthreads();
    {
        const int mt = wave >> 1;
#pragma unroll
        for (int q = 0; q < 2; ++q) { const int nt = 2 * (wave & 1) + q;
            f32x4 af = (f32x4){0.f, 0.f, 0.f, 0.f}, ab = (f32x4){0.f, 0.f, 0.f, 0.f};
            if (nt <= mt) {
#pragma unroll
                for (int ks = 0; ks < 2; ++ks) af = MFMA16(*(const LAS bf16x8*)(HGT(0) + (16 * mt + fr) * HG_TLD + 32 * ks + 8 * fq), *(const LAS bf16x8*)(HGT(2) + (16 * nt + fr) * HG_TLD + 32 * ks + 8 * fq), af); }
            if (nt >= mt) {
#pragma unroll
                for (int ks = 0; ks < 2; ++ks) ab = MFMA16(*(const LAS bf16x8*)(HGT(1) + (16 * mt + fr) * HG_TLD + 32 * ks + 8 * fq), *(const LAS bf16x8*)(HGT(3) + (16 * nt + fr) * HG_TLD + 32 * ks + 8 * fq), ab); }
            const int s = 16 * nt + fr;
#pragma unroll
            for (int reg = 0; reg < 4; ++reg) { const int t = 16 * mt + 4 * fq + reg;
                const float v = ((s <= t) ? af[reg] : 0.f) + ((s >= t) ? ab[reg] : 0.f);
                HGT(7)[t * HG_TLD + s] = f2bf(v); } }
    }
    __syncthreads();
    if (wave < 4) {
        const int mt = wave;
        f32x4 acc[4];
#pragma unroll
        for (int ni = 0; ni < 4; ++ni) acc[ni] = (f32x4){0.f, 0.f, 0.f, 0.f};
#pragma unroll
        for (int pr = 0; pr < 3; ++pr) { const LAS bf16_t* Am = (pr == 0) ? HGT(7) : (pr == 1) ? HGT(4) : HGT(5); const LAS bf16_t* Bm = (pr == 0) ? HGT(6) : (pr == 1) ? HGT(8) : HGT(9);
#pragma unroll
            for (int ks = 0; ks < 2; ++ks) { const bf16x8 a = *(const LAS bf16x8*)(Am + (16 * mt + fr) * HG_TLD + 32 * ks + 8 * fq);
#pragma unroll
                for (int ni = 0; ni < 4; ++ni) acc[ni] = MFMA16(a, *(const LAS bf16x8*)(Bm + (16 * ni + fr) * HG_TLD + 32 * ks + 8 * fq), acc[ni]); } }
#pragma unroll
        for (int reg = 0; reg < 4; ++reg) { const int t = 16 * mt + 4 * fq + reg;
            float ss = acc[0][reg] * acc[0][reg] + acc[1][reg] * acc[1][reg] + acc[2][reg] * acc[2][reg] + acc[3][reg] * acc[3][reg];
            ss += __shfl_xor(ss, 1); ss += __shfl_xor(ss, 2); ss += __shfl_xor(ss, 4); ss += __shfl_xor(ss, 8);
            const float rn = rsqrtf(ss * (1.f / 64.f) + EPSV);
            const bf16_t* gp = P + (size_t)(t0 + t) * NIN + P_HGATE + 64 * h; bf16_t* op = BR + (size_t)(t0 + t) * DM + 256 + 64 * h;
#pragma unroll
            for (int ni = 0; ni < 4; ++ni) { const int j = 16 * ni + fr; op[j] = f2bf(acc[ni][reg] * rn * gnorm[64 * h + j] * siluf_(bf2f(gp[j]))); } }
    }
#undef HGT
}

#define XB_TMO      128
#define XB_XCNT(j)  (256  + 64 * (j))
#define XB_XSUB(j)  (1280 + 64 * (j))
#define XB_XGEN(j)  (2304 + 64 * (j))
#define XB_TOP      3328
#define XB_TOPGEN   3392
#define XCD_BAR_WORDS 3456
#define XB_SPIN_CAP (1u << 22)
__device__ __forceinline__ unsigned xb_ld(unsigned* p)              { return __hip_atomic_load(p, __ATOMIC_RELAXED, __HIP_MEMORY_SCOPE_AGENT); }
__device__ __forceinline__ unsigned xb_add(unsigned* p, unsigned v) { return __hip_atomic_fetch_add(p, v, __ATOMIC_RELAXED, __HIP_MEMORY_SCOPE_AGENT); }
__device__ __forceinline__ unsigned xb_xcc_id() { return (unsigned)__builtin_amdgcn_s_getreg((3 << 11) | 20) & 0xFu; }
#define XB_SPIN(cond, bar) do { unsigned _sp = 0; while (cond) { __builtin_amdgcn_s_sleep(1); \
    if ((++_sp & 255u) == 0u) { if (xb_ld(&(bar)[XB_TMO])) break; if (_sp > XB_SPIN_CAP) { atomicAdd(&(bar)[XB_TMO], 1u); break; } } } } while (0)
struct XcdBarrier { unsigned* bar; unsigned x; volatile LAS unsigned* st; };
__device__ __forceinline__ XcdBarrier xcd_barrier_post(unsigned* bar, volatile LAS unsigned* st) {
    XcdBarrier b; b.bar = bar; b.x = xb_xcc_id(); b.st = st;
    if (threadIdx.x == 0) (void)xb_add(&bar[XB_XCNT(b.x)], 1u);
    return b;
}
__device__ __forceinline__ void xcd_barrier_complete(unsigned* bar, unsigned x, unsigned& nloc, unsigned& nx) {
    const unsigned G = gridDim.x * gridDim.y * gridDim.z;
    unsigned sum, cnt, mine, sp = 0u;
    for (;;) {
        sum = 0u; cnt = 0u; mine = 0u;
#pragma unroll
        for (unsigned j = 0; j < 16; ++j) { const unsigned c = xb_ld(&bar[XB_XCNT(j)]); sum += c; cnt += (c > 0u) ? 1u : 0u; mine = (j == x) ? c : mine; }
        if (sum == G) break;
        __builtin_amdgcn_s_sleep(1);
        if ((++sp & 255u) == 0u) { if (xb_ld(&bar[XB_TMO])) break; if (sp > XB_SPIN_CAP) { atomicAdd(&bar[XB_TMO], 1u); break; } }
    }
    nloc = mine > 0u ? mine : 1u; nx = cnt > 0u ? cnt : 1u;
}
__device__ __forceinline__ void xcd_barrier(const XcdBarrier& b) {
    asm volatile("s_waitcnt vmcnt(0)" ::: "memory");
    __syncthreads();
    if (threadIdx.x == 0) {
        unsigned* bar = b.bar;
        __builtin_amdgcn_s_waitcnt(0);
        unsigned nloc = b.st[0], nx = b.st[1];
        if (nloc == 0u) { xcd_barrier_complete(bar, b.x, nloc, nx); b.st[0] = nloc; b.st[1] = nx; }
        const unsigned old = xb_add(&bar[XB_XSUB(b.x)], 1u);
        const unsigned gen = old / nloc;
        if (old + 1u == (gen + 1u) * nloc) {
            __builtin_amdgcn_fence(__ATOMIC_RELEASE, "agent");
            asm volatile("s_waitcnt vmcnt(0)" ::: "memory");
            const unsigned og = xb_add(&bar[XB_TOP], 1u);
            const unsigned tg = og / nx;
            if (og + 1u == (tg + 1u) * nx) xb_add(&bar[XB_TOPGEN], 1u);
            else XB_SPIN(xb_ld(&bar[XB_TOPGEN]) == tg, bar);
            __builtin_amdgcn_fence(__ATOMIC_ACQUIRE, "agent");
            xb_add(&bar[XB_XGEN(b.x)], 1u);
            asm volatile("s_waitcnt vmcnt(0)" ::: "memory");
        } else {
            XB_SPIN(xb_ld(&bar[XB_XGEN(b.x)]) == gen, bar);
            __builtin_amdgcn_fence(__ATOMIC_ACQUIRE, "agent");
            asm volatile("s_waitcnt vmcnt(0)" ::: "memory");
        }
    }
    __syncthreads();
}

#define GRID_SYNC() xcd_barrier(xbar)
#ifndef MIXREP
#define MIXREP 1
#endif

__global__ void __launch_bounds__(512, 2) fwd_megakernel(Params p) {
    extern __shared__ __attribute__((aligned(16))) unsigned char smem[];
    LAS unsigned char* lds = (LAS unsigned char*)smem;
    cg::grid_group grid = cg::this_grid();
    unsigned char* ws = p.ws;
    const int G = gridDim.x, c = blockIdx.x;
    float* MOD = (float*)(ws + OFF_MOD);
    bf16_t* H = (bf16_t*)(ws + OFF_H); bf16_t* P = (bf16_t*)(ws + OFF_P); bf16_t* BR = (bf16_t*)(ws + OFF_BR); bf16_t* MG = (bf16_t*)(ws + OFF_MG);
    bf16_t* ACT = P;
    float* HGST = (float*)(ws + OFF_HGST); float* HGD = (float*)(ws + OFF_HGD);

    volatile LAS unsigned* xst = (volatile LAS unsigned*)(lds + LDS_BYTES - 16);
    if (threadIdx.x == 0) { xst[0] = 0u; xst[1] = 0u; }
    __syncthreads();
    const XcdBarrier xbar = xcd_barrier_post((unsigned*)(ws + OFF_CTL), xst);
#ifndef SKIP_PRO
    phase_prologue(p, lds);
#endif
    grid.sync();
    phase_mod_reduce(p);
    GRID_SYNC();

    for (int ck = 0; ck < NCHUNK; ++ck) {
        const int L = chunk_L(ck), bbase = chunk_bbase(ck);
        float* X = p.out + (size_t)ck * TC * DM;
        const float* xin = (ck < 2) ? p.in[0] + (size_t)ck * TC * DM : p.in[1];
        for (int l = 0; l < NLAYER; ++l) {
            const float* modl = MOD + (size_t)l * 6144;
            phase_norm_mod(l == 0 ? xin : X, l == 0 ? X : nullptr, H, p.in[6] + l * DM, modl + 0, modl + 1024, L, bbase);
            GRID_SYNC();
#ifndef SKIP_G1
            { SchedStd S; S.to.init(TC / 256, NIN / 256, G, c); S.A = (const char*)H; S.B = (const char*)(ws + OFF_WIN) + (size_t)l * NIN * DM * 2; S.atile = 256 * DM * 2; S.btile = 256 * DM * 2; S.nt = DM / 64;
              EpiProj E; E.O = P; E.ldc = NIN;
              pg8::gemm_phase(lds, DM, DM, S, E); }
            #endif
            GRID_SYNC();
            for (int rep = 0; rep < MIXREP; ++rep) {
#ifndef SKIP_MIX1
            for (int it = c; it < 256 + 1024; it += G) {
                if (it < 256) dl_item(it, P, BR, L, lds);
                else hgA_item(it - 256, P, HGST, HGD, l, p.in[14], lds);
            }
            #endif
            GRID_SYNC();
#ifndef SKIP_MIX2
            hgB_phase(HGST, HGD, L);
            for (int it = c; it < 512 + 512; it += G) {
                if (it < 512) { __syncthreads(); na_item(it, P, BR, p.in[13] + (size_t)l * 4 * 15 * 31, L, lds); }
                else sg_item(it - 512, P, BR, (const bf16_t*)(ws + OFF_SGW) + (size_t)l * 4 * 128 * 128, p.in[16] + l * 256, p.in[17] + l * 256, p.in[19] + l * 512, lds);
            }
            #endif
            GRID_SYNC();
#ifndef SKIP_MIX3
            for (int it = c; it < 1024; it += G) hgC_item(it, P, BR, HGST, l, p.in[14], p.in[15] + l * 256, lds);
            #endif
            GRID_SYNC();
            }
#ifndef SKIP_MERGE
            { SchedMerge S; S.to.init(TC / 256, DM / 256, G, c); S.H = (const char*)H; S.BR = (const char*)BR; S.WG = (const char*)(ws + OFF_WG) + (size_t)l * 4 * DM * DM * 2; S.WB = (const char*)(ws + OFF_WB) + (size_t)l * DM * DM * 2;
              EpiMerge E; E.MG = MG; E.bgate = p.in[10] + (size_t)l * 4 * DM; E.scr = (unsigned char*)P + (size_t)c * MERGE_SCR_PER_BLOCK;
              pg8::gemm_phase(lds, DM, DM, S, E); }
            #endif
            GRID_SYNC();
#ifndef SKIP_WO
            { SchedStd S; S.to.init(TC / 256, DM / 256, G, c); S.A = (const char*)MG; S.B = (const char*)(ws + OFF_WO) + (size_t)l * DM * DM * 2; S.atile = 256 * DM * 2; S.btile = 256 * DM * 2; S.nt = DM / 64;
              EpiRes E; E.X = X; E.gm = modl + 2048; E.L = L; E.bbase = bbase;
              pg8::gemm_phase(lds, DM, DM, S, E); }
            #endif
            GRID_SYNC();
            phase_norm_mod(X, nullptr, H, p.in[7] + l * DM, modl + 3072, modl + 4096, L, bbase);
            GRID_SYNC();
#ifndef SKIP_F1
            { SchedStd S; S.to.init(TC / 256, 2 * DFF / 256, G, c); S.A = (const char*)H; S.B = (const char*)(ws + OFF_WGU) + (size_t)l * 2 * DFF * DM * 2; S.atile = 256 * DM * 2; S.btile = 256 * DM * 2; S.nt = DM / 64;
              EpiAct E; E.O = ACT;
              pg8::gemm_phase(lds, DM, DM, S, E); }
            #endif
            GRID_SYNC();
#ifndef SKIP_F2
            { SchedStd S; S.to.init(TC / 256, DM / 256, G, c); S.A = (const char*)ACT; S.B = (const char*)(ws + OFF_WD) + (size_t)l * DM * DFF * 2; S.atile = (size_t)256 * DFF * 2; S.btile = (size_t)256 * DFF * 2; S.nt = DFF / 64;
              EpiRes E; E.X = X; E.gm = modl + 5120; E.L = L; E.bbase = bbase;
              pg8::gemm_phase(lds, DFF, DFF, S, E); }
            #endif
            GRID_SYNC();
        }
        phase_final_norm(X, p.in[23]);
    }
}

extern "C" void kernel_launch(void* const* d_in, const int* in_sizes, int n_in, void* d_out, int out_size, void* d_ws, size_t ws_size, hipStream_t stream) {
    static int grid = 0;
    if (grid == 0) {
        if (n_in != 24 || ws_size < WS_END) { fprintf(stderr, "kernel_launch: unexpected n_in %d or ws_size %zu (need %zu)\n", n_in, ws_size, (size_t)WS_END); grid = -1; return; }
        int dev = 0, cus = 0, per_cu = 0;
        hipGetDevice(&dev);
        hipDeviceGetAttribute(&cus, hipDeviceAttributeMultiprocessorCount, dev);
        if (hipFuncSetAttribute((const void*)fwd_megakernel, hipFuncAttributeMaxDynamicSharedMemorySize, LDS_BYTES) != hipSuccess) { fprintf(stderr, "kernel_launch: hipFuncSetAttribute failed\n"); grid = -1; return; }
        hipOccupancyMaxActiveBlocksPerMultiprocessor(&per_cu, (const void*)fwd_megakernel, NTHR, LDS_BYTES);
        if (per_cu < 1) { fprintf(stderr, "kernel_launch: occupancy query says %d blocks per CU\n", per_cu); per_cu = 1; }
        (void)hipGetLastError();
        grid = cus;
        if (grid > 272) grid = 272;
    }
    if (grid < 0) return;
    if (hipMemsetAsync((char*)d_ws + OFF_CTL, 0, 16384, stream) != hipSuccess) { fprintf(stderr, "kernel_launch: memset of control words failed\n"); return; }
    Params p{};
    for (int i = 0; i < 24; ++i) p.in[i] = (const float*)d_in[i];
    p.out = (float*)d_out; p.ws = (unsigned char*)d_ws;
    void* args[] = {&p};
    hipError_t e = hipLaunchCooperativeKernel((const void*)fwd_megakernel, dim3(grid), dim3(NTHR), args, LDS_BYTES, stream);
    if (e != hipSuccess) fprintf(stderr, "cooperative launch failed: %s (grid %d)\n", hipGetErrorString(e), grid);
}
```

```cpp
#include <hip/hip_runtime.h>
#include <hip/hip_cooperative_groups.h>
#include <cstdio>
#include <cstdint>
namespace cg = cooperative_groups;

#define LAS __attribute__((address_space(3)))
typedef unsigned short bf16_t;
typedef short bf16x8 __attribute__((ext_vector_type(8)));
typedef float f32x4 __attribute__((ext_vector_type(4)));
typedef unsigned u32x4 __attribute__((ext_vector_type(4)));
typedef unsigned u32x2 __attribute__((ext_vector_type(2)));

constexpr int DM = 1024, TC = 16384, NCHUNK = 3, NIN = 3328, DFF = 2816, NLAYER = 4, NB = 20;
constexpr int P_NAQ = 0, P_NAK = 256, P_NAV = 512, P_FF = 768, P_FB = 1024, P_HQ = 1280, P_HI = 1536, P_HGATE = 1792, P_SU = 2048, P_SV = 2304, P_DQ = 2560, P_DK = 2816, P_DV = 3072;
constexpr float EPSV = 1e-6f;
constexpr int LDS_BYTES = 163840;
constexpr int NTHR = 512;

constexpr size_t OFF_CTL = 0;
constexpr size_t OFF_MOD = 16384;
constexpr size_t SZ_MOD = (size_t)NB * NLAYER * 6144 * 4;
constexpr size_t OFF_MODP = OFF_MOD + SZ_MOD;
constexpr size_t OFF_WIN = OFF_MODP + 8 * SZ_MOD;
constexpr size_t OFF_WG = OFF_WIN + (size_t)NLAYER * NIN * DM * 2;
constexpr size_t OFF_WB = OFF_WG + (size_t)NLAYER * 4 * DM * DM * 2;
constexpr size_t OFF_WO = OFF_WB + (size_t)NLAYER * DM * DM * 2;
constexpr size_t OFF_WGU = OFF_WO + (size_t)NLAYER * DM * DM * 2;
constexpr size_t OFF_WD = OFF_WGU + (size_t)NLAYER * 2 * DFF * DM * 2;
constexpr size_t OFF_SGW = OFF_WD + (size_t)NLAYER * DM * DFF * 2;
constexpr size_t OFF_H = OFF_SGW + (size_t)NLAYER * 4 * 128 * 128 * 2;
constexpr size_t OFF_P = OFF_H + (size_t)TC * DM * 2;
constexpr size_t OFF_BR = OFF_P + (size_t)TC * NIN * 2;
constexpr size_t OFF_MG = OFF_BR + (size_t)TC * DM * 2;
constexpr size_t OFF_HGST = OFF_MG + (size_t)TC * DM * 2;
constexpr size_t OFF_HGD = OFF_HGST + (size_t)256 * 8 * 4096 * 4;
constexpr size_t WS_END = OFF_HGD + (size_t)256 * 8 * 64 * 4;
constexpr size_t MERGE_SCR_PER_BLOCK = 131072 + 262144;

struct Params {
    const float* in[24];
    float* out;
    unsigned char* ws;
};

__device__ __forceinline__ unsigned pk2(float lo, float hi) { unsigned r; asm("v_cvt_pk_bf16_f32 %0, %1, %2" : "=v"(r) : "v"(lo), "v"(hi)); return r; }
__device__ __forceinline__ bf16_t f2bf(float f) { return (bf16_t)(pk2(f, 0.f) & 0xffffu); }
__device__ __forceinline__ float bf2f(unsigned b) { return __uint_as_float(b << 16); }
__device__ __forceinline__ float bflo(unsigned w) { return __uint_as_float(w << 16); }
__device__ __forceinline__ float bfhi(unsigned w) { return __uint_as_float(w & 0xffff0000u); }
__device__ __forceinline__ float sigmoidf_(float x) { return 1.f / (1.f + __expf(-x)); }
__device__ __forceinline__ float siluf_(float x) { return x * sigmoidf_(x); }
__device__ __forceinline__ float gelu_tanh(float x) { return x * sigmoidf_(1.5957691216f * (x + 0.044715f * x * x * x)); }
__device__ __forceinline__ float wave_sum(float v) {
#pragma unroll
    for (int o = 1; o < 64; o <<= 1) v += __shfl_xor(v, o);
    return v;
}
__device__ __forceinline__ int opaque_tid() { int t = threadIdx.x; asm volatile("" : "+v"(t)); return t; }
#define MFMA16(a, b, c) __builtin_amdgcn_mfma_f32_16x16x32_bf16((a), (b), (c), 0, 0, 0)

__device__ __forceinline__ int chunk_L(int ck) { return ck < 2 ? 2048 : 4096; }
__device__ __forceinline__ int chunk_bbase(int ck) { return ck * 8; }

namespace pg8 {
constexpr int BM = 256, BK = 64, HALF = 128, HTB = HALF * BK * 2, STAGE_BYTES = 8 * HTB, NXCD = 8, WGM = 8;
__host__ __device__ __forceinline__ int lds_byte(int r, int c) { const int st = (r >> 4) * 2 + (c >> 5), rr = r & 15, cc = c & 31, ob = rr * 64 + cc * 2; return st * 1024 + (ob ^ (((ob >> 9) & 1) << 5)); }
__host__ __device__ __forceinline__ void stage_rc(int b, int& R, int& C) { const int st = b / 1024, sb = b % 1024, swz = sb ^ (((sb >> 9) & 1) << 5); R = (st >> 1) * 16 + swz / 64; C = (st & 1) * 32 + (swz % 64) / 2; }
__host__ __device__ __forceinline__ int perm32(int rho) { const int n = rho >> 4, i = rho & 15; return 8 * (i >> 2) + 4 * n + (i & 3); }

struct Unit { const char* a; const char* b; int nt; int pm, pn, kind; };

struct TileOrder {
    int nM, nN, nwg, G, c;
    __device__ __forceinline__ void init(int nM_, int nN_, int G_, int c_) { nM = nM_; nN = nN_; nwg = nM * nN; G = G_; c = c_; }
    __device__ __forceinline__ bool tile(int i, int& pm, int& pn) const {
        const long L = (long)i * G + c; if (L >= nwg) return false;
        int wgid = (int)L; { const int q = nwg / NXCD, r = nwg % NXCD, xcd = wgid % NXCD, off = wgid / NXCD; wgid = (xcd < r ? xcd * (q + 1) : r * (q + 1) + (xcd - r) * q) + off; }
        const int nig = WGM * nN, gid = wgid / nig, fm = gid * WGM, gsz = (nM - fm) < WGM ? (nM - fm) : WGM;
        pm = fm + ((wgid % nig) % gsz); pn = (wgid % nig) / gsz; return true;
    }
};

template <class Epi, class Sched>
__device__ __forceinline__ void gemm_phase(LAS unsigned char* lds, const int lda, const int ldb, const Sched& S, const Epi& E) {
    const int tid = opaque_tid(), wid = __builtin_amdgcn_readfirstlane(tid >> 6), lane = tid & 63, wr = wid >> 2, wc = wid & 3, fr = lane & 15, fq = lane >> 4;
    unsigned voffA[2], voffB[2];
#pragma unroll
    for (int i = 0; i < 2; ++i) { int R, C; stage_rc(tid * 16 + i * 8192, R, C); const int Rb = Epi::PERM ? ((R & ~31) + perm32(R & 31)) : R;
        voffA[i] = (unsigned)(R * lda + C) * 2u; voffB[i] = (unsigned)(Rb * ldb + C) * 2u; }
    const size_t kstep = (size_t)(BK * 2);
    const size_t hstepA = (size_t)HALF * lda * 2, hstepB = (size_t)HALF * ldb * 2;
    const unsigned ldsw = (unsigned)wid * 1024u;
    const int aoff = lds_byte(wr * 64 + fr, fq * 8), boff = lds_byte(wc * 32 + fr, fq * 8);
#define PG8_SA(b, h) (((b) * 2 + (h)) * HTB)
#define PG8_SB(b, h) ((4 + (b) * 2 + (h)) * HTB)
#define PG8_STAGE(bufoff, gbase, voff) do { _Pragma("unroll") for (int _i = 0; _i < 2; ++_i) \
        __builtin_amdgcn_global_load_lds((const unsigned*)((const char*)(gbase) + (voff)[_i]), (LAS unsigned*)(lds + (bufoff) + ldsw + _i * 8192), 16, 0, 0); } while (0)
#define PG8_LDA(dst, b, h) do { _Pragma("unroll") for (int m = 0; m < 4; ++m) _Pragma("unroll") for (int k = 0; k < 2; ++k) dst[m][k] = *(const LAS bf16x8*)(lds + PG8_SA(b, h) + aoff + m * 2048 + k * 1024); } while (0)
#define PG8_LDB(dst, b, h) do { _Pragma("unroll") for (int n = 0; n < 2; ++n) _Pragma("unroll") for (int k = 0; k < 2; ++k) dst[n][k] = *(const LAS bf16x8*)(lds + PG8_SB(b, h) + boff + n * 2048 + k * 1024); } while (0)
#define PG8_MMA(ai, bj, At, Bt) do { __builtin_amdgcn_s_setprio(1); _Pragma("unroll") for (int m = 0; m < 4; ++m) _Pragma("unroll") for (int n = 0; n < 2; ++n) _Pragma("unroll") for (int k = 0; k < 2; ++k) \
        acc[ai][bj][m][n] = __builtin_amdgcn_mfma_f32_16x16x32_bf16(Bt[n][k], At[m][k], acc[ai][bj][m][n], 0, 0, 0); __builtin_amdgcn_s_setprio(0); } while (0)
#define PG8_WAIT_V(n) asm volatile("s_waitcnt vmcnt(" #n ")" ::: "memory")
#define PG8_WAIT_L(n) asm volatile("s_waitcnt lgkmcnt(" #n ")" ::: "memory")
#define PG8_BAR __builtin_amdgcn_s_barrier()
#define PG8_SCHED __builtin_amdgcn_sched_barrier(0)
    Unit cur, nxt; int ui = 0;
    if (!S.next(0, cur)) return;
    f32x4 acc[2][2][4][2];
#pragma unroll
    for (int a = 0; a < 2; ++a)
#pragma unroll
        for (int b = 0; b < 2; ++b)
#pragma unroll
            for (int m = 0; m < 4; ++m)
#pragma unroll
                for (int n = 0; n < 2; ++n) acc[a][b][m][n] = (f32x4){0.f, 0.f, 0.f, 0.f};
    bf16x8 At[4][2], B0[2][2], B1[2][2];
    const char* cA = cur.a; const char* cB = cur.b;
    PG8_STAGE(PG8_SB(0, 0), cB, voffB); PG8_STAGE(PG8_SA(0, 0), cA, voffA); PG8_STAGE(PG8_SB(0, 1), cB + hstepB, voffB); PG8_STAGE(PG8_SA(0, 1), cA + hstepA, voffA);
    if (wr == 1) PG8_BAR;
    PG8_WAIT_V(4); PG8_BAR;
    PG8_STAGE(PG8_SB(1, 0), cB + kstep, voffB); PG8_STAGE(PG8_SA(1, 0), cA + kstep, voffA); PG8_STAGE(PG8_SB(1, 1), cB + hstepB + kstep, voffB);
    PG8_WAIT_V(6); PG8_BAR;
    for (;;) {
        const bool has_next = S.next(ui + 1, nxt);
        const char* nA = has_next ? nxt.a : cA; const char* nB = has_next ? nxt.b : cB;
        const int nt = cur.nt;
        for (int t = 0; t < nt; t += 2) {
            const bool last = (t == nt - 2);
            const char* a1 = cA + (size_t)(t + 1) * kstep;
            const char* a2 = last ? nA : cA + (size_t)(t + 2) * kstep; const char* b2 = last ? nB : cB + (size_t)(t + 2) * kstep;
            const char* a3 = a2 + kstep; const char* b3 = b2 + kstep;
            PG8_LDB(B0, 0, 0); PG8_SCHED; PG8_LDA(At, 0, 0); PG8_STAGE(PG8_SA(1, 1), a1 + hstepA, voffA);
            PG8_WAIT_L(8); PG8_BAR; PG8_WAIT_L(0); PG8_MMA(0, 0, At, B0); PG8_BAR; PG8_SCHED;
            PG8_LDB(B1, 0, 1); PG8_STAGE(PG8_SB(0, 0), b2, voffB);
            PG8_BAR; PG8_WAIT_L(0); PG8_MMA(0, 1, At, B1); PG8_BAR;
            PG8_LDA(At, 0, 1); PG8_STAGE(PG8_SA(0, 0), a2, voffA);
            PG8_BAR; PG8_WAIT_L(0); PG8_MMA(1, 0, At, B0); PG8_BAR; PG8_SCHED;
            PG8_STAGE(PG8_SB(0, 1), b2 + hstepB, voffB);
            PG8_WAIT_V(6); PG8_BAR; PG8_MMA(1, 1, At, B1); PG8_BAR;
            PG8_LDB(B0, 1, 0); PG8_SCHED; PG8_LDA(At, 1, 0); PG8_STAGE(PG8_SA(0, 1), a2 + hstepA, voffA);
            PG8_WAIT_L(8); PG8_BAR; PG8_WAIT_L(0); PG8_MMA(0, 0, At, B0); PG8_BAR; PG8_SCHED;
            PG8_LDB(B1, 1, 1); PG8_STAGE(PG8_SB(1, 0), b3, voffB);
            PG8_BAR; PG8_WAIT_L(0); PG8_MMA(0, 1, At, B1); PG8_BAR;
            PG8_LDA(At, 1, 1); PG8_STAGE(PG8_SA(1, 0), a3, voffA);
            PG8_BAR; PG8_WAIT_L(0); PG8_MMA(1, 0, At, B0); PG8_BAR; PG8_SCHED;
            PG8_STAGE(PG8_SB(1, 1), b3 + hstepB, voffB);
            PG8_WAIT_V(6); PG8_BAR; PG8_MMA(1, 1, At, B1); PG8_BAR;
        }
        E(acc, cur, wr, wc, fr, fq);
        if (!has_next) break;
#pragma unroll
        for (int a = 0; a < 2; ++a)
#pragma unroll
            for (int b = 0; b < 2; ++b)
#pragma unroll
                for (int m = 0; m < 4; ++m)
#pragma unroll
                    for (int n = 0; n < 2; ++n) acc[a][b][m][n] = (f32x4){0.f, 0.f, 0.f, 0.f};
        cur = nxt; cA = nA; cB = nB; ++ui;
    }
    PG8_WAIT_V(0);
    if (wr == 0) PG8_BAR;
    PG8_BAR;
#undef PG8_SA
#undef PG8_SB
#undef PG8_STAGE
#undef PG8_LDA
#undef PG8_LDB
#undef PG8_MMA
#undef PG8_WAIT_V
#undef PG8_WAIT_L
#undef PG8_BAR
#undef PG8_SCHED
}
}
using pg8::Unit;

struct SchedStd {
    pg8::TileOrder to; const char* A; const char* B; size_t atile, btile; int nt; int skip_pn;
    __device__ __forceinline__ bool next(int i, Unit& u) const {
        int pm, pn; if (!to.tile(i, pm, pn)) return false;
        pn += (pn >= skip_pn) ? 1 : 0;
        u.pm = pm; u.pn = pn; u.kind = 0; u.nt = nt; u.a = A + (size_t)pm * atile; u.b = B + (size_t)pn * btile; return true;
    }
};
struct SchedOne {
    const char* A; const char* B; int nt, pm, pn;
    __device__ __forceinline__ bool next(int i, Unit& u) const { if (i > 0) return false; u.pm = pm; u.pn = pn; u.kind = 0; u.nt = nt; u.a = A; u.b = B; return true; }
};
struct SchedMerge {
    pg8::TileOrder to; const char* H; const char* BR; const char* WG; const char* WB;
    __device__ __forceinline__ bool next(int i, Unit& u) const {
        int pm, pn; if (!to.tile(i >> 3, pm, pn)) return false;
        const int sub = i & 7, bi = sub >> 1;
        u.pm = pm; u.pn = pn; u.kind = sub;
        if (sub & 1) { u.nt = 16; u.a = H + (size_t)pm * (256 * DM * 2); u.b = WG + (size_t)bi * (DM * DM * 2) + (size_t)pn * (256 * DM * 2); }
        else { u.nt = 4; u.a = BR + (size_t)pm * (256 * DM * 2) + bi * 512; u.b = WB + (size_t)pn * (256 * DM * 2) + bi * 512; }
        return true;
    }
};

struct EpiProj {
    static constexpr bool PERM = true;
    bf16_t* O; int ldc;
    __device__ __forceinline__ void operator()(const f32x4 (&acc)[2][2][4][2], const Unit& u, int wr, int wc, int fr, int fq) const {
        const int row0 = u.pm * 256 + wr * 64 + fr, col0 = u.pn * 256 + wc * 32 + 8 * fq;
#pragma unroll
        for (int ai = 0; ai < 2; ++ai)
#pragma unroll
            for (int m = 0; m < 4; ++m) { bf16_t* rowp = O + (size_t)(row0 + ai * 128 + m * 16) * ldc + col0;
#pragma unroll
                for (int bj = 0; bj < 2; ++bj) { const f32x4 v0 = acc[ai][bj][m][0], v1 = acc[ai][bj][m][1];
                    u32x4 o; o.x = pk2(v0[0], v0[1]); o.y = pk2(v0[2], v0[3]); o.z = pk2(v1[0], v1[1]); o.w = pk2(v1[2], v1[3]);
                    *(u32x4*)(rowp + bj * 128) = o; } }
    }
};
struct EpiAct {
    static constexpr bool PERM = true;
    bf16_t* O;
    __device__ __forceinline__ void operator()(const f32x4 (&acc)[2][2][4][2], const Unit& u, int wr, int wc, int fr, int fq) const {
        const int row0 = u.pm * 256 + wr * 64 + fr, col0 = u.pn * 128 + wc * 32 + 8 * fq;
#pragma unroll
        for (int ai = 0; ai < 2; ++ai)
#pragma unroll
            for (int m = 0; m < 4; ++m) { bf16_t* rowp = O + (size_t)(row0 + ai * 128 + m * 16) * DFF + col0;
                float r[8];
#pragma unroll
                for (int n = 0; n < 2; ++n)
#pragma unroll
                    for (int j = 0; j < 4; ++j) { const float g = acc[ai][0][m][n][j], up = acc[ai][1][m][n][j]; r[n * 4 + j] = siluf_(g) * up; }
                u32x4 o; o.x = pk2(r[0], r[1]); o.y = pk2(r[2], r[3]); o.z = pk2(r[4], r[5]); o.w = pk2(r[6], r[7]);
                *(u32x4*)rowp = o; }
    }
};
struct EpiRes {
    static constexpr bool PERM = false;
    float* X; const float* gm; int L; int bbase;
    __device__ __forceinline__ void operator()(const f32x4 (&acc)[2][2][4][2], const Unit& u, int wr, int wc, int fr, int fq) const {
        const int row0 = u.pm * 256 + wr * 64 + fr, col0 = u.pn * 256 + wc * 32 + 4 * fq;
        const int b = bbase + (u.pm * 256) / L;
        const float* g = gm + (size_t)b * (NLAYER * 6144) + col0;
        f32x4 gv[2][2];
#pragma unroll
        for (int bj = 0; bj < 2; ++bj)
#pragma unroll
            for (int n = 0; n < 2; ++n) gv[bj][n] = *(const f32x4*)(g + bj * 128 + n * 16);
#pragma unroll
        for (int ai = 0; ai < 2; ++ai)
#pragma unroll
            for (int m = 0; m < 4; ++m) { float* rowp = X + (size_t)(row0 + ai * 128 + m * 16) * DM + col0;
#pragma unroll
                for (int bj = 0; bj < 2; ++bj)
#pragma unroll
                    for (int n = 0; n < 2; ++n) { f32x4* p = (f32x4*)(rowp + bj * 128 + n * 16); const f32x4 x = *p; *p = x + gv[bj][n] * acc[ai][bj][m][n]; } }
    }
};
struct EpiMerge {
    static constexpr bool PERM = true;
    bf16_t* MG; const float* bgate;
    unsigned char* scr;
    __device__ __forceinline__ void operator()(const f32x4 (&acc)[2][2][4][2], const Unit& u, int wr, int wc, int fr, int fq) const {
        const int tid = opaque_tid(), bi = u.kind >> 1;
        unsigned char* pbp = scr + tid * 16;
        unsigned char* pmp = scr + 131072 + tid * 16;
        if ((u.kind & 1) == 0) {
#pragma unroll
            for (int bj = 0; bj < 2; ++bj)
#pragma unroll
                for (int ai = 0; ai < 2; ++ai)
#pragma unroll
                    for (int m = 0; m < 4; ++m) { const f32x4 v0 = acc[ai][bj][m][0], v1 = acc[ai][bj][m][1];
                        u32x4 o; o.x = pk2(v0[0], v0[1]); o.y = pk2(v0[2], v0[3]); o.z = pk2(v1[0], v1[1]); o.w = pk2(v1[2], v1[3]);
                        *(u32x4*)pbp = o; pbp += 8192; asm volatile("" : "+v"(pbp)); }
        } else {
            const int row0 = u.pm * 256 + wr * 64 + fr, col0 = u.pn * 256 + wc * 32 + 8 * fq;
            const float* bg = bgate + bi * DM + col0;
            bf16_t* mgp = MG + (size_t)row0 * DM + col0;
#pragma unroll
            for (int bj = 0; bj < 2; ++bj) {
                const f32x4 b0 = *(const f32x4*)(bg + bj * 128), b1 = *(const f32x4*)(bg + bj * 128 + 4);
#pragma unroll
                for (int ai = 0; ai < 2; ++ai)
#pragma unroll
                    for (int m = 0; m < 4; ++m) {
                        const u32x4 pv = *(const u32x4*)pbp; pbp += 8192; asm volatile("" : "+v"(pbp));
                        const f32x4 a0 = acc[ai][bj][m][0] + b0, a1 = acc[ai][bj][m][1] + b1;
                        f32x4 r0, r1;
                        r0[0] = sigmoidf_(a0[0]) * bflo(pv.x); r0[1] = sigmoidf_(a0[1]) * bfhi(pv.x); r0[2] = sigmoidf_(a0[2]) * bflo(pv.y); r0[3] = sigmoidf_(a0[3]) * bfhi(pv.y);
                        r1[0] = sigmoidf_(a1[0]) * bflo(pv.z); r1[1] = sigmoidf_(a1[1]) * bfhi(pv.z); r1[2] = sigmoidf_(a1[2]) * bflo(pv.w); r1[3] = sigmoidf_(a1[3]) * bfhi(pv.w);
                        if (bi > 0) { r0 += *(const f32x4*)pmp; r1 += *(const f32x4*)(pmp + 8192); }
                        if (bi < 3) { *(f32x4*)pmp = r0; *(f32x4*)(pmp + 8192) = r1; }
                        else { u32x4 o; o.x = pk2(r0[0], r0[1]); o.y = pk2(r0[2], r0[3]); o.z = pk2(r1[0], r1[1]); o.w = pk2(r1[2], r1[3]);
                            bf16_t* q = mgp + (size_t)(ai * 128 + m * 16) * DM + bj * 128; asm volatile("" : "+v"(q));
                            *(u32x4*)q = o; }
                        pmp += 16384; asm volatile("" : "+v"(pmp)); }
            }
        }
    }
};

__device__ __forceinline__ void transpose_item(const float* W, int N, int k0, int n0, bf16_t* dst  , int ldwt, LAS float* scr, int lane) {
#pragma unroll 8
    for (int i = 0; i < 32; ++i) { const int kk = 2 * i + (lane >> 5); scr[kk * 33 + (lane & 31)] = W[(size_t)(k0 + kk) * N + n0 + (lane & 31)]; }
    __builtin_amdgcn_wave_barrier();
    const int c = lane & 7;
#pragma unroll
    for (int j = 0; j < 4; ++j) { const int n = (lane >> 3) + 8 * j; const LAS float* s = scr + (8 * c) * 33 + n;
        u32x4 o; o.x = pk2(s[0 * 33], s[1 * 33]); o.y = pk2(s[2 * 33], s[3 * 33]); o.z = pk2(s[4 * 33], s[5 * 33]); o.w = pk2(s[6 * 33], s[7 * 33]);
        *(u32x4*)(dst + (size_t)n * ldwt + 8 * c) = o; }
    __builtin_amdgcn_wave_barrier();
}

__device__ __forceinline__ void phase_prologue(const Params& p, LAS unsigned char* lds) {
    const int tid = opaque_tid(), lane = tid & 63, wave = tid >> 6;
    unsigned char* ws = p.ws;
    {
        LAS float* scr = (LAS float*)(lds + wave * 8704);
        const int gw = blockIdx.x * 8 + wave, NGW = gridDim.x * 8;
        constexpr int I_IN = 16 * (NIN / 32), I_G = 4 * 16 * 32, I_B = 4 * 4 * 32, I_O = 16 * 32, I_F = 16 * (DFF / 32), I_D = (DFF / 64) * 32;
        constexpr int PER_LAYER = I_IN + I_G + I_B + I_O + 2 * I_F + I_D;
        for (int it = gw; it < NLAYER * PER_LAYER; it += NGW) {
            const int l = it / PER_LAYER; int r = it % PER_LAYER;
            if (r < I_IN) { const int nb = r % (NIN / 32), kb = r / (NIN / 32);
                transpose_item(p.in[8] + (size_t)l * DM * NIN, NIN, 64 * kb, 32 * nb, (bf16_t*)(ws + OFF_WIN) + ((size_t)l * NIN + 32 * nb) * DM + 64 * kb, DM, scr, lane); continue; }
            r -= I_IN;
            if (r < I_G) { const int bi = r / 512, rr = r % 512, nb = rr % 32, kb = rr / 32;
                transpose_item(p.in[9] + ((size_t)l * 4 + bi) * DM * DM, DM, 64 * kb, 32 * nb, (bf16_t*)(ws + OFF_WG) + (((size_t)l * 4 + bi) * DM + 32 * nb) * DM + 64 * kb, DM, scr, lane); continue; }
            r -= I_G;
            if (r < I_B) { const int bi = r / 128, rr = r % 128, nb = rr % 32, kb = rr / 32;
                transpose_item(p.in[11] + ((size_t)l * 4 + bi) * 256 * DM, DM, 64 * kb, 32 * nb, (bf16_t*)(ws + OFF_WB) + ((size_t)l * DM + 32 * nb) * DM + bi * 256 + 64 * kb, DM, scr, lane); continue; }
            r -= I_B;
            if (r < I_O) { const int nb = r % 32, kb = r / 32;
                transpose_item(p.in[12] + (size_t)l * DM * DM, DM, 64 * kb, 32 * nb, (bf16_t*)(ws + OFF_WO) + ((size_t)l * DM + 32 * nb) * DM + 64 * kb, DM, scr, lane); continue; }
            r -= I_O;
            if (r < 2 * I_F) { const int which = r / I_F, rr = r % I_F, nb = rr % (DFF / 32), kb = rr / (DFF / 32);
                const int n0 = 32 * nb, row = (n0 >> 7) * 256 + (n0 & 127) + which * 128;
                transpose_item(p.in[which ? 21 : 20] + (size_t)l * DM * DFF, DFF, 64 * kb, n0, (bf16_t*)(ws + OFF_WGU) + ((size_t)l * 2 * DFF + row) * DM + 64 * kb, DM, scr, lane); continue; }
            r -= 2 * I_F;
            { const int nb = r % 32, kb = r / 32;
                transpose_item(p.in[22] + (size_t)l * DFF * DM, DM, 64 * kb, 32 * nb, (bf16_t*)(ws + OFF_WD) + ((size_t)l * DM + 32 * nb) * DFF + 64 * kb, DFF, scr, lane); }
        }
    }
    {
        const float* src = p.in[18]; bf16_t* dst = (bf16_t*)(ws + OFF_SGW);
        for (int i = blockIdx.x * NTHR + tid; i < NLAYER * 4 * 128 * 128 / 4; i += gridDim.x * NTHR) {
            const f32x4 v = *(const f32x4*)(src + 4 * (size_t)i); u32x2 o; o.x = pk2(v[0], v[1]); o.y = pk2(v[2], v[3]); *(u32x2*)(dst + 4 * (size_t)i) = o; }
    }
    __syncthreads();
    {
        LAS float* cs = (LAS float*)lds;
        float* modp = (float*)(ws + OFF_MODP);
        for (int it = blockIdx.x; it < NLAYER * 12 * 8; it += gridDim.x) {
            const int ks = it & 7, nb = (it >> 3) % 12, l = it / 96;
            __syncthreads();
            for (int e = tid; e < 128 * NB; e += NTHR) { const int kk = e / NB, b = e % NB;
                const float c = b < 16 ? p.in[2][b * DM + 128 * ks + kk] : p.in[3][(b - 16) * DM + 128 * ks + kk];
                cs[kk * NB + b] = siluf_(c); }
            __syncthreads();
            const int n = nb * 512 + tid;
            const float* w = p.in[4] + ((size_t)l * DM + 128 * ks) * 6144 + n;
            float a[NB];
#pragma unroll
            for (int b = 0; b < NB; ++b) a[b] = 0.f;
#pragma unroll 4
            for (int kk = 0; kk < 128; ++kk) { const float wv = w[(size_t)kk * 6144];
#pragma unroll
                for (int b4 = 0; b4 < NB / 4; ++b4) { const f32x4 c4 = *(const LAS f32x4*)(cs + kk * NB + 4 * b4);
                    a[4 * b4 + 0] += c4[0] * wv; a[4 * b4 + 1] += c4[1] * wv; a[4 * b4 + 2] += c4[2] * wv; a[4 * b4 + 3] += c4[3] * wv; } }
#pragma unroll
            for (int b = 0; b < NB; ++b) modp[(((size_t)ks * NB + b) * NLAYER + l) * 6144 + n] = a[b];
        }
    }
}
__device__ __forceinline__ void phase_mod_reduce(const Params& p) {
    const float* modp = (const float*)(p.ws + OFF_MODP); float* mod = (float*)(p.ws + OFF_MOD);
    constexpr int NMOD = NB * NLAYER * 6144;
    for (int i = blockIdx.x * NTHR + opaque_tid(); i < NMOD; i += gridDim.x * NTHR) {
        const int n = i % 6144, l = (i / 6144) % NLAYER;
        float s = p.in[5][l * 6144 + n];
#pragma unroll
        for (int ks = 0; ks < 8; ++ks) s += modp[(size_t)ks * NMOD + i];
        mod[i] = s;
    }
}

__device__ __forceinline__ void phase_norm_mod(const float* xsrc, float* copy_to, bf16_t* H, const float* g, const float* mod_sh, const float* mod_sc, int L, int bbase) {
    const int tid = opaque_tid(), lane = tid & 63, gw = blockIdx.x * 8 + (tid >> 6), NGW = gridDim.x * 8;
    for (int row = gw; row < TC; row += NGW) {
        const int b = bbase + row / L;
        const f32x4* xr = (const f32x4*)(xsrc + (size_t)row * DM) + lane;
        f32x4 v[4]; float s = 0.f;
#pragma unroll
        for (int j = 0; j < 4; ++j) { v[j] = xr[64 * j]; s += (v[j][0] * v[j][0] + v[j][1] * v[j][1]) + (v[j][2] * v[j][2] + v[j][3] * v[j][3]); }
        const float rstd = rsqrtf(wave_sum(s) * (1.f / DM) + EPSV);
        if (copy_to) { f32x4* cr = (f32x4*)(copy_to + (size_t)row * DM) + lane;
#pragma unroll
            for (int j = 0; j < 4; ++j) cr[64 * j] = v[j]; }
        const f32x4* gr = (const f32x4*)g + lane;
        const f32x4* shr = (const f32x4*)(mod_sh + (size_t)b * (NLAYER * 6144)) + lane;
        const f32x4* scr = (const f32x4*)(mod_sc + (size_t)b * (NLAYER * 6144)) + lane;
        u32x2* o = (u32x2*)(H + (size_t)row * DM) + lane;
#pragma unroll
        for (int j = 0; j < 4; ++j) { const f32x4 gg = gr[64 * j], sh = shr[64 * j], sc = scr[64 * j];
            const f32x4 y = v[j] * rstd * gg * (sc + 1.f) + sh;
            u32x2 w; w.x = pk2(y[0], y[1]); w.y = pk2(y[2], y[3]); o[64 * j] = w; }
    }
}
__device__ __forceinline__ void phase_final_norm(float* X, const float* g) {
    const int tid = opaque_tid(), lane = tid & 63, gw = blockIdx.x * 8 + (tid >> 6), NGW = gridDim.x * 8;
    for (int row = gw; row < TC; row += NGW) {
        f32x4* xr = (f32x4*)(X + (size_t)row * DM) + lane;
        f32x4 v[4]; float s = 0.f;
#pragma unroll
        for (int j = 0; j < 4; ++j) { v[j] = xr[64 * j]; s += (v[j][0] * v[j][0] + v[j][1] * v[j][1]) + (v[j][2] * v[j][2] + v[j][3] * v[j][3]); }
        const float rstd = rsqrtf(wave_sum(s) * (1.f / DM) + EPSV);
        const f32x4* gr = (const f32x4*)g + lane;
#pragma unroll
        for (int j = 0; j < 4; ++j) xr[64 * j] = v[j] * rstd * gr[64 * j];
    }
}

struct AttnState { f32x4 o[4]; float m, l; };
constexpr int VT_LD = 40;
constexpr int VT_BYTES = 64 * VT_LD * 2;
struct KVRegs { bf16x8 k[2][2]; u32x4 v[4]; };
template <class TokK, class TokV>
__device__ __forceinline__ void kv_load(KVRegs& kv, const bf16_t* P, int kcol, int vcol, int lane, int fq, const TokK& tok_k, const TokV& tok_v) {
#pragma unroll
    for (int t = 0; t < 2; ++t) { const bf16_t* kp = P + (size_t)tok_k(t) * NIN + kcol + 8 * fq; kv.k[t][0] = *(const bf16x8*)kp; kv.k[t][1] = *(const bf16x8*)(kp + 32); }
#pragma unroll
    for (int i = 0; i < 4; ++i) { const int pc = lane + 64 * i, key = pc >> 3, ch = pc & 7; kv.v[i] = *(const u32x4*)(P + (size_t)tok_v(key) * NIN + vcol + 8 * ch); }
}
__device__ __forceinline__ void attn_stage_v(LAS bf16_t* vt, const KVRegs& kv, int lane) {
#pragma unroll
    for (int i = 0; i < 4; ++i) { const int pc = lane + 64 * i, key = pc >> 3, ch = pc & 7;
        const u32x4 v = kv.v[i];
        const int slot = 8 * ((key & 15) >> 2) + 4 * (key >> 4) + (key & 3);
        LAS bf16_t* d = vt + ch * VT_LD + slot;
        d[0 * 8 * VT_LD] = (bf16_t)(v.x & 0xffffu); d[1 * 8 * VT_LD] = (bf16_t)(v.x >> 16);
        d[2 * 8 * VT_LD] = (bf16_t)(v.y & 0xffffu); d[3 * 8 * VT_LD] = (bf16_t)(v.y >> 16);
        d[4 * 8 * VT_LD] = (bf16_t)(v.z & 0xffffu); d[5 * 8 * VT_LD] = (bf16_t)(v.z >> 16);
        d[6 * 8 * VT_LD] = (bf16_t)(v.w & 0xffffu); d[7 * 8 * VT_LD] = (bf16_t)(v.w >> 16); }
}
__device__ __forceinline__ void attn_softmax(AttnState& st, const float (&s)[2][4], const bool (&valid)[2][4], bf16x8& pfo, float& alpha) {
    float mx = fmaxf(fmaxf(fmaxf(s[0][0], s[0][1]), fmaxf(s[0][2], s[0][3])), fmaxf(fmaxf(s[1][0], s[1][1]), fmaxf(s[1][2], s[1][3])));
    mx = fmaxf(mx, __shfl_xor(mx, 16)); mx = fmaxf(mx, __shfl_xor(mx, 32));
    const float mn = fmaxf(st.m, mx); alpha = __expf(st.m - mn);
    float pv[2][4]; float ps = 0.f;
#pragma unroll
    for (int t = 0; t < 2; ++t)
#pragma unroll
        for (int r = 0; r < 4; ++r) { pv[t][r] = valid[t][r] ? __expf(s[t][r] - mn) : 0.f; ps += pv[t][r]; }
    st.m = mn; st.l = st.l * alpha + ps;
    union { bf16x8 v; unsigned u[4]; } pf;
    pf.u[0] = pk2(pv[0][0], pv[0][1]); pf.u[1] = pk2(pv[0][2], pv[0][3]); pf.u[2] = pk2(pv[1][0], pv[1][1]); pf.u[3] = pk2(pv[1][2], pv[1][3]);
    pfo = pf.v;
}
__device__ __forceinline__ void attn_pv(AttnState& st, const bf16x8 pf, const float alpha, const LAS bf16_t* vt, int fr, int fq) {
#pragma unroll
    for (int dt = 0; dt < 4; ++dt) {
        const bf16x8 vf = *(const LAS bf16x8*)(vt + ((fr & 7) * 8 + 2 * dt + (fr >> 3)) * VT_LD + 8 * fq);
        st.o[dt] = st.o[dt] * alpha;
        st.o[dt] = MFMA16(vf, pf, st.o[dt]);
    }
}
__device__ __forceinline__ void attn_qk(f32x4 (&sacc)[2], const KVRegs& kv, const bf16x8 (&qf)[2]) {
#pragma unroll
    for (int t = 0; t < 2; ++t) { sacc[t] = (f32x4){0.f, 0.f, 0.f, 0.f};
#pragma unroll
        for (int ks = 0; ks < 2; ++ks) sacc[t] = MFMA16(kv.k[t][ks], qf[ks], sacc[t]); }
}

__device__ __forceinline__ void na_item(int item, const bf16_t* P, bf16_t* BR, const float* rpb  , int L, LAS unsigned char* lds) {
    const int tid = opaque_tid(), lane = tid & 63, wave = tid >> 6, fr = lane & 15, fq = lane >> 4;
    const int rr = item, n = wave & 3, h0 = 2 * (wave >> 2);
    const int rows = L >> 6, seq = rr / rows, r = rr % rows, seqbase = seq * L;
    const int r0 = min(max(r - 4, 0), rows - 8);
    LAS bf16_t* vt[2] = {(LAS bf16_t*)(lds + (2 * wave) * VT_BYTES), (LAS bf16_t*)(lds + (2 * wave + 1) * VT_BYTES)};
    const int qtok = seqbase + r * 64 + 16 * n + fr;
    const int col0 = min(max(16 * n - 8, 0), 32), qcol = 16 * n + fr, win0 = min(max(qcol - 8, 0), 48);
    bf16x8 qf[2][2]; AttnState st[2]; KVRegs cur[2];
#pragma unroll
    for (int c = 0; c < 2; ++c) {
#pragma unroll
        for (int ks = 0; ks < 2; ++ks) qf[c][ks] = *(const bf16x8*)(P + (size_t)qtok * NIN + P_NAQ + 64 * (h0 + c) + 32 * ks + 8 * fq);
#pragma unroll
        for (int dt = 0; dt < 4; ++dt) st[c].o[dt] = (f32x4){0.f, 0.f, 0.f, 0.f};
        st[c].m = -1e30f; st[c].l = 0.f;
        const int rowtok = seqbase + r0 * 64 + col0;
        kv_load(cur[c], P, P_NAK + 64 * (h0 + c), P_NAV + 64 * (h0 + c), lane, fq, [&](int t) { return rowtok + 16 * t + fr; }, [&](int key) { return rowtok + key; });
    }
    for (int kr = 0; kr < 8; ++kr) {
        const int krow = r0 + kr;
        KVRegs nxt[2];
        { const int rowtok = seqbase + min(krow + 1, r0 + 7) * 64 + col0;
#pragma unroll
          for (int c = 0; c < 2; ++c) kv_load(nxt[c], P, P_NAK + 64 * (h0 + c), P_NAV + 64 * (h0 + c), lane, fq, [&](int t) { return rowtok + 16 * t + fr; }, [&](int key) { return rowtok + key; }); }
        float bias[2][2][4]; bool valid[2][4];
#pragma unroll
        for (int t = 0; t < 2; ++t)
#pragma unroll
            for (int g = 0; g < 4; ++g) { const int kc = col0 + 16 * t + 4 * fq + g; valid[t][g] = (kc >= win0) && (kc < win0 + 16);
                const int bi = (h0 * 15 + (krow - r + 7)) * 31 + min(max(kc - qcol + 15, 0), 30);
                bias[0][t][g] = rpb[bi]; bias[1][t][g] = rpb[bi + 15 * 31]; }
        attn_stage_v(vt[0], cur[0], lane); attn_stage_v(vt[1], cur[1], lane);
        __builtin_amdgcn_wave_barrier();
        bf16x8 pf[2]; float alpha[2];
#pragma unroll
        for (int c = 0; c < 2; ++c) {
            f32x4 sacc[2]; attn_qk(sacc, cur[c], qf[c]);
            float sc[2][4];
#pragma unroll
            for (int t = 0; t < 2; ++t)
#pragma unroll
                for (int g = 0; g < 4; ++g) sc[t][g] = valid[t][g] ? sacc[t][g] * 0.125f + bias[c][t][g] : -1e30f;
            attn_softmax(st[c], sc, valid, pf[c], alpha[c]);
        }
#pragma unroll
        for (int c = 0; c < 2; ++c) attn_pv(st[c], pf[c], alpha[c], vt[c], fr, fq);
        __builtin_amdgcn_wave_barrier();
        cur[0] = nxt[0]; cur[1] = nxt[1];
    }
#pragma unroll
    for (int c = 0; c < 2; ++c) {
        float l = st[c].l; l += __shfl_xor(l, 16); l += __shfl_xor(l, 32);
        const float inv = 1.f / l;
        bf16_t* orow = BR + (size_t)qtok * DM + 0 + 64 * (h0 + c) + 4 * fq;
#pragma unroll
        for (int dt = 0; dt < 4; ++dt) { u32x2 o; o.x = pk2(st[c].o[dt][0] * inv, st[c].o[dt][1] * inv); o.y = pk2(st[c].o[dt][2] * inv, st[c].o[dt][3] * inv); *(u32x2*)(orow + 16 * dt) = o; }
    }
}

constexpr int DL_OLD = 68;
constexpr int DL_O_OFF = 16 * VT_BYTES;
constexpr int DL_M_OFF = DL_O_OFF + 256 * DL_OLD * 4;
constexpr int DL_L_OFF = DL_M_OFF + 1024;
__device__ __forceinline__ void dl_item(int item, const bf16_t* P, bf16_t* BR, int L, LAS unsigned char* lds) {
    const int tid = opaque_tid(), lane = tid & 63, wave = tid >> 6, fr = lane & 15, fq = lane >> 4;
    const int sp = item >> 2, h = item & 3;
    const int t0 = sp * 256, seq = t0 / L, seqbase = seq * L, p0 = t0 - seqbase;
    LAS bf16_t* vt[2] = {(LAS bf16_t*)(lds + (2 * wave) * VT_BYTES), (LAS bf16_t*)(lds + (2 * wave + 1) * VT_BYTES)};
    LAS float* OL = (LAS float*)(lds + DL_O_OFF); LAS float* ML = (LAS float*)(lds + DL_M_OFF); LAS float* LL = (LAS float*)(lds + DL_L_OFF);
    __syncthreads();
    for (int e = tid; e < 256 * DL_OLD; e += NTHR) OL[e] = 0.f;
    if (tid < 256) { ML[tid] = -1e30f; LL[tid] = 0.f; }
    __syncthreads();
    const float slope = (h == 0) ? 0.25f : (h == 1) ? 0.0625f : (h == 2) ? 0.015625f : 0.00390625f;
    const int kcol = P_DK + 64 * h, vcol = P_DV + 64 * h;
    for (int cfg = 0; cfg < 3; ++cfg) {
        const int dsh = 2 * cfg, n = L >> dsh;
        int rC[2], subC[2], j0C[2], qjC[2];
        bf16x8 qf[2][2]; AttnState st[2]; KVRegs cur[2];
#pragma unroll
        for (int c = 0; c < 2; ++c) {
            const int qt = 2 * wave + c;
            rC[c] = (cfg == 0) ? 0 : (cfg == 1) ? (qt >> 2) : qt;
            subC[c] = (cfg == 0) ? qt : (cfg == 1) ? (qt & 3) : 0;
            j0C[c] = (p0 >> dsh) + 16 * subC[c]; qjC[c] = j0C[c] + fr;
            const int qtok = seqbase + (qjC[c] << dsh) + rC[c];
#pragma unroll
            for (int ks = 0; ks < 2; ++ks) qf[c][ks] = *(const bf16x8*)(P + (size_t)qtok * NIN + P_DQ + 64 * h + 32 * ks + 8 * fq);
#pragma unroll
            for (int dt = 0; dt < 4; ++dt) st[c].o[dt] = (f32x4){0.f, 0.f, 0.f, 0.f};
            st[c].m = -1e30f; st[c].l = 0.f;
        }
        int s_lo = 0, s_hi = 5;
        while (s_lo < 4 && j0C[1] - 64 + 32 * s_lo + 32 <= 0) ++s_lo;
        while (s_hi > s_lo + 1 && j0C[0] - 64 + 32 * (s_hi - 1) >= n) --s_hi;
#pragma unroll
        for (int c = 0; c < 2; ++c) { const int kb = j0C[c] - 64 + 32 * s_lo, rr_ = rC[c];
            kv_load(cur[c], P, kcol, vcol, lane, fq, [&](int t) { const int kj = min(max(kb + 16 * t + fr, 0), n - 1); return seqbase + (kj << dsh) + rr_; },
                    [&](int key) { const int kj = min(max(kb + key, 0), n - 1); return seqbase + (kj << dsh) + rr_; }); }
        for (int sx = s_lo; sx < s_hi; ++sx) {
            KVRegs nxt[2];
#pragma unroll
            for (int c = 0; c < 2; ++c) { const int kb2 = j0C[c] - 64 + 32 * min(sx + 1, s_hi - 1), rr_ = rC[c];
                kv_load(nxt[c], P, kcol, vcol, lane, fq, [&](int t) { const int kj = min(max(kb2 + 16 * t + fr, 0), n - 1); return seqbase + (kj << dsh) + rr_; },
                        [&](int key) { const int kj = min(max(kb2 + key, 0), n - 1); return seqbase + (kj << dsh) + rr_; }); }
            attn_stage_v(vt[0], cur[0], lane); attn_stage_v(vt[1], cur[1], lane);
            __builtin_amdgcn_wave_barrier();
            bf16x8 pf[2]; float alpha[2];
#pragma unroll
            for (int c = 0; c < 2; ++c) {
                const int kb = j0C[c] - 64 + 32 * sx;
                f32x4 sacc[2]; attn_qk(sacc, cur[c], qf[c]);
                float sc[2][4]; bool valid[2][4];
#pragma unroll
                for (int t = 0; t < 2; ++t)
#pragma unroll
                    for (int g = 0; g < 4; ++g) { const int kj = kb + 16 * t + 4 * fq + g; const int dist = abs(kj - qjC[c]);
                        const bool v = (dist <= 64) && (kj >= 0) && (kj < n);
                        valid[t][g] = v; sc[t][g] = v ? sacc[t][g] * 0.125f - slope * (float)(dist << dsh) : -1e30f; }
                attn_softmax(st[c], sc, valid, pf[c], alpha[c]);
            }
#pragma unroll
            for (int c = 0; c < 2; ++c) attn_pv(st[c], pf[c], alpha[c], vt[c], fr, fq);
            __builtin_amdgcn_wave_barrier();
            cur[0] = nxt[0]; cur[1] = nxt[1];
        }
#pragma unroll
        for (int c = 0; c < 2; ++c) {
            float l = st[c].l; l += __shfl_xor(l, 16); l += __shfl_xor(l, 32);
            const int ql = ((16 * subC[c] + fr) << dsh) + rC[c];
            const float mo = ML[ql], lo = LL[ql], mn = fmaxf(mo, st[c].m), a = __expf(mo - mn), b = __expf(st[c].m - mn);
            LAS float* orow = OL + ql * DL_OLD + 4 * fq;
#pragma unroll
            for (int dt = 0; dt < 4; ++dt) { f32x4 ov = *(LAS f32x4*)(orow + 16 * dt); ov = ov * a + st[c].o[dt] * b; *(LAS f32x4*)(orow + 16 * dt) = ov; }
            __builtin_amdgcn_wave_barrier();
            if (fq == 0) { ML[ql] = mn; LL[ql] = lo * a + l * b; }
            __builtin_amdgcn_wave_barrier();
        }
        __syncthreads();
    }
    for (int e = tid; e < 256 * 8; e += NTHR) { const int ql = e >> 3, c8 = e & 7;
        const float inv = 1.f / LL[ql]; const LAS float* orow = OL + ql * DL_OLD + 8 * c8;
        const f32x4 a = *(const LAS f32x4*)orow, b = *(const LAS f32x4*)(orow + 4);
        u32x4 o; o.x = pk2(a[0] * inv, a[1] * inv); o.y = pk2(a[2] * inv, a[3] * inv); o.z = pk2(b[0] * inv, b[1] * inv); o.w = pk2(b[2] * inv, b[3] * inv);
        *(u32x4*)(BR + (size_t)(t0 + ql) * DM + 768 + 64 * h + 8 * c8) = o; }
}

constexpr int SG_WLD = 136, SG_VLD = 136;
constexpr int SG_V_OFF = 128 * SG_WLD * 2;
__device__ __forceinline__ void sg_item(int item, const bf16_t* P, bf16_t* BR, const bf16_t* sgw  , const float* ln_g, const float* ln_b, const float* sgb  , LAS unsigned char* lds) {
    const int tid = opaque_tid(), lane = tid & 63, wave = tid >> 6, fr = lane & 15, fq = lane >> 4;
    const int nc = item >> 2, g = item & 3, t0 = nc * 128;
    LAS bf16_t* WL = (LAS bf16_t*)lds; LAS bf16_t* VT = (LAS bf16_t*)(lds + SG_V_OFF);
    __syncthreads();
    for (int e = tid; e < 128 * 16; e += NTHR) { const int row = e >> 4, c8 = e & 15;
        *(LAS u32x4*)(WL + row * SG_WLD + 8 * c8) = *(const u32x4*)(sgw + ((size_t)g * 128 + row) * 128 + 8 * c8); }
    {
        const int s = tid >> 2, qd = tid & 3;
        const bf16_t* vp = P + (size_t)(t0 + s) * NIN + P_SV + 64 * qd;
        float sum = 0.f, sq = 0.f;
#pragma unroll
        for (int i = 0; i < 8; ++i) { const u32x4 w = *(const u32x4*)(vp + 8 * i);
            const unsigned ww[4] = {w.x, w.y, w.z, w.w};
#pragma unroll
            for (int j = 0; j < 4; ++j) { const float a = gelu_tanh(bflo(ww[j])), b = gelu_tanh(bfhi(ww[j])); sum += a + b; sq += a * a + b * b; } }
        sum += __shfl_xor(sum, 1); sum += __shfl_xor(sum, 2); sq += __shfl_xor(sq, 1); sq += __shfl_xor(sq, 2);
        const float mean = sum * (1.f / 256.f), var = fmaxf(sq * (1.f / 256.f) - mean * mean, 0.f), rstd = rsqrtf(var + EPSV);
        const bf16_t* gp = P + (size_t)(t0 + s) * NIN + P_SV + 64 * g + 16 * qd;
#pragma unroll
        for (int i = 0; i < 2; ++i) { const u32x4 w = *(const u32x4*)(gp + 8 * i);
            const unsigned ww[4] = {w.x, w.y, w.z, w.w};
#pragma unroll
            for (int j = 0; j < 4; ++j) {
                const int c = 16 * qd + 8 * i + 2 * j, ch = 64 * g + c;
                const float a = (gelu_tanh(bflo(ww[j])) - mean) * rstd * ln_g[ch] + ln_b[ch], b = (gelu_tanh(bfhi(ww[j])) - mean) * rstd * ln_g[ch + 1] + ln_b[ch + 1];
                VT[c * SG_VLD + s] = f2bf(a); VT[(c + 1) * SG_VLD + s] = f2bf(b); } }
    }
    __syncthreads();
    f32x4 acc[4];
#pragma unroll
    for (int ni = 0; ni < 4; ++ni) acc[ni] = (f32x4){0.f, 0.f, 0.f, 0.f};
#pragma unroll
    for (int ks = 0; ks < 4; ++ks) { const bf16x8 a = *(const LAS bf16x8*)(WL + (16 * wave + fr) * SG_WLD + 32 * ks + 8 * fq);
#pragma unroll
        for (int ni = 0; ni < 4; ++ni) { const bf16x8 b = *(const LAS bf16x8*)(VT + (16 * ni + fr) * SG_VLD + 32 * ks + 8 * fq); acc[ni] = MFMA16(a, b, acc[ni]); } }
#pragma unroll
    for (int reg = 0; reg < 4; ++reg) { const int t = 16 * wave + 4 * fq + reg; const float bs = sgb[g * 128 + t];
        const bf16_t* up = P + (size_t)(t0 + t) * NIN + P_SU + 64 * g; bf16_t* op = BR + (size_t)(t0 + t) * DM + 512 + 64 * g;
#pragma unroll
        for (int ni = 0; ni < 4; ++ni) { const int c = 16 * ni + fr; const float u = gelu_tanh(bf2f(up[c])); op[c] = f2bf(u * (acc[ni][reg] + bs)); } }
}

constexpr int HG_LF_OFF = 0;
constexpr int HG_T_OFF = 32768;
constexpr int HG_TLD = 72, HG_TB = 64 * HG_TLD * 2;
__device__ __forceinline__ float hg_lb(const float* hg_lb_in, int dir, int l, int ch) {
    const float* q = hg_lb_in + (size_t)dir * NLAYER * 256 + ch;
    const float a0 = q[0], a1 = q[256], a2 = q[512], a3 = q[768];
    const float mx = fmaxf(fmaxf(a0, a1), fmaxf(a2, a3));
    const float e0 = __expf(a0 - mx), e1 = __expf(a1 - mx), e2 = __expf(a2 - mx), e3 = __expf(a3 - mx);
    const float num = (l >= 1 ? e1 : 0.f) + (l >= 2 ? e2 : 0.f) + (l >= 3 ? e3 : 0.f);
    return num / (e0 + e1 + e2 + e3);
}
constexpr int HG_LB_OFF = 155648;
constexpr int HG_TOT_OFF = 157696;
__device__ __forceinline__ void hg_lb_table(const float* hg_lb_in, int l, LAS unsigned char* lds) {
    const int tid = opaque_tid();
    ((LAS float*)(lds + HG_LB_OFF))[tid] = hg_lb(hg_lb_in, (tid >> 6) & 1, l, 64 * (tid >> 7) + (tid & 63));
    __syncthreads();
}
__device__ __forceinline__ void hg_front(const u32x4 (&wf)[2], int h, LAS unsigned char* lds) {
    const int tid = opaque_tid();
    LAS float* LF = (LAS float*)(lds + HG_LF_OFF); LAS float* TOT = (LAS float*)(lds + HG_TOT_OFF); const LAS float* LBS = (const LAS float*)(lds + HG_LB_OFF) + h * 128;
    {
        const int s = tid >> 3, i0 = 8 * (tid & 7);
#pragma unroll
        for (int dir = 0; dir < 2; ++dir) {
            const unsigned ww[4] = {wf[dir].x, wf[dir].y, wf[dir].z, wf[dir].w};
#pragma unroll
            for (int j = 0; j < 4; ++j) {
                const float lb0 = LBS[dir * 64 + i0 + 2 * j], lb1 = LBS[dir * 64 + i0 + 2 * j + 1];
                const float f0 = lb0 + (1.f - lb0) * sigmoidf_(bflo(ww[j])), f1 = lb1 + (1.f - lb1) * sigmoidf_(bfhi(ww[j]));
                LF[dir * 4096 + s * 64 + i0 + 2 * j] = __logf(f0); LF[dir * 4096 + s * 64 + i0 + 2 * j + 1] = __logf(f1); }
        }
    }
    __syncthreads();
    {
        const int dir = tid >> 8, seg = (tid >> 6) & 3, i = tid & 63;
        LAS float* a = LF + dir * 4096 + i;
        float r[16]; float run = 0.f;
#pragma unroll
        for (int k = 0; k < 16; ++k) { const int sidx = dir ? (16 * seg + 15 - k) : (16 * seg + k); run += a[sidx * 64]; r[k] = run; }
        TOT[(dir * 4 + seg) * 64 + i] = run;
        __syncthreads();
        float off = 0.f;
#pragma unroll
        for (int q = 0; q < 4; ++q) { const float tq = TOT[(dir * 4 + q) * 64 + i]; off += (dir ? (q > seg) : (q < seg)) ? tq : 0.f; }
#pragma unroll
        for (int k = 0; k < 16; ++k) { const int sidx = dir ? (16 * seg + 15 - k) : (16 * seg + k); a[sidx * 64] = r[k] + off; }
    }
    __syncthreads();
}
__device__ __forceinline__ float hg_kk(LAS unsigned char* lds, int h, int dir, int i, float x) { const float lb = ((LAS float*)(lds + HG_LB_OFF))[(h * 2 + dir) * 64 + i]; return (1.f - lb) * sigmoidf_(-x); }

__device__ __forceinline__ void hgA_item(int item, const bf16_t* P, float* HGST, float* HGD, LAS unsigned char* lds) {
    const int tid = opaque_tid(), lane = tid & 63, wave = tid >> 6, fr = lane & 15, fq = lane >> 4;
    const int cc = item >> 2, h = item & 3, t0 = cc * 64;
    const int s = tid >> 3, i0 = 8 * (tid & 7);
    u32x4 wf[2];
    wf[0] = *(const u32x4*)(P + (size_t)(t0 + s) * NIN + P_FF + 64 * h + i0);
    wf[1] = *(const u32x4*)(P + (size_t)(t0 + s) * NIN + P_FB + 64 * h + i0);
    const u32x4 wv = *(const u32x4*)(P + (size_t)(t0 + s) * NIN + P_HI + 64 * h + i0);
    __syncthreads();
    hg_front(wf, h, lds);
    LAS float* LF = (LAS float*)(lds + HG_LF_OFF);
    LAS bf16_t* KD0 = (LAS bf16_t*)(lds + HG_T_OFF); LAS bf16_t* KD1 = (LAS bf16_t*)(lds + HG_T_OFF + HG_TB); LAS bf16_t* VT = (LAS bf16_t*)(lds + HG_T_OFF + 2 * HG_TB);
    {
#pragma unroll
        for (int dir = 0; dir < 2; ++dir) {
            const unsigned ww[4] = {wf[dir].x, wf[dir].y, wf[dir].z, wf[dir].w};
            LAS bf16_t* KD = dir ? KD1 : KD0; const LAS float* A = LF + dir * 4096; const int slast = dir ? 0 : 63;
#pragma unroll
            for (int j = 0; j < 8; ++j) { const int i = i0 + j; const float x = (j & 1) ? bfhi(ww[j >> 1]) : bflo(ww[j >> 1]);
                const float kd = hg_kk(lds, h, dir, i, x) * __expf(A[slast * 64 + i] - A[s * 64 + i]);
                KD[i * HG_TLD + s] = f2bf(kd); }
        }
        const unsigned ww[4] = {wv.x, wv.y, wv.z, wv.w};
#pragma unroll
        for (int j = 0; j < 8; ++j) VT[(i0 + j) * HG_TLD + s] = (bf16_t)((j & 1) ? (ww[j >> 1] >> 16) : (ww[j >> 1] & 0xffffu));
        if (tid < 128) { const int dir = tid >> 6, i = tid & 63; HGD[((size_t)(cc * 4 + h) * 2 + dir) * 64 + i] = __expf(LF[dir * 4096 + (dir ? 0 : 63) * 64 + i]); }
    }
    __syncthreads();
    {
        const int dir = wave >> 2, mt = wave & 3; const LAS bf16_t* KD = dir ? KD1 : KD0;
        f32x4 acc[4];
#pragma unroll
        for (int ni = 0; ni < 4; ++ni) acc[ni] = (f32x4){0.f, 0.f, 0.f, 0.f};
#pragma unroll
        for (int ks = 0; ks < 2; ++ks) { const bf16x8 a = *(const LAS bf16x8*)(VT + (16 * mt + fr) * HG_TLD + 32 * ks + 8 * fq);
#pragma unroll
            for (int ni = 0; ni < 4; ++ni) { const bf16x8 b = *(const LAS bf16x8*)(KD + (16 * ni + fr) * HG_TLD + 32 * ks + 8 * fq); acc[ni] = MFMA16(a, b, acc[ni]); } }
        float* dst = HGST + ((size_t)(cc * 4 + h) * 2 + dir) * 4096;
#pragma unroll
        for (int ni = 0; ni < 4; ++ni)
#pragma unroll
            for (int reg = 0; reg < 4; ++reg) dst[(16 * mt + 4 * fq + reg) * 64 + 16 * ni + fr] = acc[ni][reg];
    }
}
__device__ __forceinline__ void hgB_phase(float* HGST, const float* HGD, int L) {
    const int ncs = L >> 6, nseq = TC / L, total = nseq * 8 * 4096;
    for (int e = blockIdx.x * NTHR + opaque_tid(); e < total; e += gridDim.x * NTHR) {
        const int ji = e & 4095, dir = (e >> 12) & 1, h = (e >> 13) & 3, seq = e >> 15, i = ji & 63;
        float S = 0.f;
        for (int c0 = 0; c0 < ncs; c0 += 8) {
            float u[8], d[8];
#pragma unroll
            for (int k = 0; k < 8; ++k) { const int cc = seq * ncs + (dir ? (ncs - 1 - (c0 + k)) : (c0 + k)); const size_t o = ((size_t)(cc * 4 + h) * 2 + dir);
                u[k] = HGST[o * 4096 + ji]; d[k] = HGD[o * 64 + i]; }
#pragma unroll
            for (int k = 0; k < 8; ++k) { const int cc = seq * ncs + (dir ? (ncs - 1 - (c0 + k)) : (c0 + k)); const size_t o = ((size_t)(cc * 4 + h) * 2 + dir);
                HGST[o * 4096 + ji] = S; S = S * d[k] + u[k]; }
        }
    }
}
__device__ __forceinline__ void hgC_item(int item, const bf16_t* P, bf16_t* BR, const float* HGST, const float* gnorm  , LAS unsigned char* lds) {
    const int tid = opaque_tid(), lane = tid & 63, wave = tid >> 6, fr = lane & 15, fq = lane >> 4;
    const int cc = item >> 2, h = item & 3, t0 = cc * 64;
    const int s = tid >> 3, i0 = 8 * (tid & 7);
    u32x4 wf[2];
    wf[0] = *(const u32x4*)(P + (size_t)(t0 + s) * NIN + P_FF + 64 * h + i0);
    wf[1] = *(const u32x4*)(P + (size_t)(t0 + s) * NIN + P_FB + 64 * h + i0);
    const u32x4 wq = *(const u32x4*)(P + (size_t)(t0 + s) * NIN + P_HQ + 64 * h + i0);
    const u32x4 wv = *(const u32x4*)(P + (size_t)(t0 + s) * NIN + P_HI + 64 * h + i0);
    f32x4 stv[4];
    { const int dir = tid >> 8, j = (tid >> 2) & 63, i4 = 16 * (tid & 3);
      const float* src = HGST + ((size_t)(cc * 4 + h) * 2 + dir) * 4096 + j * 64 + i4;
#pragma unroll
      for (int q = 0; q < 4; ++q) stv[q] = *(const f32x4*)(src + 4 * q); }
    unsigned gpre[4][4];
    if (wave < 4) {
#pragma unroll
        for (int reg = 0; reg < 4; ++reg)
#pragma unroll
            for (int ni = 0; ni < 4; ++ni) gpre[reg][ni] = P[(size_t)(t0 + 16 * wave + 4 * fq + reg) * NIN + P_HGATE + 64 * h + 16 * ni + fr];
    }
    __syncthreads();
    hg_front(wf, h, lds);
    LAS float* LF = (LAS float*)(lds + HG_LF_OFF);
#define HGT(k) ((LAS bf16_t*)(lds + HG_T_OFF + (k) * HG_TB))
    {
        const unsigned wqq[4] = {wq.x, wq.y, wq.z, wq.w};
#pragma unroll
        for (int dir = 0; dir < 2; ++dir) {
            const unsigned ww[4] = {wf[dir].x, wf[dir].y, wf[dir].z, wf[dir].w};
            const LAS float* A = LF + dir * 4096;
            u32x4 oq, ok, oe; unsigned* oqp = (unsigned*)&oq; unsigned* okp = (unsigned*)&ok; unsigned* oep = (unsigned*)&oe;
#pragma unroll
            for (int j2 = 0; j2 < 4; ++j2) { float qt[2], kt[2], qe[2];
#pragma unroll
                for (int e = 0; e < 2; ++e) { const int i = i0 + 2 * j2 + e; const float x = e ? bfhi(ww[j2]) : bflo(ww[j2]); const float qs = siluf_(e ? bfhi(wqq[j2]) : bflo(wqq[j2]));
                    const float a = A[s * 64 + i], ref = A[32 * 64 + i];
                    const float d1 = fminf(fmaxf(a - ref, -80.f), 80.f);
                    qt[e] = qs * __expf(d1); kt[e] = hg_kk(lds, h, dir, i, x) * __expf(-d1); qe[e] = qs * __expf(a); }
                oqp[j2] = pk2(qt[0], qt[1]); okp[j2] = pk2(kt[0], kt[1]); oep[j2] = pk2(qe[0], qe[1]); }
            *(LAS u32x4*)(HGT(0 + dir) + s * HG_TLD + i0) = oq; *(LAS u32x4*)(HGT(2 + dir) + s * HG_TLD + i0) = ok; *(LAS u32x4*)(HGT(4 + dir) + s * HG_TLD + i0) = oe;
        }
        const unsigned ww[4] = {wv.x, wv.y, wv.z, wv.w};
        LAS bf16_t* VT = HGT(6);
#pragma unroll
        for (int j = 0; j < 8; ++j) VT[(i0 + j) * HG_TLD + s] = (bf16_t)((j & 1) ? (ww[j >> 1] >> 16) : (ww[j >> 1] & 0xffffu));
        { const int dir = tid >> 8, j = (tid >> 2) & 63, i4 = 16 * (tid & 3);
          LAS bf16_t* dstp = HGT(8 + dir) + j * HG_TLD + i4;
#pragma unroll
          for (int q = 0; q < 2; ++q) { const f32x4 a = stv[2 * q], b = stv[2 * q + 1];
              u32x4 o; o.x = pk2(a[0], a[1]); o.y = pk2(a[2], a[3]); o.z = pk2(b[0], b[1]); o.w = pk2(b[2], b[3]); *(LAS u32x4*)(dstp + 8 * q) = o; } }
    }
    __syncthreads();
    {
        const int mt = wave >> 1;
#pragma unroll
        for (int q = 0; q < 2; ++q) { const int nt = 2 * (wave & 1) + q;
            f32x4 af = (f32x4){0.f, 0.f, 0.f, 0.f}, ab = (f32x4){0.f, 0.f, 0.f, 0.f};
            if (nt <= mt) {
#pragma unroll
                for (int ks = 0; ks < 2; ++ks) af = MFMA16(*(const LAS bf16x8*)(HGT(0) + (16 * mt + fr) * HG_TLD + 32 * ks + 8 * fq), *(const LAS bf16x8*)(HGT(2) + (16 * nt + fr) * HG_TLD + 32 * ks + 8 * fq), af); }
            if (nt >= mt) {
#pragma unroll
                for (int ks = 0; ks < 2; ++ks) ab = MFMA16(*(const LAS bf16x8*)(HGT(1) + (16 * mt + fr) * HG_TLD + 32 * ks + 8 * fq), *(const LAS bf16x8*)(HGT(3) + (16 * nt + fr) * HG_TLD + 32 * ks + 8 * fq), ab); }
            const int s = 16 * nt + fr;
#pragma unroll
            for (int reg = 0; reg < 4; ++reg) { const int t = 16 * mt + 4 * fq + reg;
                const float v = ((s <= t) ? af[reg] : 0.f) + ((s >= t) ? ab[reg] : 0.f);
                HGT(7)[t * HG_TLD + s] = f2bf(v); } }
    }
    __syncthreads();
    if (wave < 4) {
        const int mt = wave;
        f32x4 acc[4];
#pragma unroll
        for (int ni = 0; ni < 4; ++ni) acc[ni] = (f32x4){0.f, 0.f, 0.f, 0.f};
#pragma unroll
        for (int pr = 0; pr < 3; ++pr) { const LAS bf16_t* Am = (pr == 0) ? HGT(7) : (pr == 1) ? HGT(4) : HGT(5); const LAS bf16_t* Bm = (pr == 0) ? HGT(6) : (pr == 1) ? HGT(8) : HGT(9);
#pragma unroll
            for (int ks = 0; ks < 2; ++ks) { const bf16x8 a = *(const LAS bf16x8*)(Am + (16 * mt + fr) * HG_TLD + 32 * ks + 8 * fq);
#pragma unroll
                for (int ni = 0; ni < 4; ++ni) acc[ni] = MFMA16(a, *(const LAS bf16x8*)(Bm + (16 * ni + fr) * HG_TLD + 32 * ks + 8 * fq), acc[ni]); } }
#pragma unroll
        for (int reg = 0; reg < 4; ++reg) { const int t = 16 * mt + 4 * fq + reg;
            float ss = acc[0][reg] * acc[0][reg] + acc[1][reg] * acc[1][reg] + acc[2][reg] * acc[2][reg] + acc[3][reg] * acc[3][reg];
            ss += __shfl_xor(ss, 1); ss += __shfl_xor(ss, 2); ss += __shfl_xor(ss, 4); ss += __shfl_xor(ss, 8);
            const float rn = rsqrtf(ss * (1.f / 64.f) + EPSV);
            bf16_t* op = BR + (size_t)(t0 + t) * DM + 256 + 64 * h;
#pragma unroll
            for (int ni = 0; ni < 4; ++ni) { const int j = 16 * ni + fr; op[j] = f2bf(acc[ni][reg] * rn * gnorm[64 * h + j] * siluf_(bf2f(gpre[reg][ni]))); } }
    }
#undef HGT
}

#define XB_TMO      128
#define XB_XCNT(j)  (256  + 64 * (j))
#define XB_XSUB(j)  (1280 + 64 * (j))
#define XB_XGEN(j)  (2304 + 64 * (j))
#define XB_TOP      3328
#define XB_TOPGEN   3392
#define XCD_BAR_WORDS 3456
#define XB_SPIN_CAP (1u << 22)
__device__ __forceinline__ unsigned xb_ld(unsigned* p)              { return __hip_atomic_load(p, __ATOMIC_RELAXED, __HIP_MEMORY_SCOPE_AGENT); }
__device__ __forceinline__ unsigned xb_add(unsigned* p, unsigned v) { return __hip_atomic_fetch_add(p, v, __ATOMIC_RELAXED, __HIP_MEMORY_SCOPE_AGENT); }
__device__ __forceinline__ unsigned xb_xcc_id() { return (unsigned)__builtin_amdgcn_s_getreg((3 << 11) | 20) & 0xFu; }
#define XB_SPIN(cond, bar) do { unsigned _sp = 0; while (cond) { __builtin_amdgcn_s_sleep(1); \
    if ((++_sp & 255u) == 0u) { if (xb_ld(&(bar)[XB_TMO])) break; if (_sp > XB_SPIN_CAP) { atomicAdd(&(bar)[XB_TMO], 1u); break; } } } } while (0)
struct XcdBarrier { unsigned* bar; unsigned x; volatile LAS unsigned* st; };
__device__ __forceinline__ XcdBarrier xcd_barrier_post(unsigned* bar, volatile LAS unsigned* st) {
    XcdBarrier b; b.bar = bar; b.x = xb_xcc_id(); b.st = st;
    if (threadIdx.x == 0) (void)xb_add(&bar[XB_XCNT(b.x)], 1u);
    return b;
}
__device__ __forceinline__ void xcd_barrier_complete(unsigned* bar, unsigned x, unsigned& nloc, unsigned& nx) {
    const unsigned G = gridDim.x * gridDim.y * gridDim.z;
    unsigned sum, cnt, mine, sp = 0u;
    for (;;) {
        sum = 0u; cnt = 0u; mine = 0u;
#pragma unroll
        for (unsigned j = 0; j < 16; ++j) { const unsigned c = xb_ld(&bar[XB_XCNT(j)]); sum += c; cnt += (c > 0u) ? 1u : 0u; mine = (j == x) ? c : mine; }
        if (sum == G) break;
        __builtin_amdgcn_s_sleep(1);
        if ((++sp & 255u) == 0u) { if (xb_ld(&bar[XB_TMO])) break; if (sp > XB_SPIN_CAP) { atomicAdd(&bar[XB_TMO], 1u); break; } }
    }
    nloc = mine > 0u ? mine : 1u; nx = cnt > 0u ? cnt : 1u;
}
__device__ __forceinline__ void xcd_barrier(unsigned* bar_in, volatile LAS unsigned* st_in) {
    XcdBarrier b; b.bar = bar_in; b.st = st_in; b.x = xb_xcc_id();
    asm volatile("s_waitcnt vmcnt(0)" ::: "memory");
    __syncthreads();
    if (threadIdx.x == 0) {
        unsigned* bar = b.bar;
        __builtin_amdgcn_s_waitcnt(0);
        unsigned nloc = b.st[0], nx = b.st[1];
        if (nloc == 0u) { xcd_barrier_complete(bar, b.x, nloc, nx); b.st[0] = nloc; b.st[1] = nx; }
        const unsigned old = xb_add(&bar[XB_XSUB(b.x)], 1u);
        const unsigned gen = old / nloc;
        if (old + 1u == (gen + 1u) * nloc) {
            __builtin_amdgcn_fence(__ATOMIC_RELEASE, "agent");
            asm volatile("s_waitcnt vmcnt(0)" ::: "memory");
            const unsigned og = xb_add(&bar[XB_TOP], 1u);
            const unsigned tg = og / nx;
            if (og + 1u == (tg + 1u) * nx) xb_add(&bar[XB_TOPGEN], 1u);
            else XB_SPIN(xb_ld(&bar[XB_TOPGEN]) == tg, bar);
            __builtin_amdgcn_fence(__ATOMIC_ACQUIRE, "agent");
            xb_add(&bar[XB_XGEN(b.x)], 1u);
            asm volatile("s_waitcnt vmcnt(0)" ::: "memory");
        } else {
            XB_SPIN(xb_ld(&bar[XB_XGEN(b.x)]) == gen, bar);
            __builtin_amdgcn_fence(__ATOMIC_ACQUIRE, "agent");
            asm volatile("s_waitcnt vmcnt(0)" ::: "memory");
        }
    }
    __syncthreads();
}

#define GRID_SYNC() xcd_barrier((unsigned*)(p.ws + OFF_CTL), (volatile LAS unsigned*)(lds + LDS_BYTES - 16))
#ifndef REP_DL
#define REP_DL 1
#endif
#ifndef REP_HGA
#define REP_HGA 1
#endif
#ifndef REP_NA
#define REP_NA 1
#endif
#ifndef REP_SG
#define REP_SG 1
#endif
#ifndef REP_HGC
#define REP_HGC 1
#endif
#define REP_A (REP_DL > REP_HGA ? REP_DL : REP_HGA)
#define REP_B (REP_NA > REP_SG ? REP_NA : REP_SG)
#ifndef MIXREP
#define MIXREP 1
#endif

__global__ void __launch_bounds__(512, 2) fwd_megakernel(Params p) {
    extern __shared__ __attribute__((aligned(16))) unsigned char smem[];
    LAS unsigned char* lds = (LAS unsigned char*)smem;
    cg::grid_group grid = cg::this_grid();
    unsigned char* ws = p.ws;
    const int G = gridDim.x, c = blockIdx.x;
    float* MOD = (float*)(ws + OFF_MOD);
    bf16_t* H = (bf16_t*)(ws + OFF_H); bf16_t* P = (bf16_t*)(ws + OFF_P); bf16_t* BR = (bf16_t*)(ws + OFF_BR); bf16_t* MG = (bf16_t*)(ws + OFF_MG);
    bf16_t* ACT = P;
    float* HGST = (float*)(ws + OFF_HGST); float* HGD = (float*)(ws + OFF_HGD);

    volatile LAS unsigned* xst = (volatile LAS unsigned*)(lds + LDS_BYTES - 16);
    if (threadIdx.x == 0) { xst[0] = 0u; xst[1] = 0u; }
    __syncthreads();
    (void)xcd_barrier_post((unsigned*)(ws + OFF_CTL), xst);
#ifndef SKIP_PRO
    phase_prologue(p, lds);
#endif
    grid.sync();
    phase_mod_reduce(p);
    GRID_SYNC();

    for (int ck = 0; ck < NCHUNK; ++ck) {
        const int L = chunk_L(ck), bbase = chunk_bbase(ck);
        float* X = p.out + (size_t)ck * TC * DM;
        const float* xin = (ck < 2) ? p.in[0] + (size_t)ck * TC * DM : p.in[1];
        for (int l = 0; l < NLAYER; ++l) {
            const float* modl = MOD + (size_t)l * 6144;
            phase_norm_mod(l == 0 ? xin : X, l == 0 ? X : nullptr, H, p.in[6] + l * DM, modl + 0, modl + 1024, L, bbase);
            GRID_SYNC();
#ifndef SKIP_G1
            { SchedStd S; S.to.init(TC / 256, (G == 256) ? NIN / 256 - 1 : NIN / 256, G, c); S.skip_pn = (G == 256) ? (P_HGATE / 256) : 1000; S.A = (const char*)H; S.B = (const char*)(ws + OFF_WIN) + (size_t)l * NIN * DM * 2; S.atile = 256 * DM * 2; S.btile = 256 * DM * 2; S.nt = DM / 64;
              EpiProj E; E.O = P; E.ldc = NIN;
              pg8::gemm_phase(lds, DM, DM, S, E); }
            #endif
            GRID_SYNC();
            for (int rep = 0; rep < MIXREP; ++rep) {
#ifndef SKIP_MIX1
            hg_lb_table(p.in[14], l, lds);
            for (int rr_ = 0; rr_ < REP_A; ++rr_)
            for (int it = c; it < 256 + 1024; it += G) {
                if (it >= 256 && rr_ >= REP_HGA) continue;
                if (it < 256 && rr_ >= REP_DL) continue;
                if (it < 256) { int item = it;
                    if (G == 256) { const int x = it & 7, y = it >> 3, spans = L >> 8, q = x + 8 * (y / spans), span = y % spans;
                        item = (((q >> 2) * spans + span) << 2) | (q & 3); }
                    dl_item(item, P, BR, L, lds); }
                else hgA_item(it - 256, P, HGST, HGD, lds);
            }
            #endif
            GRID_SYNC();
#ifndef SKIP_MIX2
            hgB_phase(HGST, HGD, L);
            if (G == 256) {
                __syncthreads(); na_item((c & 7) * 32 + (c >> 3), P, BR, p.in[13] + (size_t)l * 4 * 15 * 31, L, lds);
                const int y = c >> 3, x = c & 7;
                if ((y & 3) == 0) {
                    __syncthreads();
                    SchedOne S; S.pm = (y >> 2) * 8 + x; S.pn = P_HGATE / 256; S.nt = DM / 64;
                    S.A = (const char*)H + (size_t)S.pm * (256 * DM * 2); S.B = (const char*)(ws + OFF_WIN) + ((size_t)l * NIN + P_HGATE) * DM * 2;
                    EpiProj E; E.O = P; E.ldc = NIN;
                    pg8::gemm_phase(lds, DM, DM, S, E);
                } else {
                    const int rank = (y - (y >> 2) - 1) * 8 + x;
                    for (int it = rank; it < 512; it += 192)
                        sg_item(it, P, BR, (const bf16_t*)(ws + OFF_SGW) + (size_t)l * 4 * 128 * 128, p.in[16] + l * 256, p.in[17] + l * 256, p.in[19] + l * 512, lds);
                }
            } else {
                for (int it = c; it < 256 + 512; it += G) {
                    if (it < 256) { __syncthreads(); na_item(it, P, BR, p.in[13] + (size_t)l * 4 * 15 * 31, L, lds); }
                    else sg_item(it - 256, P, BR, (const bf16_t*)(ws + OFF_SGW) + (size_t)l * 4 * 128 * 128, p.in[16] + l * 256, p.in[17] + l * 256, p.in[19] + l * 512, lds);
                }
            }
            #endif
            GRID_SYNC();
#ifndef SKIP_MIX3
            hg_lb_table(p.in[14], l, lds);
            for (int rr_ = 0; rr_ < REP_HGC; ++rr_)
            for (int it = c; it < 1024; it += G) hgC_item(it, P, BR, HGST, p.in[15] + l * 256, lds);
            #endif
            GRID_SYNC();
            }
#ifndef SKIP_MERGE
            { SchedMerge S; S.to.init(TC / 256, DM / 256, G, c); S.H = (const char*)H; S.BR = (const char*)BR; S.WG = (const char*)(ws + OFF_WG) + (size_t)l * 4 * DM * DM * 2; S.WB = (const char*)(ws + OFF_WB) + (size_t)l * DM * DM * 2;
              EpiMerge E; E.MG = MG; E.bgate = p.in[10] + (size_t)l * 4 * DM; E.scr = (unsigned char*)P + (size_t)c * MERGE_SCR_PER_BLOCK;
              pg8::gemm_phase(lds, DM, DM, S, E); }
            #endif
            GRID_SYNC();
#ifndef SKIP_WO
            { SchedStd S; S.to.init(TC / 256, DM / 256, G, c); S.skip_pn = 1000; S.A = (const char*)MG; S.B = (const char*)(ws + OFF_WO) + (size_t)l * DM * DM * 2; S.atile = 256 * DM * 2; S.btile = 256 * DM * 2; S.nt = DM / 64;
              EpiRes E; E.X = X; E.gm = modl + 2048; E.L = L; E.bbase = bbase;
              pg8::gemm_phase(lds, DM, DM, S, E); }
            #endif
            GRID_SYNC();
            phase_norm_mod(X, nullptr, H, p.in[7] + l * DM, modl + 3072, modl + 4096, L, bbase);
            GRID_SYNC();
#ifndef SKIP_F1
            { SchedStd S; S.to.init(TC / 256, 2 * DFF / 256, G, c); S.skip_pn = 1000; S.A = (const char*)H; S.B = (const char*)(ws + OFF_WGU) + (size_t)l * 2 * DFF * DM * 2; S.atile = 256 * DM * 2; S.btile = 256 * DM * 2; S.nt = DM / 64;
              EpiAct E; E.O = ACT;
              pg8::gemm_phase(lds, DM, DM, S, E); }
            #endif
            GRID_SYNC();
#ifndef SKIP_F2
            { SchedStd S; S.to.init(TC / 256, DM / 256, G, c); S.skip_pn = 1000; S.A = (const char*)ACT; S.B = (const char*)(ws + OFF_WD) + (size_t)l * DM * DFF * 2; S.atile = (size_t)256 * DFF * 2; S.btile = (size_t)256 * DFF * 2; S.nt = DFF / 64;
              EpiRes E; E.X = X; E.gm = modl + 5120; E.L = L; E.bbase = bbase;
              pg8::gemm_phase(lds, DFF, DFF, S, E); }
            #endif
            GRID_SYNC();
        }
        phase_final_norm(X, p.in[23]);
    }
}

extern "C" void kernel_launch(void* const* d_in, const int* in_sizes, int n_in, void* d_out, int out_size, void* d_ws, size_t ws_size, hipStream_t stream) {
    static int grid = 0;
    if (grid == 0) {
        if (n_in != 24 || ws_size < WS_END) { fprintf(stderr, "kernel_launch: unexpected n_in %d or ws_size %zu (need %zu)\n", n_in, ws_size, (size_t)WS_END); grid = -1; return; }
        int dev = 0, cus = 0, per_cu = 0;
        hipGetDevice(&dev);
        hipDeviceGetAttribute(&cus, hipDeviceAttributeMultiprocessorCount, dev);
        if (hipFuncSetAttribute((const void*)fwd_megakernel, hipFuncAttributeMaxDynamicSharedMemorySize, LDS_BYTES) != hipSuccess) { fprintf(stderr, "kernel_launch: hipFuncSetAttribute failed\n"); grid = -1; return; }
        hipOccupancyMaxActiveBlocksPerMultiprocessor(&per_cu, (const void*)fwd_megakernel, NTHR, LDS_BYTES);
        if (per_cu < 1) { fprintf(stderr, "kernel_launch: occupancy query says %d blocks per CU\n", per_cu); per_cu = 1; }
        (void)hipGetLastError();
        grid = cus;
        if (grid > 272) grid = 272;
    }
    if (grid < 0) return;
    if (hipMemsetAsync((char*)d_ws + OFF_CTL, 0, 16384, stream) != hipSuccess) { fprintf(stderr, "kernel_launch: memset of control words failed\n"); return; }
    Params p{};
    for (int i = 0; i < 24; ++i) p.in[i] = (const float*)d_in[i];
    p.out = (float*)d_out; p.ws = (unsigned char*)d_ws;
    void* args[] = {&p};
    hipError_t e = hipLaunchCooperativeKernel((const void*)fwd_megakernel, dim3(grid), dim3(NTHR), args, LDS_BYTES, stream);
    if (e != hipSuccess) fprintf(stderr, "cooperative launch failed: %s (grid %d)\n", hipGetErrorString(e), grid);
}
```

```cpp
#include <hip/hip_runtime.h>
#include <hip/hip_cooperative_groups.h>
#include <cstdio>
#include <cstdint>
namespace cg = cooperative_groups;

#define LAS __attribute__((address_space(3)))
typedef unsigned short bf16_t;
typedef short bf16x8 __attribute__((ext_vector_type(8)));
typedef float f32x4 __attribute__((ext_vector_type(4)));
typedef unsigned u32x4 __attribute__((ext_vector_type(4)));
typedef unsigned u32x2 __attribute__((ext_vector_type(2)));

constexpr int DM = 1024, TC = 16384, NCHUNK = 3, NIN = 3328, DFF = 2816, NLAYER = 4, NB = 20;
constexpr int P_NAQ = 0, P_NAK = 256, P_NAV = 512, P_FF = 768, P_FB = 1024, P_HQ = 1280, P_HI = 1536, P_HGATE = 1792, P_SU = 2048, P_SV = 2304, P_DQ = 2560, P_DK = 2816, P_DV = 3072;
constexpr float EPSV = 1e-6f;
constexpr int LDS_BYTES = 163840;
constexpr int NTHR = 512;

constexpr size_t OFF_CTL = 0;
constexpr size_t OFF_MOD = 16384;
constexpr size_t SZ_MOD = (size_t)NB * NLAYER * 6144 * 4;
constexpr size_t OFF_MODP = OFF_MOD + SZ_MOD;
constexpr size_t OFF_WIN = OFF_MODP + 8 * SZ_MOD;
constexpr size_t OFF_WG = OFF_WIN + (size_t)NLAYER * NIN * DM * 2;
constexpr size_t OFF_WB = OFF_WG + (size_t)NLAYER * 4 * DM * DM * 2;
constexpr size_t OFF_WO = OFF_WB + (size_t)NLAYER * DM * DM * 2;
constexpr size_t OFF_WGU = OFF_WO + (size_t)NLAYER * DM * DM * 2;
constexpr size_t OFF_WD = OFF_WGU + (size_t)NLAYER * 2 * DFF * DM * 2;
constexpr size_t OFF_SGW = OFF_WD + (size_t)NLAYER * DM * DFF * 2;
constexpr size_t OFF_H = OFF_SGW + (size_t)NLAYER * 4 * 128 * 128 * 2;
constexpr size_t OFF_P = OFF_H + (size_t)TC * DM * 2;
constexpr size_t OFF_BR = OFF_P + (size_t)TC * NIN * 2;
constexpr size_t OFF_MG = OFF_BR + (size_t)TC * DM * 2;
constexpr size_t OFF_HGST = OFF_MG + (size_t)TC * DM * 2;
constexpr size_t OFF_HGD = OFF_HGST + (size_t)256 * 8 * 4096 * 4;
constexpr size_t WS_END = OFF_HGD + (size_t)256 * 8 * 64 * 4;
constexpr size_t MERGE_SCR_PER_BLOCK = 131072 + 131072;

struct Params {
    const float* in[24];
    float* out;
    unsigned char* ws;
};

__device__ __forceinline__ unsigned pk2(float lo, float hi) { unsigned r; asm("v_cvt_pk_bf16_f32 %0, %1, %2" : "=v"(r) : "v"(lo), "v"(hi)); return r; }
__device__ __forceinline__ bf16_t f2bf(float f) { return (bf16_t)(pk2(f, 0.f) & 0xffffu); }
__device__ __forceinline__ float bf2f(unsigned b) { return __uint_as_float(b << 16); }
__device__ __forceinline__ float bflo(unsigned w) { return __uint_as_float(w << 16); }
__device__ __forceinline__ float bfhi(unsigned w) { return __uint_as_float(w & 0xffff0000u); }
__device__ __forceinline__ float sigmoidf_(float x) { return 1.f / (1.f + __expf(-x)); }
__device__ __forceinline__ float siluf_(float x) { return x * sigmoidf_(x); }
__device__ __forceinline__ float gelu_tanh(float x) { return x * sigmoidf_(1.5957691216f * (x + 0.044715f * x * x * x)); }
__device__ __forceinline__ float wave_sum(float v) {
#pragma unroll
    for (int o = 1; o < 64; o <<= 1) v += __shfl_xor(v, o);
    return v;
}
__device__ __forceinline__ int opaque_tid() { int t = threadIdx.x; asm volatile("" : "+v"(t)); return t; }
#define MFMA16(a, b, c) __builtin_amdgcn_mfma_f32_16x16x32_bf16((a), (b), (c), 0, 0, 0)

__device__ __forceinline__ int chunk_L(int ck) { return ck < 2 ? 2048 : 4096; }
__device__ __forceinline__ int chunk_bbase(int ck) { return ck * 8; }

namespace pg8 {
constexpr int BM = 256, BK = 64, HALF = 128, HTB = HALF * BK * 2, STAGE_BYTES = 8 * HTB, NXCD = 8, WGM = 8;
__host__ __device__ __forceinline__ int lds_byte(int r, int c) { const int st = (r >> 4) * 2 + (c >> 5), rr = r & 15, cc = c & 31, ob = rr * 64 + cc * 2; return st * 1024 + (ob ^ (((ob >> 9) & 1) << 5)); }
__host__ __device__ __forceinline__ void stage_rc(int b, int& R, int& C) { const int st = b / 1024, sb = b % 1024, swz = sb ^ (((sb >> 9) & 1) << 5); R = (st >> 1) * 16 + swz / 64; C = (st & 1) * 32 + (swz % 64) / 2; }
__host__ __device__ __forceinline__ int perm32(int rho) { const int n = rho >> 4, i = rho & 15; return 8 * (i >> 2) + 4 * n + (i & 3); }

struct Unit { const char* a; const char* b; int nt; int pm, pn, kind; };

struct TileOrder {
    int nM, nN, nwg, G, c;
    __device__ __forceinline__ void init(int nM_, int nN_, int G_, int c_) { nM = nM_; nN = nN_; nwg = nM * nN; G = G_; c = c_; }
    __device__ __forceinline__ bool tile(int i, int& pm, int& pn) const {
        const long L = (long)i * G + c; if (L >= nwg) return false;
        int wgid = (int)L; { const int q = nwg / NXCD, r = nwg % NXCD, xcd = wgid % NXCD, off = wgid / NXCD; wgid = (xcd < r ? xcd * (q + 1) : r * (q + 1) + (xcd - r) * q) + off; }
        const int nig = WGM * nN, gid = wgid / nig, fm = gid * WGM, gsz = (nM - fm) < WGM ? (nM - fm) : WGM;
        pm = fm + ((wgid % nig) % gsz); pn = (wgid % nig) / gsz; return true;
    }
};

template <class Epi, class Sched>
__device__ __forceinline__ void gemm_phase(LAS unsigned char* lds, const int lda, const int ldb, const Sched& S, const Epi& E) {
    const int tid = opaque_tid(), wid = __builtin_amdgcn_readfirstlane(tid >> 6), lane = tid & 63, wr = wid >> 2, wc = wid & 3, fr = lane & 15, fq = lane >> 4;
    unsigned voffA[2], voffB[2];
#pragma unroll
    for (int i = 0; i < 2; ++i) { int R, C; stage_rc(tid * 16 + i * 8192, R, C); const int Rb = Epi::PERM ? ((R & ~31) + perm32(R & 31)) : R;
        voffA[i] = (unsigned)(R * lda + C) * 2u; voffB[i] = (unsigned)(Rb * ldb + C) * 2u; }
    const size_t kstep = (size_t)(BK * 2);
    const size_t hstepA = (size_t)HALF * lda * 2, hstepB = (size_t)HALF * ldb * 2;
    const unsigned ldsw = (unsigned)wid * 1024u;
    const int aoff = lds_byte(wr * 64 + fr, fq * 8), boff = lds_byte(wc * 32 + fr, fq * 8);
#define PG8_SA(b, h) (((b) * 2 + (h)) * HTB)
#define PG8_SB(b, h) ((4 + (b) * 2 + (h)) * HTB)
#define PG8_STAGE(bufoff, gbase, voff) do { _Pragma("unroll") for (int _i = 0; _i < 2; ++_i) \
        __builtin_amdgcn_global_load_lds((const unsigned*)((const char*)(gbase) + (voff)[_i]), (LAS unsigned*)(lds + (bufoff) + ldsw + _i * 8192), 16, 0, 0); } while (0)
#define PG8_LDA(dst, b, h) do { _Pragma("unroll") for (int m = 0; m < 4; ++m) _Pragma("unroll") for (int k = 0; k < 2; ++k) dst[m][k] = *(const LAS bf16x8*)(lds + PG8_SA(b, h) + aoff + m * 2048 + k * 1024); } while (0)
#define PG8_LDB(dst, b, h) do { _Pragma("unroll") for (int n = 0; n < 2; ++n) _Pragma("unroll") for (int k = 0; k < 2; ++k) dst[n][k] = *(const LAS bf16x8*)(lds + PG8_SB(b, h) + boff + n * 2048 + k * 1024); } while (0)
#define PG8_MMA(ai, bj, At, Bt) do { __builtin_amdgcn_s_setprio(1); _Pragma("unroll") for (int m = 0; m < 4; ++m) _Pragma("unroll") for (int n = 0; n < 2; ++n) _Pragma("unroll") for (int k = 0; k < 2; ++k) \
        acc[ai][bj][m][n] = __builtin_amdgcn_mfma_f32_16x16x32_bf16(Bt[n][k], At[m][k], acc[ai][bj][m][n], 0, 0, 0); __builtin_amdgcn_s_setprio(0); } while (0)
#define PG8_WAIT_V(n) asm volatile("s_waitcnt vmcnt(" #n ")" ::: "memory")
#define PG8_WAIT_L(n) asm volatile("s_waitcnt lgkmcnt(" #n ")" ::: "memory")
#define PG8_BAR __builtin_amdgcn_s_barrier()
#define PG8_SCHED __builtin_amdgcn_sched_barrier(0)
    Unit cur, nxt; int ui = 0;
    if (!S.next(0, cur)) return;
    f32x4 acc[2][2][4][2];
#pragma unroll
    for (int a = 0; a < 2; ++a)
#pragma unroll
        for (int b = 0; b < 2; ++b)
#pragma unroll
            for (int m = 0; m < 4; ++m)
#pragma unroll
                for (int n = 0; n < 2; ++n) acc[a][b][m][n] = (f32x4){0.f, 0.f, 0.f, 0.f};
    bf16x8 At[4][2], B0[2][2], B1[2][2];
    const char* cA = cur.a; const char* cB = cur.b;
    PG8_STAGE(PG8_SB(0, 0), cB, voffB); PG8_STAGE(PG8_SA(0, 0), cA, voffA); PG8_STAGE(PG8_SB(0, 1), cB + hstepB, voffB); PG8_STAGE(PG8_SA(0, 1), cA + hstepA, voffA);
    if (wr == 1) PG8_BAR;
    PG8_WAIT_V(4); PG8_BAR;
    PG8_STAGE(PG8_SB(1, 0), cB + kstep, voffB); PG8_STAGE(PG8_SA(1, 0), cA + kstep, voffA); PG8_STAGE(PG8_SB(1, 1), cB + hstepB + kstep, voffB);
    PG8_WAIT_V(6); PG8_BAR;
    for (;;) {
        const bool has_next = S.next(ui + 1, nxt);
        const char* nA = has_next ? nxt.a : cA; const char* nB = has_next ? nxt.b : cB;
        const int nt = cur.nt;
        for (int t = 0; t < nt; t += 2) {
            const bool last = (t == nt - 2);
            const char* a1 = cA + (size_t)(t + 1) * kstep;
            const char* a2 = last ? nA : cA + (size_t)(t + 2) * kstep; const char* b2 = last ? nB : cB + (size_t)(t + 2) * kstep;
            const char* a3 = a2 + kstep; const char* b3 = b2 + kstep;
            PG8_LDB(B0, 0, 0); PG8_SCHED; PG8_LDA(At, 0, 0); PG8_STAGE(PG8_SA(1, 1), a1 + hstepA, voffA);
            PG8_WAIT_L(8); PG8_BAR; PG8_WAIT_L(0); PG8_MMA(0, 0, At, B0); PG8_BAR; PG8_SCHED;
            PG8_LDB(B1, 0, 1); PG8_STAGE(PG8_SB(0, 0), b2, voffB);
            PG8_BAR; PG8_WAIT_L(0); PG8_MMA(0, 1, At, B1); PG8_BAR;
            PG8_LDA(At, 0, 1); PG8_STAGE(PG8_SA(0, 0), a2, voffA);
            PG8_BAR; PG8_WAIT_L(0); PG8_MMA(1, 0, At, B0); PG8_BAR; PG8_SCHED;
            PG8_STAGE(PG8_SB(0, 1), b2 + hstepB, voffB);
            PG8_WAIT_V(6); PG8_BAR; PG8_MMA(1, 1, At, B1); PG8_BAR;
            PG8_LDB(B0, 1, 0); PG8_SCHED; PG8_LDA(At, 1, 0); PG8_STAGE(PG8_SA(0, 1), a2 + hstepA, voffA);
            PG8_WAIT_L(8); PG8_BAR; PG8_WAIT_L(0); PG8_MMA(0, 0, At, B0); PG8_BAR; PG8_SCHED;
            PG8_LDB(B1, 1, 1); PG8_STAGE(PG8_SB(1, 0), b3, voffB);
            PG8_BAR; PG8_WAIT_L(0); PG8_MMA(0, 1, At, B1); PG8_BAR;
            PG8_LDA(At, 1, 1); PG8_STAGE(PG8_SA(1, 0), a3, voffA);
            PG8_BAR; PG8_WAIT_L(0); PG8_MMA(1, 0, At, B0); PG8_BAR; PG8_SCHED;
            PG8_STAGE(PG8_SB(1, 1), b3 + hstepB, voffB);
            PG8_WAIT_V(6); PG8_BAR; PG8_MMA(1, 1, At, B1); PG8_BAR;
        }
        E(acc, cur, wr, wc, fr, fq);
        if (!has_next) break;
#pragma unroll
        for (int a = 0; a < 2; ++a)
#pragma unroll
            for (int b = 0; b < 2; ++b)
#pragma unroll
                for (int m = 0; m < 4; ++m)
#pragma unroll
                    for (int n = 0; n < 2; ++n) acc[a][b][m][n] = (f32x4){0.f, 0.f, 0.f, 0.f};
        cur = nxt; cA = nA; cB = nB; ++ui;
    }
    PG8_WAIT_V(0);
    if (wr == 0) PG8_BAR;
    PG8_BAR;
#undef PG8_SA
#undef PG8_SB
#undef PG8_STAGE
#undef PG8_LDA
#undef PG8_LDB
#undef PG8_MMA
#undef PG8_WAIT_V
#undef PG8_WAIT_L
#undef PG8_BAR
#undef PG8_SCHED
}
}
using pg8::Unit;

struct SchedStd {
    pg8::TileOrder to; const char* A; const char* B; size_t atile, btile; int nt; int skip_pn;
    __device__ __forceinline__ bool next(int i, Unit& u) const {
        int pm, pn; if (!to.tile(i, pm, pn)) return false;
        pn += (pn >= skip_pn) ? 1 : 0;
        u.pm = pm; u.pn = pn; u.kind = 0; u.nt = nt; u.a = A + (size_t)pm * atile; u.b = B + (size_t)pn * btile; return true;
    }
};
struct SchedOne {
    const char* A; const char* B; int nt, pm, pn;
    __device__ __forceinline__ bool next(int i, Unit& u) const { if (i > 0) return false; u.pm = pm; u.pn = pn; u.kind = 0; u.nt = nt; u.a = A; u.b = B; return true; }
};
struct SchedMerge {
    pg8::TileOrder to; const char* H; const char* BR; const char* WG; const char* WB;
    __device__ __forceinline__ bool next(int i, Unit& u) const {
        int pm, pn; if (!to.tile(i >> 3, pm, pn)) return false;
        const int sub = i & 7, bi = sub >> 1;
        u.pm = pm; u.pn = pn; u.kind = sub;
        if (sub & 1) { u.nt = 16; u.a = H + (size_t)pm * (256 * DM * 2); u.b = WG + (size_t)bi * (DM * DM * 2) + (size_t)pn * (256 * DM * 2); }
        else { u.nt = 4; u.a = BR + (size_t)pm * (256 * DM * 2) + bi * 512; u.b = WB + (size_t)pn * (256 * DM * 2) + bi * 512; }
        return true;
    }
};

struct EpiProj {
    static constexpr bool PERM = true;
    bf16_t* O; int ldc;
    __device__ __forceinline__ void operator()(const f32x4 (&acc)[2][2][4][2], const Unit& u, int wr, int wc, int fr, int fq) const {
        const int row0 = u.pm * 256 + wr * 64 + fr, col0 = u.pn * 256 + wc * 32 + 8 * fq;
#pragma unroll
        for (int ai = 0; ai < 2; ++ai)
#pragma unroll
            for (int m = 0; m < 4; ++m) { bf16_t* rowp = O + (size_t)(row0 + ai * 128 + m * 16) * ldc + col0;
#pragma unroll
                for (int bj = 0; bj < 2; ++bj) { const f32x4 v0 = acc[ai][bj][m][0], v1 = acc[ai][bj][m][1];
                    u32x4 o; o.x = pk2(v0[0], v0[1]); o.y = pk2(v0[2], v0[3]); o.z = pk2(v1[0], v1[1]); o.w = pk2(v1[2], v1[3]);
                    *(u32x4*)(rowp + bj * 128) = o; } }
    }
};
struct EpiAct {
    static constexpr bool PERM = true;
    bf16_t* O;
    __device__ __forceinline__ void operator()(const f32x4 (&acc)[2][2][4][2], const Unit& u, int wr, int wc, int fr, int fq) const {
        const int row0 = u.pm * 256 + wr * 64 + fr, col0 = u.pn * 128 + wc * 32 + 8 * fq;
#pragma unroll
        for (int ai = 0; ai < 2; ++ai)
#pragma unroll
            for (int m = 0; m < 4; ++m) { bf16_t* rowp = O + (size_t)(row0 + ai * 128 + m * 16) * DFF + col0;
                float r[8];
#pragma unroll
                for (int n = 0; n < 2; ++n)
#pragma unroll
                    for (int j = 0; j < 4; ++j) { const float g = acc[ai][0][m][n][j], up = acc[ai][1][m][n][j]; r[n * 4 + j] = siluf_(g) * up; }
                u32x4 o; o.x = pk2(r[0], r[1]); o.y = pk2(r[2], r[3]); o.z = pk2(r[4], r[5]); o.w = pk2(r[6], r[7]);
                *(u32x4*)rowp = o; }
    }
};
struct EpiRes {
    static constexpr bool PERM = false;
    float* X; const float* gm; int L; int bbase;
    __device__ __forceinline__ void operator()(const f32x4 (&acc)[2][2][4][2], const Unit& u, int wr, int wc, int fr, int fq) const {
        const int row0 = u.pm * 256 + wr * 64 + fr, col0 = u.pn * 256 + wc * 32 + 4 * fq;
        const int b = bbase + (u.pm * 256) / L;
        const float* g = gm + (size_t)b * (NLAYER * 6144) + col0;
        f32x4 gv[2][2];
#pragma unroll
        for (int bj = 0; bj < 2; ++bj)
#pragma unroll
            for (int n = 0; n < 2; ++n) gv[bj][n] = *(const f32x4*)(g + bj * 128 + n * 16);
#pragma unroll
        for (int ai = 0; ai < 2; ++ai)
#pragma unroll
            for (int mh = 0; mh < 2; ++mh) {
                f32x4 xv[2][2][2];
#pragma unroll
                for (int mm = 0; mm < 2; ++mm) { const float* rowp = X + (size_t)(row0 + ai * 128 + (2 * mh + mm) * 16) * DM + col0;
#pragma unroll
                    for (int bj = 0; bj < 2; ++bj)
#pragma unroll
                        for (int n = 0; n < 2; ++n) xv[mm][bj][n] = *(const f32x4*)(rowp + bj * 128 + n * 16); }
#pragma unroll
                for (int mm = 0; mm < 2; ++mm) { float* rowp = X + (size_t)(row0 + ai * 128 + (2 * mh + mm) * 16) * DM + col0;
#pragma unroll
                    for (int bj = 0; bj < 2; ++bj)
#pragma unroll
                        for (int n = 0; n < 2; ++n) *(f32x4*)(rowp + bj * 128 + n * 16) = xv[mm][bj][n] + gv[bj][n] * acc[ai][bj][2 * mh + mm][n]; }
            }
    }
};
struct EpiMerge {
    static constexpr bool PERM = true;
    bf16_t* MG; const float* bgate;
    unsigned char* scr;
    __device__ __forceinline__ void operator()(const f32x4 (&acc)[2][2][4][2], const Unit& u, int wr, int wc, int fr, int fq) const {
        const int tid = threadIdx.x, bi = u.kind >> 1;
        unsigned char* pbp = scr + tid * 16;
        asm volatile("" : "+v"(pbp));
        if ((u.kind & 1) == 0) {
#pragma unroll
            for (int bj = 0; bj < 2; ++bj)
#pragma unroll
                for (int ai = 0; ai < 2; ++ai)
#pragma unroll
                    for (int m = 0; m < 4; ++m) { const f32x4 v0 = acc[ai][bj][m][0], v1 = acc[ai][bj][m][1];
                        u32x4 o; o.x = pk2(v0[0], v0[1]); o.y = pk2(v0[2], v0[3]); o.z = pk2(v1[0], v1[1]); o.w = pk2(v1[2], v1[3]);
                        *(u32x4*)(pbp + ((bj * 2 + ai) * 4 + m) * 8192) = o; }
        } else {
            const int row0 = u.pm * 256 + wr * 64 + fr, col0 = u.pn * 256 + wc * 32 + 8 * fq;
            const float* bg = bgate + bi * DM + col0;
            bf16_t* mgp = MG + (size_t)row0 * DM + col0;
#pragma unroll
            for (int bj = 0; bj < 2; ++bj) {
                const f32x4 b0 = *(const f32x4*)(bg + bj * 128), b1 = *(const f32x4*)(bg + bj * 128 + 4);
                u32x4 pv[8], pp[8];
#pragma unroll
                for (int k = 0; k < 8; ++k) { pv[k] = *(const u32x4*)(pbp + (bj * 8 + k) * 8192);
                    pp[k] = (bi > 0) ? *(const u32x4*)(pbp + 131072 + (bj * 8 + k) * 8192) : (u32x4){0u, 0u, 0u, 0u}; }
#pragma unroll
                for (int ai = 0; ai < 2; ++ai)
#pragma unroll
                    for (int m = 0; m < 4; ++m) { const int k = ai * 4 + m;
                        const f32x4 a0 = acc[ai][bj][m][0] + b0, a1 = acc[ai][bj][m][1] + b1;
                        f32x4 r0, r1;
                        r0[0] = sigmoidf_(a0[0]) * bflo(pv[k].x) + bflo(pp[k].x); r0[1] = sigmoidf_(a0[1]) * bfhi(pv[k].x) + bfhi(pp[k].x);
                        r0[2] = sigmoidf_(a0[2]) * bflo(pv[k].y) + bflo(pp[k].y); r0[3] = sigmoidf_(a0[3]) * bfhi(pv[k].y) + bfhi(pp[k].y);
                        r1[0] = sigmoidf_(a1[0]) * bflo(pv[k].z) + bflo(pp[k].z); r1[1] = sigmoidf_(a1[1]) * bfhi(pv[k].z) + bfhi(pp[k].z);
                        r1[2] = sigmoidf_(a1[2]) * bflo(pv[k].w) + bflo(pp[k].w); r1[3] = sigmoidf_(a1[3]) * bfhi(pv[k].w) + bfhi(pp[k].w);
                        u32x4 o; o.x = pk2(r0[0], r0[1]); o.y = pk2(r0[2], r0[3]); o.z = pk2(r1[0], r1[1]); o.w = pk2(r1[2], r1[3]);
                        if (bi < 3) *(u32x4*)(pbp + 131072 + (bj * 8 + k) * 8192) = o;
                        else *(u32x4*)(mgp + (size_t)(ai * 128 + m * 16) * DM + bj * 128) = o; }
            }
        }
    }
};

__device__ __forceinline__ void transpose_item(const float* W, int N, int k0, int n0, bf16_t* dst  , int ldwt, LAS float* scr, int lane) {
    float tv[32];
#pragma unroll
    for (int i = 0; i < 32; ++i) tv[i] = W[(size_t)(k0 + 2 * i + (lane >> 5)) * N + n0 + (lane & 31)];
#pragma unroll
    for (int i = 0; i < 32; ++i) scr[(2 * i + (lane >> 5)) * 33 + (lane & 31)] = tv[i];
    __builtin_amdgcn_wave_barrier();
    const int c = lane & 7;
#pragma unroll
    for (int j = 0; j < 4; ++j) { const int n = (lane >> 3) + 8 * j; const LAS float* s = scr + (8 * c) * 33 + n;
        u32x4 o; o.x = pk2(s[0 * 33], s[1 * 33]); o.y = pk2(s[2 * 33], s[3 * 33]); o.z = pk2(s[4 * 33], s[5 * 33]); o.w = pk2(s[6 * 33], s[7 * 33]);
        *(u32x4*)(dst + (size_t)n * ldwt + 8 * c) = o; }
    __builtin_amdgcn_wave_barrier();
}

__device__ __forceinline__ void phase_prologue(const Params& p, LAS unsigned char* lds) {
    const int tid = opaque_tid(), lane = tid & 63, wave = tid >> 6;
    unsigned char* ws = p.ws;
    {
        LAS float* scr = (LAS float*)(lds + wave * 8704);
        const int gw = blockIdx.x * 8 + wave, NGW = gridDim.x * 8;
        constexpr int I_IN = 16 * (NIN / 32), I_G = 4 * 16 * 32, I_B = 4 * 4 * 32, I_O = 16 * 32, I_F = 16 * (DFF / 32), I_D = (DFF / 64) * 32;
        constexpr int PER_LAYER = I_IN + I_G + I_B + I_O + 2 * I_F + I_D;
        for (int it = gw; it < NLAYER * PER_LAYER; it += NGW) {
            const int l = it / PER_LAYER; int r = it % PER_LAYER;
            if (r < I_IN) { const int nb = r % (NIN / 32), kb = r / (NIN / 32);
                transpose_item(p.in[8] + (size_t)l * DM * NIN, NIN, 64 * kb, 32 * nb, (bf16_t*)(ws + OFF_WIN) + ((size_t)l * NIN + 32 * nb) * DM + 64 * kb, DM, scr, lane); continue; }
            r -= I_IN;
            if (r < I_G) { const int bi = r / 512, rr = r % 512, nb = rr % 32, kb = rr / 32;
                transpose_item(p.in[9] + ((size_t)l * 4 + bi) * DM * DM, DM, 64 * kb, 32 * nb, (bf16_t*)(ws + OFF_WG) + (((size_t)l * 4 + bi) * DM + 32 * nb) * DM + 64 * kb, DM, scr, lane); continue; }
            r -= I_G;
            if (r < I_B) { const int bi = r / 128, rr = r % 128, nb = rr % 32, kb = rr / 32;
                transpose_item(p.in[11] + ((size_t)l * 4 + bi) * 256 * DM, DM, 64 * kb, 32 * nb, (bf16_t*)(ws + OFF_WB) + ((size_t)l * DM + 32 * nb) * DM + bi * 256 + 64 * kb, DM, scr, lane); continue; }
            r -= I_B;
            if (r < I_O) { const int nb = r % 32, kb = r / 32;
                transpose_item(p.in[12] + (size_t)l * DM * DM, DM, 64 * kb, 32 * nb, (bf16_t*)(ws + OFF_WO) + ((size_t)l * DM + 32 * nb) * DM + 64 * kb, DM, scr, lane); continue; }
            r -= I_O;
            if (r < 2 * I_F) { const int which = r / I_F, rr = r % I_F, nb = rr % (DFF / 32), kb = rr / (DFF / 32);
                const int n0 = 32 * nb, row = (n0 >> 7) * 256 + (n0 & 127) + which * 128;
                transpose_item(p.in[which ? 21 : 20] + (size_t)l * DM * DFF, DFF, 64 * kb, n0, (bf16_t*)(ws + OFF_WGU) + ((size_t)l * 2 * DFF + row) * DM + 64 * kb, DM, scr, lane); continue; }
            r -= 2 * I_F;
            { const int nb = r % 32, kb = r / 32;
                transpose_item(p.in[22] + (size_t)l * DFF * DM, DM, 64 * kb, 32 * nb, (bf16_t*)(ws + OFF_WD) + ((size_t)l * DM + 32 * nb) * DFF + 64 * kb, DFF, scr, lane); }
        }
    }
    {
        const float* src = p.in[18]; bf16_t* dst = (bf16_t*)(ws + OFF_SGW);
        for (int i = blockIdx.x * NTHR + tid; i < NLAYER * 4 * 128 * 128 / 4; i += gridDim.x * NTHR) {
            const f32x4 v = *(const f32x4*)(src + 4 * (size_t)i); u32x2 o; o.x = pk2(v[0], v[1]); o.y = pk2(v[2], v[3]); *(u32x2*)(dst + 4 * (size_t)i) = o; }
    }
    __syncthreads();
    {
        LAS float* cs = (LAS float*)lds;
        float* modp = (float*)(ws + OFF_MODP);
        for (int it = blockIdx.x; it < NLAYER * 12 * 8; it += gridDim.x) {
            const int ks = it & 7, nb = (it >> 3) % 12, l = it / 96;
            __syncthreads();
            for (int e = tid; e < 128 * NB; e += NTHR) { const int kk = e / NB, b = e % NB;
                const float c = b < 16 ? p.in[2][b * DM + 128 * ks + kk] : p.in[3][(b - 16) * DM + 128 * ks + kk];
                cs[kk * NB + b] = siluf_(c); }
            __syncthreads();
            const int n = nb * 512 + tid;
            const float* w = p.in[4] + ((size_t)l * DM + 128 * ks) * 6144 + n;
            float a[NB];
#pragma unroll
            for (int b = 0; b < NB; ++b) a[b] = 0.f;
#pragma unroll 16
            for (int kk = 0; kk < 128; ++kk) { const float wv = w[(size_t)kk * 6144];
#pragma unroll
                for (int b4 = 0; b4 < NB / 4; ++b4) { const f32x4 c4 = *(const LAS f32x4*)(cs + kk * NB + 4 * b4);
                    a[4 * b4 + 0] += c4[0] * wv; a[4 * b4 + 1] += c4[1] * wv; a[4 * b4 + 2] += c4[2] * wv; a[4 * b4 + 3] += c4[3] * wv; } }
#pragma unroll
            for (int b = 0; b < NB; ++b) modp[(((size_t)ks * NB + b) * NLAYER + l) * 6144 + n] = a[b];
        }
    }
}
__device__ __forceinline__ void phase_mod_reduce(const Params& p) {
    const float* modp = (const float*)(p.ws + OFF_MODP); float* mod = (float*)(p.ws + OFF_MOD);
    constexpr int NMOD = NB * NLAYER * 6144;
    for (int i = blockIdx.x * NTHR + opaque_tid(); i < NMOD; i += gridDim.x * NTHR) {
        const int n = i % 6144, l = (i / 6144) % NLAYER;
        float s = p.in[5][l * 6144 + n];
#pragma unroll
        for (int ks = 0; ks < 8; ++ks) s += modp[(size_t)ks * NMOD + i];
        mod[i] = s;
    }
}

__device__ __forceinline__ void phase_norm_mod(const float* xsrc, float* copy_to, bf16_t* H, const float* g, const float* mod_sh, const float* mod_sc, int L, int bbase) {
    const int tid = opaque_tid(), lane = tid & 63, gw = blockIdx.x * 8 + (tid >> 6), NGW = gridDim.x * 8;
    for (int row = gw; row < TC; row += NGW) {
        const int b = bbase + row / L;
        const f32x4* xr = (const f32x4*)(xsrc + (size_t)row * DM) + lane;
        f32x4 v[4]; float s = 0.f;
#pragma unroll
        for (int j = 0; j < 4; ++j) { v[j] = xr[64 * j]; s += (v[j][0] * v[j][0] + v[j][1] * v[j][1]) + (v[j][2] * v[j][2] + v[j][3] * v[j][3]); }
        const float rstd = rsqrtf(wave_sum(s) * (1.f / DM) + EPSV);
        if (copy_to) { f32x4* cr = (f32x4*)(copy_to + (size_t)row * DM) + lane;
#pragma unroll
            for (int j = 0; j < 4; ++j) cr[64 * j] = v[j]; }
        const f32x4* gr = (const f32x4*)g + lane;
        const f32x4* shr = (const f32x4*)(mod_sh + (size_t)b * (NLAYER * 6144)) + lane;
        const f32x4* scr = (const f32x4*)(mod_sc + (size_t)b * (NLAYER * 6144)) + lane;
        u32x2* o = (u32x2*)(H + (size_t)row * DM) + lane;
#pragma unroll
        for (int j = 0; j < 4; ++j) { const f32x4 gg = gr[64 * j], sh = shr[64 * j], sc = scr[64 * j];
            const f32x4 y = v[j] * rstd * gg * (sc + 1.f) + sh;
            u32x2 w; w.x = pk2(y[0], y[1]); w.y = pk2(y[2], y[3]); o[64 * j] = w; }
    }
}
__device__ __forceinline__ void phase_final_norm(float* X, const float* g) {
    const int tid = opaque_tid(), lane = tid & 63, gw = blockIdx.x * 8 + (tid >> 6), NGW = gridDim.x * 8;
    for (int row = gw; row < TC; row += NGW) {
        f32x4* xr = (f32x4*)(X + (size_t)row * DM) + lane;
        f32x4 v[4]; float s = 0.f;
#pragma unroll
        for (int j = 0; j < 4; ++j) { v[j] = xr[64 * j]; s += (v[j][0] * v[j][0] + v[j][1] * v[j][1]) + (v[j][2] * v[j][2] + v[j][3] * v[j][3]); }
        const float rstd = rsqrtf(wave_sum(s) * (1.f / DM) + EPSV);
        const f32x4* gr = (const f32x4*)g + lane;
#pragma unroll
        for (int j = 0; j < 4; ++j) xr[64 * j] = v[j] * rstd * gr[64 * j];
    }
}

struct AttnState { f32x4 o[4]; float m, l; };
constexpr int VT_BYTES = 5120;
struct KVRegs { bf16x8 k[2][2]; u32x4 v[4]; };
template <class TokK, class TokV>
__device__ __forceinline__ void kv_load(KVRegs& kv, const bf16_t* P, int kcol, int vcol, int lane, int fq, const TokK& tok_k, const TokV& tok_v) {
#pragma unroll
    for (int t = 0; t < 2; ++t) { const bf16_t* kp = P + (size_t)tok_k(t) * NIN + kcol + 8 * fq; kv.k[t][0] = *(const bf16x8*)kp; kv.k[t][1] = *(const bf16x8*)(kp + 32); }
#pragma unroll
    for (int i = 0; i < 4; ++i) { const int pc = lane + 64 * i, key = pc >> 3, ch = pc & 7; kv.v[i] = *(const u32x4*)(P + (size_t)tok_v(key) * NIN + vcol + 8 * ch); }
}
constexpr int VROW = 72;
typedef short v4s_t __attribute__((ext_vector_type(4)));
__device__ __forceinline__ void attn_stage_v(LAS bf16_t* vt, const KVRegs& kv, int lane) {
#pragma unroll
    for (int i = 0; i < 4; ++i) { const int pc = lane + 64 * i, key = pc >> 3, ch = pc & 7; *(LAS u32x4*)(vt + key * VROW + 8 * ch) = kv.v[i]; }
}
__device__ __forceinline__ void attn_softmax(AttnState& st, const float (&s)[2][4], const bool (&valid)[2][4], bf16x8& pfo, float& alpha) {
    float mx = fmaxf(fmaxf(fmaxf(s[0][0], s[0][1]), fmaxf(s[0][2], s[0][3])), fmaxf(fmaxf(s[1][0], s[1][1]), fmaxf(s[1][2], s[1][3])));
    mx = fmaxf(mx, __shfl_xor(mx, 16)); mx = fmaxf(mx, __shfl_xor(mx, 32));
    const float mn = fmaxf(st.m, mx); alpha = __expf(st.m - mn);
    float pv[2][4]; float ps = 0.f;
#pragma unroll
    for (int t = 0; t < 2; ++t)
#pragma unroll
        for (int r = 0; r < 4; ++r) { pv[t][r] = valid[t][r] ? __expf(s[t][r] - mn) : 0.f; ps += pv[t][r]; }
    st.m = mn; st.l = st.l * alpha + ps;
    union { bf16x8 v; unsigned u[4]; } pf;
    pf.u[0] = pk2(pv[0][0], pv[0][1]); pf.u[1] = pk2(pv[0][2], pv[0][3]); pf.u[2] = pk2(pv[1][0], pv[1][1]); pf.u[3] = pk2(pv[1][2], pv[1][3]);
    pfo = pf.v;
}
__device__ __forceinline__ void attn_pv(AttnState& st, const bf16x8 pf, const float alpha, const LAS bf16_t* vt, int fr, int fq) {
    const LAS bf16_t* base = vt + (4 * fq + (fr >> 2)) * VROW + 4 * (fr & 3);
#pragma unroll
    for (int dt = 0; dt < 4; ++dt) {
        const v4s_t a0 = __builtin_amdgcn_ds_read_tr16_b64_v4i16((LAS v4s_t*)(base + 16 * dt));
        const v4s_t a1 = __builtin_amdgcn_ds_read_tr16_b64_v4i16((LAS v4s_t*)(base + 16 * VROW + 16 * dt));
        bf16x8 vf; vf[0] = a0[0]; vf[1] = a0[1]; vf[2] = a0[2]; vf[3] = a0[3]; vf[4] = a1[0]; vf[5] = a1[1]; vf[6] = a1[2]; vf[7] = a1[3];
        st.o[dt] = st.o[dt] * alpha;
        st.o[dt] = MFMA16(vf, pf, st.o[dt]);
    }
}
__device__ __forceinline__ void attn_qk(f32x4 (&sacc)[2], const KVRegs& kv, const bf16x8 (&qf)[2]) {
#pragma unroll
    for (int t = 0; t < 2; ++t) { sacc[t] = (f32x4){0.f, 0.f, 0.f, 0.f};
#pragma unroll
        for (int ks = 0; ks < 2; ++ks) sacc[t] = MFMA16(kv.k[t][ks], qf[ks], sacc[t]); }
}

__device__ __forceinline__ void na_item(int item, const bf16_t* P, bf16_t* BR, const float* rpb  , int L, LAS unsigned char* lds) {
    const int tid = opaque_tid(), lane = tid & 63, wave = tid >> 6, fr = lane & 15, fq = lane >> 4;
    asm volatile("" : "+s"(item));
    const int rr = item, n = wave & 3, h0 = 2 * (wave >> 2);
    const int rows = L >> 6, seq = rr / rows, r = rr % rows, seqbase = seq * L;
    const int r0 = min(max(r - 4, 0), rows - 8);
    LAS bf16_t* vt[2] = {(LAS bf16_t*)(lds + (2 * wave) * VT_BYTES), (LAS bf16_t*)(lds + (2 * wave + 1) * VT_BYTES)};
    const int qtok = seqbase + r * 64 + 16 * n + fr;
    const int col0 = min(max(16 * n - 8, 0), 32), qcol = 16 * n + fr, win0 = min(max(qcol - 8, 0), 48);
    bf16x8 qf[2][2]; AttnState st[2]; KVRegs cur[2];
#pragma unroll
    for (int c = 0; c < 2; ++c) {
#pragma unroll
        for (int ks = 0; ks < 2; ++ks) qf[c][ks] = *(const bf16x8*)(P + (size_t)qtok * NIN + P_NAQ + 64 * (h0 + c) + 32 * ks + 8 * fq);
#pragma unroll
        for (int dt = 0; dt < 4; ++dt) st[c].o[dt] = (f32x4){0.f, 0.f, 0.f, 0.f};
        st[c].m = -1e30f; st[c].l = 0.f;
        const int rowtok = seqbase + r0 * 64 + col0;
        kv_load(cur[c], P, P_NAK + 64 * (h0 + c), P_NAV + 64 * (h0 + c), lane, fq, [&](int t) { return rowtok + 16 * t + fr; }, [&](int key) { return rowtok + key; });
    }
    for (int kr = 0; kr < 8; ++kr) {
        const int krow = r0 + kr;
        KVRegs nxt[2];
        { const int rowtok = seqbase + min(krow + 1, r0 + 7) * 64 + col0;
#pragma unroll
          for (int c = 0; c < 2; ++c) kv_load(nxt[c], P, P_NAK + 64 * (h0 + c), P_NAV + 64 * (h0 + c), lane, fq, [&](int t) { return rowtok + 16 * t + fr; }, [&](int key) { return rowtok + key; }); }
        float bias[2][2][4]; bool valid[2][4];
#pragma unroll
        for (int t = 0; t < 2; ++t)
#pragma unroll
            for (int g = 0; g < 4; ++g) { const int kc = col0 + 16 * t + 4 * fq + g; valid[t][g] = (kc >= win0) && (kc < win0 + 16);
                const int bi = (h0 * 15 + (krow - r + 7)) * 31 + min(max(kc - qcol + 15, 0), 30);
                bias[0][t][g] = rpb[bi]; bias[1][t][g] = rpb[bi + 15 * 31]; }
        attn_stage_v(vt[0], cur[0], lane); attn_stage_v(vt[1], cur[1], lane);
        __builtin_amdgcn_wave_barrier();
        bf16x8 pf[2]; float alpha[2];
#pragma unroll
        for (int c = 0; c < 2; ++c) {
            f32x4 sacc[2]; attn_qk(sacc, cur[c], qf[c]);
            float sc[2][4];
#pragma unroll
            for (int t = 0; t < 2; ++t)
#pragma unroll
                for (int g = 0; g < 4; ++g) sc[t][g] = valid[t][g] ? sacc[t][g] * 0.125f + bias[c][t][g] : -1e30f;
            attn_softmax(st[c], sc, valid, pf[c], alpha[c]);
        }
#pragma unroll
        for (int c = 0; c < 2; ++c) attn_pv(st[c], pf[c], alpha[c], vt[c], fr, fq);
        __builtin_amdgcn_wave_barrier();
        cur[0] = nxt[0]; cur[1] = nxt[1];
    }
#pragma unroll
    for (int c = 0; c < 2; ++c) {
        float l = st[c].l; l += __shfl_xor(l, 16); l += __shfl_xor(l, 32);
        const float inv = 1.f / l;
        bf16_t* orow = BR + (size_t)qtok * DM + 0 + 64 * (h0 + c) + 4 * fq;
#pragma unroll
        for (int dt = 0; dt < 4; ++dt) { u32x2 o; o.x = pk2(st[c].o[dt][0] * inv, st[c].o[dt][1] * inv); o.y = pk2(st[c].o[dt][2] * inv, st[c].o[dt][3] * inv); *(u32x2*)(orow + 16 * dt) = o; }
    }
}

constexpr int DL_OLD = 68;
constexpr int DL_O_OFF = 16 * VT_BYTES;
constexpr int DL_M_OFF = DL_O_OFF + 256 * DL_OLD * 4;
constexpr int DL_L_OFF = DL_M_OFF + 1024;
__device__ __forceinline__ void dl_item(int item, const bf16_t* P, bf16_t* BR, int L, LAS unsigned char* lds) {
    const int tid = opaque_tid(), lane = tid & 63, wave = tid >> 6, fr = lane & 15, fq = lane >> 4;
    asm volatile("" : "+s"(item));
    const int sp = item >> 2, h = item & 3;
    const int t0 = sp * 256, seq = t0 / L, seqbase = seq * L, p0 = t0 - seqbase;
    LAS bf16_t* vt[2] = {(LAS bf16_t*)(lds + (2 * wave) * VT_BYTES), (LAS bf16_t*)(lds + (2 * wave + 1) * VT_BYTES)};
    LAS float* OL = (LAS float*)(lds + DL_O_OFF); LAS float* ML = (LAS float*)(lds + DL_M_OFF); LAS float* LL = (LAS float*)(lds + DL_L_OFF);
    __syncthreads();
    for (int e = tid; e < 256 * DL_OLD; e += NTHR) OL[e] = 0.f;
    if (tid < 256) { ML[tid] = -1e30f; LL[tid] = 0.f; }
    __syncthreads();
    const float slope = (h == 0) ? 0.25f : (h == 1) ? 0.0625f : (h == 2) ? 0.015625f : 0.00390625f;
    const int kcol = P_DK + 64 * h, vcol = P_DV + 64 * h;
    for (int cfg = 0; cfg < 3; ++cfg) {
        const int dsh = 2 * cfg, n = L >> dsh;
        int rC[2], subC[2], j0C[2], qjC[2];
        bf16x8 qf[2][2]; AttnState st[2]; KVRegs cur[2];
#pragma unroll
        for (int c = 0; c < 2; ++c) {
            const int qt = 2 * wave + c;
            rC[c] = (cfg == 0) ? 0 : (cfg == 1) ? (qt >> 2) : qt;
            subC[c] = (cfg == 0) ? qt : (cfg == 1) ? (qt & 3) : 0;
            j0C[c] = (p0 >> dsh) + 16 * subC[c]; qjC[c] = j0C[c] + fr;
            const int qtok = seqbase + (qjC[c] << dsh) + rC[c];
#pragma unroll
            for (int ks = 0; ks < 2; ++ks) qf[c][ks] = *(const bf16x8*)(P + (size_t)qtok * NIN + P_DQ + 64 * h + 32 * ks + 8 * fq);
#pragma unroll
            for (int dt = 0; dt < 4; ++dt) st[c].o[dt] = (f32x4){0.f, 0.f, 0.f, 0.f};
            st[c].m = -1e30f; st[c].l = 0.f;
        }
        int s_lo = 0, s_hi = 5;
        while (s_lo < 4 && j0C[1] - 64 + 32 * s_lo + 32 <= 0) ++s_lo;
        while (s_hi > s_lo + 1 && j0C[0] - 64 + 32 * (s_hi - 1) >= n) --s_hi;
#pragma unroll
        for (int c = 0; c < 2; ++c) { const int kb = j0C[c] - 64 + 32 * s_lo, rr_ = rC[c];
            kv_load(cur[c], P, kcol, vcol, lane, fq, [&](int t) { const int kj = min(max(kb + 16 * t + fr, 0), n - 1); return seqbase + (kj << dsh) + rr_; },
                    [&](int key) { const int kj = min(max(kb + key, 0), n - 1); return seqbase + (kj << dsh) + rr_; }); }
        for (int sx = s_lo; sx < s_hi; ++sx) {
            KVRegs nxt[2];
#pragma unroll
            for (int c = 0; c < 2; ++c) { const int kb2 = j0C[c] - 64 + 32 * min(sx + 1, s_hi - 1), rr_ = rC[c];
                kv_load(nxt[c], P, kcol, vcol, lane, fq, [&](int t) { const int kj = min(max(kb2 + 16 * t + fr, 0), n - 1); return seqbase + (kj << dsh) + rr_; },
                        [&](int key) { const int kj = min(max(kb2 + key, 0), n - 1); return seqbase + (kj << dsh) + rr_; }); }
            attn_stage_v(vt[0], cur[0], lane); attn_stage_v(vt[1], cur[1], lane);
            __builtin_amdgcn_wave_barrier();
            bf16x8 pf[2]; float alpha[2];
#pragma unroll
            for (int c = 0; c < 2; ++c) {
                const int kb = j0C[c] - 64 + 32 * sx;
                f32x4 sacc[2]; attn_qk(sacc, cur[c], qf[c]);
                float sc[2][4]; bool valid[2][4];
#pragma unroll
                for (int t = 0; t < 2; ++t)
#pragma unroll
                    for (int g = 0; g < 4; ++g) { const int kj = kb + 16 * t + 4 * fq + g; const int dist = abs(kj - qjC[c]);
                        const bool v = (dist <= 64) && (kj >= 0) && (kj < n);
                        valid[t][g] = v; sc[t][g] = v ? sacc[t][g] * 0.125f - slope * (float)(dist << dsh) : -1e30f; }
                attn_softmax(st[c], sc, valid, pf[c], alpha[c]);
            }
#pragma unroll
            for (int c = 0; c < 2; ++c) attn_pv(st[c], pf[c], alpha[c], vt[c], fr, fq);
            __builtin_amdgcn_wave_barrier();
            cur[0] = nxt[0]; cur[1] = nxt[1];
        }
#pragma unroll
        for (int c = 0; c < 2; ++c) {
            float l = st[c].l; l += __shfl_xor(l, 16); l += __shfl_xor(l, 32);
            const int ql = ((16 * subC[c] + fr) << dsh) + rC[c];
            const float mo = ML[ql], lo = LL[ql], mn = fmaxf(mo, st[c].m), a = __expf(mo - mn), b = __expf(st[c].m - mn);
            LAS float* orow = OL + ql * DL_OLD + 4 * fq;
#pragma unroll
            for (int dt = 0; dt < 4; ++dt) { f32x4 ov = *(LAS f32x4*)(orow + 16 * dt); ov = ov * a + st[c].o[dt] * b; *(LAS f32x4*)(orow + 16 * dt) = ov; }
            __builtin_amdgcn_wave_barrier();
            if (fq == 0) { ML[ql] = mn; LL[ql] = lo * a + l * b; }
            __builtin_amdgcn_wave_barrier();
        }
        __syncthreads();
    }
    for (int e = tid; e < 256 * 8; e += NTHR) { const int ql = e >> 3, c8 = e & 7;
        const float inv = 1.f / LL[ql]; const LAS float* orow = OL + ql * DL_OLD + 8 * c8;
        const f32x4 a = *(const LAS f32x4*)orow, b = *(const LAS f32x4*)(orow + 4);
        u32x4 o; o.x = pk2(a[0] * inv, a[1] * inv); o.y = pk2(a[2] * inv, a[3] * inv); o.z = pk2(b[0] * inv, b[1] * inv); o.w = pk2(b[2] * inv, b[3] * inv);
        *(u32x4*)(BR + (size_t)(t0 + ql) * DM + 768 + 64 * h + 8 * c8) = o; }
}

constexpr int SG_WLD = 136, SG_VLD = 136;
constexpr int SG_V_OFF = 128 * SG_WLD * 2;
__device__ __forceinline__ void sg_item(int item, const bf16_t* P, bf16_t* BR, const bf16_t* sgw  , const float* ln_g, const float* ln_b, const float* sgb  , LAS unsigned char* lds) {
    const int tid = opaque_tid(), lane = tid & 63, wave = tid >> 6, fr = lane & 15, fq = lane >> 4;
    const int nc = item >> 2, g = item & 3, t0 = nc * 128;
    LAS bf16_t* WL = (LAS bf16_t*)lds; LAS bf16_t* VT = (LAS bf16_t*)(lds + SG_V_OFF);
    __syncthreads();
    for (int e = tid; e < 128 * 16; e += NTHR) { const int row = e >> 4, c8 = e & 15;
        *(LAS u32x4*)(WL + row * SG_WLD + 8 * c8) = *(const u32x4*)(sgw + ((size_t)g * 128 + row) * 128 + 8 * c8); }
    {
        const int s = tid >> 2, qd = tid & 3;
        const bf16_t* vp = P + (size_t)(t0 + s) * NIN + P_SV + 64 * qd;
        float sum = 0.f, sq = 0.f;
#pragma unroll
        for (int i = 0; i < 8; ++i) { const u32x4 w = *(const u32x4*)(vp + 8 * i);
            const unsigned ww[4] = {w.x, w.y, w.z, w.w};
#pragma unroll
            for (int j = 0; j < 4; ++j) { const float a = gelu_tanh(bflo(ww[j])), b = gelu_tanh(bfhi(ww[j])); sum += a + b; sq += a * a + b * b; } }
        sum += __shfl_xor(sum, 1); sum += __shfl_xor(sum, 2); sq += __shfl_xor(sq, 1); sq += __shfl_xor(sq, 2);
        const float mean = sum * (1.f / 256.f), var = fmaxf(sq * (1.f / 256.f) - mean * mean, 0.f), rstd = rsqrtf(var + EPSV);
        const bf16_t* gp = P + (size_t)(t0 + s) * NIN + P_SV + 64 * g + 16 * qd;
#pragma unroll
        for (int i = 0; i < 2; ++i) { const u32x4 w = *(const u32x4*)(gp + 8 * i);
            const unsigned ww[4] = {w.x, w.y, w.z, w.w};
#pragma unroll
            for (int j = 0; j < 4; ++j) {
                const int c = 16 * qd + 8 * i + 2 * j, ch = 64 * g + c;
                const float a = (gelu_tanh(bflo(ww[j])) - mean) * rstd * ln_g[ch] + ln_b[ch], b = (gelu_tanh(bfhi(ww[j])) - mean) * rstd * ln_g[ch + 1] + ln_b[ch + 1];
                VT[c * SG_VLD + s] = f2bf(a); VT[(c + 1) * SG_VLD + s] = f2bf(b); } }
    }
    __syncthreads();
    f32x4 acc[4];
#pragma unroll
    for (int ni = 0; ni < 4; ++ni) acc[ni] = (f32x4){0.f, 0.f, 0.f, 0.f};
#pragma unroll
    for (int ks = 0; ks < 4; ++ks) { const bf16x8 a = *(const LAS bf16x8*)(WL + (16 * wave + fr) * SG_WLD + 32 * ks + 8 * fq);
#pragma unroll
        for (int ni = 0; ni < 4; ++ni) { const bf16x8 b = *(const LAS bf16x8*)(VT + (16 * ni + fr) * SG_VLD + 32 * ks + 8 * fq); acc[ni] = MFMA16(a, b, acc[ni]); } }
#pragma unroll
    for (int reg = 0; reg < 4; ++reg) { const int t = 16 * wave + 4 * fq + reg; const float bs = sgb[g * 128 + t];
        const bf16_t* up = P + (size_t)(t0 + t) * NIN + P_SU + 64 * g; bf16_t* op = BR + (size_t)(t0 + t) * DM + 512 + 64 * g;
#pragma unroll
        for (int ni = 0; ni < 4; ++ni) { const int c = 16 * ni + fr; const float u = gelu_tanh(bf2f(up[c])); op[c] = f2bf(u * (acc[ni][reg] + bs)); } }
}

constexpr int HG_LF_OFF = 0;
constexpr int HG_T_OFF = 32768;
constexpr int HG_TLD = 72, HG_TB = 64 * HG_TLD * 2;
__device__ __forceinline__ float hg_lb(const float* hg_lb_in, int dir, int l, int ch) {
    const float* q = hg_lb_in + (size_t)dir * NLAYER * 256 + ch;
    const float a0 = q[0], a1 = q[256], a2 = q[512], a3 = q[768];
    const float mx = fmaxf(fmaxf(a0, a1), fmaxf(a2, a3));
    const float e0 = __expf(a0 - mx), e1 = __expf(a1 - mx), e2 = __expf(a2 - mx), e3 = __expf(a3 - mx);
    const float num = (l >= 1 ? e1 : 0.f) + (l >= 2 ? e2 : 0.f) + (l >= 3 ? e3 : 0.f);
    return num / (e0 + e1 + e2 + e3);
}
constexpr int HG_LB_OFF = 155648;
constexpr int HG_TOT_OFF = 157696;
__device__ __forceinline__ void hg_lb_table(const float* hg_lb_in, int l, LAS unsigned char* lds) {
    const int tid = opaque_tid();
    ((LAS float*)(lds + HG_LB_OFF))[tid] = hg_lb(hg_lb_in, (tid >> 6) & 1, l, 64 * (tid >> 7) + (tid & 63));
    __syncthreads();
}
__device__ __forceinline__ void hg_front(const u32x4 (&wf)[2], int h, LAS unsigned char* lds) {
    const int tid = opaque_tid();
    LAS float* LF = (LAS float*)(lds + HG_LF_OFF); LAS float* TOT = (LAS float*)(lds + HG_TOT_OFF); const LAS float* LBS = (const LAS float*)(lds + HG_LB_OFF) + h * 128;
    {
        const int s = tid >> 3, i0 = 8 * (tid & 7);
#pragma unroll
        for (int dir = 0; dir < 2; ++dir) {
            const unsigned ww[4] = {wf[dir].x, wf[dir].y, wf[dir].z, wf[dir].w};
#pragma unroll
            for (int j = 0; j < 4; ++j) {
                const float lb0 = LBS[dir * 64 + i0 + 2 * j], lb1 = LBS[dir * 64 + i0 + 2 * j + 1];
                const float f0 = lb0 + (1.f - lb0) * sigmoidf_(bflo(ww[j])), f1 = lb1 + (1.f - lb1) * sigmoidf_(bfhi(ww[j]));
                LF[dir * 4096 + s * 64 + i0 + 2 * j] = __logf(f0); LF[dir * 4096 + s * 64 + i0 + 2 * j + 1] = __logf(f1); }
        }
    }
    __syncthreads();
    {
        const int dir = tid >> 8, seg = (tid >> 6) & 3, i = tid & 63;
        LAS float* a = LF + dir * 4096 + i;
        float r[16]; float run = 0.f;
#pragma unroll
        for (int k = 0; k < 16; ++k) { const int sidx = dir ? (16 * seg + 15 - k) : (16 * seg + k); run += a[sidx * 64]; r[k] = run; }
        TOT[(dir * 4 + seg) * 64 + i] = run;
        __syncthreads();
        float off = 0.f;
#pragma unroll
        for (int q = 0; q < 4; ++q) { const float tq = TOT[(dir * 4 + q) * 64 + i]; off += (dir ? (q > seg) : (q < seg)) ? tq : 0.f; }
#pragma unroll
        for (int k = 0; k < 16; ++k) { const int sidx = dir ? (16 * seg + 15 - k) : (16 * seg + k); a[sidx * 64] = r[k] + off; }
    }
    __syncthreads();
}
__device__ __forceinline__ float hg_kk(LAS unsigned char* lds, int h, int dir, int i, float x) { const float lb = ((LAS float*)(lds + HG_LB_OFF))[(h * 2 + dir) * 64 + i]; return (1.f - lb) * sigmoidf_(-x); }

__device__ __forceinline__ void hgA_item(int item, const bf16_t* P, float* HGST, float* HGD, LAS unsigned char* lds) {
    const int tid = opaque_tid(), lane = tid & 63, wave = tid >> 6, fr = lane & 15, fq = lane >> 4;
    const int cc = item >> 2, h = item & 3, t0 = cc * 64;
    const int s = tid >> 3, i0 = 8 * (tid & 7);
    u32x4 wf[2];
    wf[0] = *(const u32x4*)(P + (size_t)(t0 + s) * NIN + P_FF + 64 * h + i0);
    wf[1] = *(const u32x4*)(P + (size_t)(t0 + s) * NIN + P_FB + 64 * h + i0);
    const u32x4 wv = *(const u32x4*)(P + (size_t)(t0 + s) * NIN + P_HI + 64 * h + i0);
    __syncthreads();
    hg_front(wf, h, lds);
    LAS float* LF = (LAS float*)(lds + HG_LF_OFF);
    LAS bf16_t* KD0 = (LAS bf16_t*)(lds + HG_T_OFF); LAS bf16_t* KD1 = (LAS bf16_t*)(lds + HG_T_OFF + HG_TB); LAS bf16_t* VT = (LAS bf16_t*)(lds + HG_T_OFF + 2 * HG_TB);
    {
#pragma unroll
        for (int dir = 0; dir < 2; ++dir) {
            const unsigned ww[4] = {wf[dir].x, wf[dir].y, wf[dir].z, wf[dir].w};
            LAS bf16_t* KD = dir ? KD1 : KD0; const LAS float* A = LF + dir * 4096; const int slast = dir ? 0 : 63;
#pragma unroll
            for (int j = 0; j < 8; ++j) { const int i = i0 + j; const float x = (j & 1) ? bfhi(ww[j >> 1]) : bflo(ww[j >> 1]);
                const float kd = hg_kk(lds, h, dir, i, x) * __expf(A[slast * 64 + i] - A[s * 64 + i]);
                KD[i * HG_TLD + s] = f2bf(kd); }
        }
        const unsigned ww[4] = {wv.x, wv.y, wv.z, wv.w};
#pragma unroll
        for (int j = 0; j < 8; ++j) VT[(i0 + j) * HG_TLD + s] = (bf16_t)((j & 1) ? (ww[j >> 1] >> 16) : (ww[j >> 1] & 0xffffu));
        if (tid < 128) { const int dir = tid >> 6, i = tid & 63; HGD[((size_t)(cc * 4 + h) * 2 + dir) * 64 + i] = __expf(LF[dir * 4096 + (dir ? 0 : 63) * 64 + i]); }
    }
    __syncthreads();
    {
        const int dir = wave >> 2, mt = wave & 3; const LAS bf16_t* KD = dir ? KD1 : KD0;
        f32x4 acc[4];
#pragma unroll
        for (int ni = 0; ni < 4; ++ni) acc[ni] = (f32x4){0.f, 0.f, 0.f, 0.f};
#pragma unroll
        for (int ks = 0; ks < 2; ++ks) { const bf16x8 a = *(const LAS bf16x8*)(VT + (16 * mt + fr) * HG_TLD + 32 * ks + 8 * fq);
#pragma unroll
            for (int ni = 0; ni < 4; ++ni) { const bf16x8 b = *(const LAS bf16x8*)(KD + (16 * ni + fr) * HG_TLD + 32 * ks + 8 * fq); acc[ni] = MFMA16(a, b, acc[ni]); } }
        float* dst = HGST + ((size_t)(cc * 4 + h) * 2 + dir) * 4096;
#pragma unroll
        for (int ni = 0; ni < 4; ++ni)
#pragma unroll
            for (int reg = 0; reg < 4; ++reg) dst[(16 * mt + 4 * fq + reg) * 64 + 16 * ni + fr] = acc[ni][reg];
    }
}
__device__ __forceinline__ void hgB_phase(float* HGST, const float* HGD, int L) {
    const int ncs = L >> 6, nseq = TC / L, total = nseq * 8 * 4096;
    for (int e = blockIdx.x * NTHR + opaque_tid(); e < total; e += gridDim.x * NTHR) {
        const int ji = e & 4095, dir = (e >> 12) & 1, h = (e >> 13) & 3, seq = e >> 15, i = ji & 63;
        float S = 0.f;
        for (int c0 = 0; c0 < ncs; c0 += 8) {
            float u[8], d[8];
#pragma unroll
            for (int k = 0; k < 8; ++k) { const int cc = seq * ncs + (dir ? (ncs - 1 - (c0 + k)) : (c0 + k)); const size_t o = ((size_t)(cc * 4 + h) * 2 + dir);
                u[k] = HGST[o * 4096 + ji]; d[k] = HGD[o * 64 + i]; }
#pragma unroll
            for (int k = 0; k < 8; ++k) { const int cc = seq * ncs + (dir ? (ncs - 1 - (c0 + k)) : (c0 + k)); const size_t o = ((size_t)(cc * 4 + h) * 2 + dir);
                HGST[o * 4096 + ji] = S; S = S * d[k] + u[k]; }
        }
    }
}
__device__ __forceinline__ void hgC_item(int item, const bf16_t* P, bf16_t* BR, const float* HGST, const float* gnorm  , LAS unsigned char* lds) {
    const int tid = opaque_tid(), lane = tid & 63, wave = tid >> 6, fr = lane & 15, fq = lane >> 4;
    const int cc = item >> 2, h = item & 3, t0 = cc * 64;
    const int s = tid >> 3, i0 = 8 * (tid & 7);
    u32x4 wf[2];
    wf[0] = *(const u32x4*)(P + (size_t)(t0 + s) * NIN + P_FF + 64 * h + i0);
    wf[1] = *(const u32x4*)(P + (size_t)(t0 + s) * NIN + P_FB + 64 * h + i0);
    const u32x4 wq = *(const u32x4*)(P + (size_t)(t0 + s) * NIN + P_HQ + 64 * h + i0);
    const u32x4 wv = *(const u32x4*)(P + (size_t)(t0 + s) * NIN + P_HI + 64 * h + i0);
    f32x4 stv[4];
    { const int dir = tid >> 8, j = (tid >> 2) & 63, i4 = 16 * (tid & 3);
      const float* src = HGST + ((size_t)(cc * 4 + h) * 2 + dir) * 4096 + j * 64 + i4;
#pragma unroll
      for (int q = 0; q < 4; ++q) stv[q] = *(const f32x4*)(src + 4 * q); }
    unsigned gpre[4][4];
    if (wave < 4) {
#pragma unroll
        for (int reg = 0; reg < 4; ++reg)
#pragma unroll
            for (int ni = 0; ni < 4; ++ni) gpre[reg][ni] = P[(size_t)(t0 + 16 * wave + 4 * fq + reg) * NIN + P_HGATE + 64 * h + 16 * ni + fr];
    }
    __syncthreads();
    hg_front(wf, h, lds);
    LAS float* LF = (LAS float*)(lds + HG_LF_OFF);
#define HGT(k) ((LAS bf16_t*)(lds + HG_T_OFF + (k) * HG_TB))
    {
        const unsigned wqq[4] = {wq.x, wq.y, wq.z, wq.w};
#pragma unroll
        for (int dir = 0; dir < 2; ++dir) {
            const unsigned ww[4] = {wf[dir].x, wf[dir].y, wf[dir].z, wf[dir].w};
            const LAS float* A = LF + dir * 4096;
            u32x4 oq, ok, oe; unsigned* oqp = (unsigned*)&oq; unsigned* okp = (unsigned*)&ok; unsigned* oep = (unsigned*)&oe;
#pragma unroll
            for (int j2 = 0; j2 < 4; ++j2) { float qt[2], kt[2], qe[2];
#pragma unroll
                for (int e = 0; e < 2; ++e) { const int i = i0 + 2 * j2 + e; const float x = e ? bfhi(ww[j2]) : bflo(ww[j2]); const float qs = siluf_(e ? bfhi(wqq[j2]) : bflo(wqq[j2]));
                    const float a = A[s * 64 + i], ref = A[32 * 64 + i];
                    const float d1 = fminf(fmaxf(a - ref, -80.f), 80.f);
                    qt[e] = qs * __expf(d1); kt[e] = hg_kk(lds, h, dir, i, x) * __expf(-d1); qe[e] = qs * __expf(a); }
                oqp[j2] = pk2(qt[0], qt[1]); okp[j2] = pk2(kt[0], kt[1]); oep[j2] = pk2(qe[0], qe[1]); }
            *(LAS u32x4*)(HGT(0 + dir) + s * HG_TLD + i0) = oq; *(LAS u32x4*)(HGT(2 + dir) + s * HG_TLD + i0) = ok; *(LAS u32x4*)(HGT(4 + dir) + s * HG_TLD + i0) = oe;
        }
        const unsigned ww[4] = {wv.x, wv.y, wv.z, wv.w};
        LAS bf16_t* VT = HGT(6);
#pragma unroll
        for (int j = 0; j < 8; ++j) VT[(i0 + j) * HG_TLD + s] = (bf16_t)((j & 1) ? (ww[j >> 1] >> 16) : (ww[j >> 1] & 0xffffu));
        { const int dir = tid >> 8, j = (tid >> 2) & 63, i4 = 16 * (tid & 3);
          LAS bf16_t* dstp = HGT(8 + dir) + j * HG_TLD + i4;
#pragma unroll
          for (int q = 0; q < 2; ++q) { const f32x4 a = stv[2 * q], b = stv[2 * q + 1];
              u32x4 o; o.x = pk2(a[0], a[1]); o.y = pk2(a[2], a[3]); o.z = pk2(b[0], b[1]); o.w = pk2(b[2], b[3]); *(LAS u32x4*)(dstp + 8 * q) = o; } }
    }
    __syncthreads();
    {
        const int mt = wave >> 1;
#pragma unroll
        for (int q = 0; q < 2; ++q) { const int nt = 2 * (wave & 1) + q;
            f32x4 af = (f32x4){0.f, 0.f, 0.f, 0.f}, ab = (f32x4){0.f, 0.f, 0.f, 0.f};
            if (nt <= mt) {
#pragma unroll
                for (int ks = 0; ks < 2; ++ks) af = MFMA16(*(const LAS bf16x8*)(HGT(0) + (16 * mt + fr) * HG_TLD + 32 * ks + 8 * fq), *(const LAS bf16x8*)(HGT(2) + (16 * nt + fr) * HG_TLD + 32 * ks + 8 * fq), af); }
            if (nt >= mt) {
#pragma unroll
                for (int ks = 0; ks < 2; ++ks) ab = MFMA16(*(const LAS bf16x8*)(HGT(1) + (16 * mt + fr) * HG_TLD + 32 * ks + 8 * fq), *(const LAS bf16x8*)(HGT(3) + (16 * nt + fr) * HG_TLD + 32 * ks + 8 * fq), ab); }
            const int s = 16 * nt + fr;
#pragma unroll
            for (int reg = 0; reg < 4; ++reg) { const int t = 16 * mt + 4 * fq + reg;
                const float v = ((s <= t) ? af[reg] : 0.f) + ((s >= t) ? ab[reg] : 0.f);
                HGT(7)[t * HG_TLD + s] = f2bf(v); } }
    }
    __syncthreads();
    if (wave < 4) {
        const int mt = wave;
        f32x4 acc[4];
#pragma unroll
        for (int ni = 0; ni < 4; ++ni) acc[ni] = (f32x4){0.f, 0.f, 0.f, 0.f};
#pragma unroll
        for (int pr = 0; pr < 3; ++pr) { const LAS bf16_t* Am = (pr == 0) ? HGT(7) : (pr == 1) ? HGT(4) : HGT(5); const LAS bf16_t* Bm = (pr == 0) ? HGT(6) : (pr == 1) ? HGT(8) : HGT(9);
#pragma unroll
            for (int ks = 0; ks < 2; ++ks) { const bf16x8 a = *(const LAS bf16x8*)(Am + (16 * mt + fr) * HG_TLD + 32 * ks + 8 * fq);
#pragma unroll
                for (int ni = 0; ni < 4; ++ni) acc[ni] = MFMA16(a, *(const LAS bf16x8*)(Bm + (16 * ni + fr) * HG_TLD + 32 * ks + 8 * fq), acc[ni]); } }
#pragma unroll
        for (int reg = 0; reg < 4; ++reg) { const int t = 16 * mt + 4 * fq + reg;
            float ss = acc[0][reg] * acc[0][reg] + acc[1][reg] * acc[1][reg] + acc[2][reg] * acc[2][reg] + acc[3][reg] * acc[3][reg];
            ss += __shfl_xor(ss, 1); ss += __shfl_xor(ss, 2); ss += __shfl_xor(ss, 4); ss += __shfl_xor(ss, 8);
            const float rn = rsqrtf(ss * (1.f / 64.f) + EPSV);
            bf16_t* op = BR + (size_t)(t0 + t) * DM + 256 + 64 * h;
#pragma unroll
            for (int ni = 0; ni < 4; ++ni) { const int j = 16 * ni + fr; op[j] = f2bf(acc[ni][reg] * rn * gnorm[64 * h + j] * siluf_(bf2f(gpre[reg][ni]))); } }
    }
#undef HGT
}

#define XB_TMO      128
#define XB_XCNT(j)  (256  + 64 * (j))
#define XB_XSUB(j)  (1280 + 64 * (j))
#define XB_XGEN(j)  (2304 + 64 * (j))
#define XB_TOP      3328
#define XB_TOPGEN   3392
#define XCD_BAR_WORDS 3456
#define XB_SPIN_CAP (1u << 22)
__device__ __forceinline__ unsigned xb_ld(unsigned* p)              { return __hip_atomic_load(p, __ATOMIC_RELAXED, __HIP_MEMORY_SCOPE_AGENT); }
__device__ __forceinline__ unsigned xb_add(unsigned* p, unsigned v) { return __hip_atomic_fetch_add(p, v, __ATOMIC_RELAXED, __HIP_MEMORY_SCOPE_AGENT); }
__device__ __forceinline__ unsigned xb_xcc_id() { return (unsigned)__builtin_amdgcn_s_getreg((3 << 11) | 20) & 0xFu; }
#define XB_SPIN(cond, bar) do { unsigned _sp = 0; while (cond) { __builtin_amdgcn_s_sleep(1); \
    if ((++_sp & 255u) == 0u) { if (xb_ld(&(bar)[XB_TMO])) break; if (_sp > XB_SPIN_CAP) { atomicAdd(&(bar)[XB_TMO], 1u); break; } } } } while (0)
struct XcdBarrier { unsigned* bar; unsigned x; volatile LAS unsigned* st; };
__device__ __forceinline__ XcdBarrier xcd_barrier_post(unsigned* bar, volatile LAS unsigned* st) {
    XcdBarrier b; b.bar = bar; b.x = xb_xcc_id(); b.st = st;
    if (threadIdx.x == 0) (void)xb_add(&bar[XB_XCNT(b.x)], 1u);
    return b;
}
__device__ __forceinline__ void xcd_barrier_complete(unsigned* bar, unsigned x, unsigned& nloc, unsigned& nx) {
    const unsigned G = gridDim.x * gridDim.y * gridDim.z;
    unsigned sum, cnt, mine, sp = 0u;
    for (;;) {
        sum = 0u; cnt = 0u; mine = 0u;
#pragma unroll
        for (unsigned j = 0; j < 16; ++j) { const unsigned c = xb_ld(&bar[XB_XCNT(j)]); sum += c; cnt += (c > 0u) ? 1u : 0u; mine = (j == x) ? c : mine; }
        if (sum == G) break;
        __builtin_amdgcn_s_sleep(1);
        if ((++sp & 255u) == 0u) { if (xb_ld(&bar[XB_TMO])) break; if (sp > XB_SPIN_CAP) { atomicAdd(&bar[XB_TMO], 1u); break; } }
    }
    nloc = mine > 0u ? mine : 1u; nx = cnt > 0u ? cnt : 1u;
}
__device__ __forceinline__ void xcd_barrier(unsigned* bar_in, volatile LAS unsigned* st_in) {
    XcdBarrier b; b.bar = bar_in; b.st = st_in; b.x = xb_xcc_id();
    asm volatile("s_waitcnt vmcnt(0)" ::: "memory");
    __syncthreads();
    if (threadIdx.x == 0) {
        unsigned* bar = b.bar;
        __builtin_amdgcn_s_waitcnt(0);
        unsigned nloc = b.st[0], nx = b.st[1];
        if (nloc == 0u) { xcd_barrier_complete(bar, b.x, nloc, nx); b.st[0] = nloc; b.st[1] = nx; }
        const unsigned old = xb_add(&bar[XB_XSUB(b.x)], 1u);
        const unsigned gen = old / nloc;
        if (old + 1u == (gen + 1u) * nloc) {
            __builtin_amdgcn_fence(__ATOMIC_RELEASE, "agent");
            asm volatile("s_waitcnt vmcnt(0)" ::: "memory");
            const unsigned og = xb_add(&bar[XB_TOP], 1u);
            const unsigned tg = og / nx;
            if (og + 1u == (tg + 1u) * nx) xb_add(&bar[XB_TOPGEN], 1u);
            else XB_SPIN(xb_ld(&bar[XB_TOPGEN]) == tg, bar);
            __builtin_amdgcn_fence(__ATOMIC_ACQUIRE, "agent");
            xb_add(&bar[XB_XGEN(b.x)], 1u);
            asm volatile("s_waitcnt vmcnt(0)" ::: "memory");
        } else {
            XB_SPIN(xb_ld(&bar[XB_XGEN(b.x)]) == gen, bar);
            __builtin_amdgcn_fence(__ATOMIC_ACQUIRE, "agent");
            asm volatile("s_waitcnt vmcnt(0)" ::: "memory");
        }
    }
    __syncthreads();
}

#define GRID_SYNC() xcd_barrier((unsigned*)(p.ws + OFF_CTL), (volatile LAS unsigned*)(lds + LDS_BYTES - 16))
#ifndef REP_DL
#define REP_DL 1
#endif
#ifndef REP_HGA
#define REP_HGA 1
#endif
#ifndef REP_NA
#define REP_NA 1
#endif
#ifndef REP_SG
#define REP_SG 1
#endif
#ifndef REP_HGC
#define REP_HGC 1
#endif
#define REP_A (REP_DL > REP_HGA ? REP_DL : REP_HGA)
#define REP_B (REP_NA > REP_SG ? REP_NA : REP_SG)
#ifndef MIXREP
#define MIXREP 1
#endif

__global__ void __launch_bounds__(512, 2) fwd_megakernel(Params p) {
    extern __shared__ __attribute__((aligned(16))) unsigned char smem[];
    LAS unsigned char* lds = (LAS unsigned char*)smem;
    cg::grid_group grid = cg::this_grid();
    unsigned char* ws = p.ws;
    const int G = gridDim.x, c = blockIdx.x;
    float* MOD = (float*)(ws + OFF_MOD);
    bf16_t* H = (bf16_t*)(ws + OFF_H); bf16_t* P = (bf16_t*)(ws + OFF_P); bf16_t* BR = (bf16_t*)(ws + OFF_BR); bf16_t* MG = (bf16_t*)(ws + OFF_MG);
    bf16_t* ACT = P;
    float* HGST = (float*)(ws + OFF_HGST); float* HGD = (float*)(ws + OFF_HGD);

    volatile LAS unsigned* xst = (volatile LAS unsigned*)(lds + LDS_BYTES - 16);
    if (threadIdx.x == 0) { xst[0] = 0u; xst[1] = 0u; }
    __syncthreads();
    (void)xcd_barrier_post((unsigned*)(ws + OFF_CTL), xst);
#ifndef SKIP_PRO
    phase_prologue(p, lds);
#endif
    grid.sync();
    phase_mod_reduce(p);
    GRID_SYNC();

    for (int ck = 0; ck < NCHUNK; ++ck) {
        const int L = chunk_L(ck), bbase = chunk_bbase(ck);
        float* X = p.out + (size_t)ck * TC * DM;
        const float* xin = (ck < 2) ? p.in[0] + (size_t)ck * TC * DM : p.in[1];
        for (int l = 0; l < NLAYER; ++l) {
            const float* modl = MOD + (size_t)l * 6144;
            phase_norm_mod(l == 0 ? xin : X, l == 0 ? X : nullptr, H, p.in[6] + l * DM, modl + 0, modl + 1024, L, bbase);
            GRID_SYNC();
#ifndef SKIP_G1
            { SchedStd S; S.to.init(TC / 256, (G == 256) ? NIN / 256 - 1 : NIN / 256, G, c); S.skip_pn = (G == 256) ? (P_HGATE / 256) : 1000; S.A = (const char*)H; S.B = (const char*)(ws + OFF_WIN) + (size_t)l * NIN * DM * 2; S.atile = 256 * DM * 2; S.btile = 256 * DM * 2; S.nt = DM / 64;
              EpiProj E; E.O = P; E.ldc = NIN;
              pg8::gemm_phase(lds, DM, DM, S, E); }
            #endif
            GRID_SYNC();
            for (int rep = 0; rep < MIXREP; ++rep) {
#ifndef SKIP_MIX1
            hg_lb_table(p.in[14], l, lds);
            for (int rr_ = 0; rr_ < REP_A; ++rr_)
            for (int it = c; it < 256 + 1024; it += G) {
                if (it >= 256 && rr_ >= REP_HGA) continue;
                if (it < 256 && rr_ >= REP_DL) continue;
                if (it < 256) { int item = it;
                    if (G == 256) { const int x = it & 7, y = it >> 3, spans = L >> 8, q = x + 8 * (y / spans), span = y % spans;
                        item = (((q >> 2) * spans + span) << 2) | (q & 3); }
                    dl_item(item, P, BR, L, lds); }
                else hgA_item(it - 256, P, HGST, HGD, lds);
            }
            #endif
            GRID_SYNC();
#ifndef SKIP_MIX2
            hgB_phase(HGST, HGD, L);
            if (G == 256) {
                __syncthreads(); na_item((c & 7) * 32 + (c >> 3), P, BR, p.in[13] + (size_t)l * 4 * 15 * 31, L, lds);
                const int y = c >> 3, x = c & 7;
                if ((y & 3) == 0) {
                    __syncthreads();
                    SchedOne S; S.pm = (y >> 2) * 8 + x; S.pn = P_HGATE / 256; S.nt = DM / 64;
                    S.A = (const char*)H + (size_t)S.pm * (256 * DM * 2); S.B = (const char*)(ws + OFF_WIN) + ((size_t)l * NIN + P_HGATE) * DM * 2;
                    EpiProj E; E.O = P; E.ldc = NIN;
                    pg8::gemm_phase(lds, DM, DM, S, E);
                } else {
                    const int rank = (y - (y >> 2) - 1) * 8 + x;
                    for (int it = rank; it < 512; it += 192)
                        sg_item(it, P, BR, (const bf16_t*)(ws + OFF_SGW) + (size_t)l * 4 * 128 * 128, p.in[16] + l * 256, p.in[17] + l * 256, p.in[19] + l * 512, lds);
                }
            } else {
                for (int it = c; it < 256 + 512; it += G) {
                    if (it < 256) { __syncthreads(); na_item(it, P, BR, p.in[13] + (size_t)l * 4 * 15 * 31, L, lds); }
                    else sg_item(it - 256, P, BR, (const bf16_t*)(ws + OFF_SGW) + (size_t)l * 4 * 128 * 128, p.in[16] + l * 256, p.in[17] + l * 256, p.in[19] + l * 512, lds);
                }
            }
            #endif
            GRID_SYNC();
#ifndef SKIP_MIX3
            hg_lb_table(p.in[14], l, lds);
            for (int rr_ = 0; rr_ < REP_HGC; ++rr_)
            for (int it = c; it < 1024; it += G) hgC_item(it, P, BR, HGST, p.in[15] + l * 256, lds);
            #endif
            GRID_SYNC();
            }
#ifndef SKIP_MERGE
            { SchedMerge S; S.to.init(TC / 256, DM / 256, G, c); S.H = (const char*)H; S.BR = (const char*)BR; S.WG = (const char*)(ws + OFF_WG) + (size_t)l * 4 * DM * DM * 2; S.WB = (const char*)(ws + OFF_WB) + (size_t)l * DM * DM * 2;
              EpiMerge E; E.MG = MG; E.bgate = p.in[10] + (size_t)l * 4 * DM; E.scr = (unsigned char*)P + (size_t)c * MERGE_SCR_PER_BLOCK;
              pg8::gemm_phase(lds, DM, DM, S, E); }
            #endif
            GRID_SYNC();
#ifndef SKIP_WO
            { SchedStd S; S.to.init(TC / 256, DM / 256, G, c); S.skip_pn = 1000; S.A = (const char*)MG; S.B = (const char*)(ws + OFF_WO) + (size_t)l * DM * DM * 2; S.atile = 256 * DM * 2; S.btile = 256 * DM * 2; S.nt = DM / 64;
              EpiRes E; E.X = X; E.gm = modl + 2048; E.L = L; E.bbase = bbase;
              pg8::gemm_phase(lds, DM, DM, S, E); }
            #endif
            GRID_SYNC();
            phase_norm_mod(X, nullptr, H, p.in[7] + l * DM, modl + 3072, modl + 4096, L, bbase);
            GRID_SYNC();
#ifndef SKIP_F1
            { SchedStd S; S.to.init(TC / 256, 2 * DFF / 256, G, c); S.skip_pn = 1000; S.A = (const char*)H; S.B = (const char*)(ws + OFF_WGU) + (size_t)l * 2 * DFF * DM * 2; S.atile = 256 * DM * 2; S.btile = 256 * DM * 2; S.nt = DM / 64;
              EpiAct E; E.O = ACT;
              pg8::gemm_phase(lds, DM, DM, S, E); }
            #endif
            GRID_SYNC();
#ifndef SKIP_F2
            { SchedStd S; S.to.init(TC / 256, DM / 256, G, c); S.skip_pn = 1000; S.A = (const char*)ACT; S.B = (const char*)(ws + OFF_WD) + (size_t)l * DM * DFF * 2; S.atile = (size_t)256 * DFF * 2; S.btile = (size_t)256 * DFF * 2; S.nt = DFF / 64;
              EpiRes E; E.X = X; E.gm = modl + 5120; E.L = L; E.bbase = bbase;
              pg8::gemm_phase(lds, DFF, DFF, S, E); }
            #endif
            GRID_SYNC();
        }
        phase_final_norm(X, p.in[23]);
    }
}

extern "C" void kernel_launch(void* const* d_in, const int* in_sizes, int n_in, void* d_out, int out_size, void* d_ws, size_t ws_size, hipStream_t stream) {
    static int grid = 0;
    if (grid == 0) {
        if (n_in != 24 || ws_size < WS_END) { fprintf(stderr, "kernel_launch: unexpected n_in %d or ws_size %zu (need %zu)\n", n_in, ws_size, (size_t)WS_END); grid = -1; return; }
        int dev = 0, cus = 0, per_cu = 0;
        hipGetDevice(&dev);
        hipDeviceGetAttribute(&cus, hipDeviceAttributeMultiprocessorCount, dev);
        if (hipFuncSetAttribute((const void*)fwd_megakernel, hipFuncAttributeMaxDynamicSharedMemorySize, LDS_BYTES) != hipSuccess) { fprintf(stderr, "kernel_launch: hipFuncSetAttribute failed\n"); grid = -1; return; }
        hipOccupancyMaxActiveBlocksPerMultiprocessor(&per_cu, (const void*)fwd_megakernel, NTHR, LDS_BYTES);
        if (per_cu < 1) { fprintf(stderr, "kernel_launch: occupancy query says %d blocks per CU\n", per_cu); per_cu = 1; }
        (void)hipGetLastError();
        grid = cus;
        if (grid > 272) grid = 272;
    }
    if (grid < 0) return;
    if (hipMemsetAsync((char*)d_ws + OFF_CTL, 0, 16384, stream) != hipSuccess) { fprintf(stderr, "kernel_launch: memset of control words failed\n"); return; }
    Params p{};
    for (int i = 0; i < 24; ++i) p.in[i] = (const float*)d_in[i];
    p.out = (float*)d_out; p.ws = (unsigned char*)d_ws;
    void* args[] = {&p};
    hipError_t e = hipLaunchCooperativeKernel((const void*)fwd_megakernel, dim3(grid), dim3(NTHR), args, LDS_BYTES, stream);
    if (e != hipSuccess) fprintf(stderr, "cooperative launch failed: %s (grid %d)\n", hipGetErrorString(e), grid);
}
```

```cpp
#include <hip/hip_runtime.h>
#include <hip/hip_cooperative_groups.h>
#include <cstdio>
#include <cstdint>
namespace cg = cooperative_groups;

#define LAS __attribute__((address_space(3)))
typedef unsigned short bf16_t;
typedef short bf16x8 __attribute__((ext_vector_type(8)));
typedef float f32x4 __attribute__((ext_vector_type(4)));
typedef unsigned u32x4 __attribute__((ext_vector_type(4)));
typedef unsigned u32x2 __attribute__((ext_vector_type(2)));

constexpr int DM = 1024, TC = 16384, NCHUNK = 3, NIN = 3328, DFF = 2816, NLAYER = 4, NB = 20;
constexpr int P_NAQ = 0, P_NAK = 256, P_NAV = 512, P_FF = 768, P_FB = 1024, P_HQ = 1280, P_HI = 1536, P_HGATE = 1792, P_SU = 2048, P_SV = 2304, P_DQ = 2560, P_DK = 2816, P_DV = 3072;
constexpr float EPSV = 1e-6f;
constexpr int LDS_BYTES = 163840;
constexpr int NTHR = 512;

constexpr size_t OFF_CTL = 0;
constexpr size_t OFF_MOD = 16384;
constexpr size_t SZ_MOD = (size_t)NB * NLAYER * 6144 * 4;
constexpr size_t OFF_MODP = OFF_MOD + SZ_MOD;
constexpr size_t OFF_WIN = OFF_MODP + 8 * SZ_MOD;
constexpr size_t OFF_WG = OFF_WIN + (size_t)NLAYER * NIN * DM * 2;
constexpr size_t OFF_WB = OFF_WG + (size_t)NLAYER * 4 * DM * DM * 2;
constexpr size_t OFF_WO = OFF_WB + (size_t)NLAYER * DM * DM * 2;
constexpr size_t OFF_WGU = OFF_WO + (size_t)NLAYER * DM * DM * 2;
constexpr size_t OFF_WD = OFF_WGU + (size_t)NLAYER * 2 * DFF * DM * 2;
constexpr size_t OFF_SGW = OFF_WD + (size_t)NLAYER * DM * DFF * 2;
constexpr size_t OFF_H = OFF_SGW + (size_t)NLAYER * 4 * 128 * 128 * 2;
constexpr size_t OFF_P = OFF_H + (size_t)TC * DM * 2;
constexpr size_t OFF_BR = OFF_P + (size_t)TC * NIN * 2;
constexpr size_t OFF_MG = OFF_BR + (size_t)TC * DM * 2;
constexpr size_t OFF_HGST = OFF_MG + (size_t)TC * DM * 2;
constexpr size_t OFF_HGD = OFF_HGST + (size_t)256 * 8 * 4096 * 4;
constexpr size_t WS_END = OFF_HGD + (size_t)256 * 8 * 64 * 4;
constexpr size_t MERGE_SCR_PER_BLOCK = 131072 + 131072;

struct Params {
    const float* in[24];
    float* out;
    unsigned char* ws;
};

__device__ __forceinline__ unsigned pk2(float lo, float hi) { unsigned r; asm("v_cvt_pk_bf16_f32 %0, %1, %2" : "=v"(r) : "v"(lo), "v"(hi)); return r; }
__device__ __forceinline__ bf16_t f2bf(float f) { return (bf16_t)(pk2(f, 0.f) & 0xffffu); }
__device__ __forceinline__ float bf2f(unsigned b) { return __uint_as_float(b << 16); }
__device__ __forceinline__ float bflo(unsigned w) { return __uint_as_float(w << 16); }
__device__ __forceinline__ float bfhi(unsigned w) { return __uint_as_float(w & 0xffff0000u); }
__device__ __forceinline__ float sigmoidf_(float x) { return 1.f / (1.f + __expf(-x)); }
__device__ __forceinline__ float siluf_(float x) { return x * sigmoidf_(x); }
__device__ __forceinline__ float gelu_tanh(float x) { return x * sigmoidf_(1.5957691216f * (x + 0.044715f * x * x * x)); }
__device__ __forceinline__ float wave_sum(float v) {
#pragma unroll
    for (int o = 1; o < 64; o <<= 1) v += __shfl_xor(v, o);
    return v;
}
__device__ __forceinline__ int opaque_tid() { int t = threadIdx.x; asm volatile("" : "+v"(t)); return t; }
#define MFMA16(a, b, c) __builtin_amdgcn_mfma_f32_16x16x32_bf16((a), (b), (c), 0, 0, 0)

__device__ __forceinline__ int chunk_L(int ck) { return ck < 2 ? 2048 : 4096; }
__device__ __forceinline__ int chunk_bbase(int ck) { return ck * 8; }

namespace pg8 {
constexpr int BM = 256, BK = 64, HALF = 128, HTB = HALF * BK * 2, STAGE_BYTES = 8 * HTB, NXCD = 8, WGM = 8;
__host__ __device__ __forceinline__ int lds_byte(int r, int c) { const int st = (r >> 4) * 2 + (c >> 5), rr = r & 15, cc = c & 31, ob = rr * 64 + cc * 2; return st * 1024 + (ob ^ (((ob >> 9) & 1) << 5)); }
__host__ __device__ __forceinline__ void stage_rc(int b, int& R, int& C) { const int st = b / 1024, sb = b % 1024, swz = sb ^ (((sb >> 9) & 1) << 5); R = (st >> 1) * 16 + swz / 64; C = (st & 1) * 32 + (swz % 64) / 2; }
__host__ __device__ __forceinline__ int perm32(int rho) { const int n = rho >> 4, i = rho & 15; return 8 * (i >> 2) + 4 * n + (i & 3); }

struct Unit { const char* a; const char* b; int nt; int pm, pn, kind; };

struct TileOrder {
    int nM, nN, nwg, G, c;
    __device__ __forceinline__ void init(int nM_, int nN_, int G_, int c_) { nM = nM_; nN = nN_; nwg = nM * nN; G = G_; c = c_; }
    __device__ __forceinline__ bool tile(int i, int& pm, int& pn) const {
        const long L = (long)i * G + c; if (L >= nwg) return false;
        int wgid = (int)L; { const int q = nwg / NXCD, r = nwg % NXCD, xcd = wgid % NXCD, off = wgid / NXCD; wgid = (xcd < r ? xcd * (q + 1) : r * (q + 1) + (xcd - r) * q) + off; }
        const int nig = WGM * nN, gid = wgid / nig, fm = gid * WGM, gsz = (nM - fm) < WGM ? (nM - fm) : WGM;
        pm = fm + ((wgid % nig) % gsz); pn = (wgid % nig) / gsz; return true;
    }
};

template <class Epi, class Sched>
__device__ __forceinline__ void gemm_phase(LAS unsigned char* lds, const int lda, const int ldb, const Sched& S, const Epi& E) {
    const int tid = opaque_tid(), wid = __builtin_amdgcn_readfirstlane(tid >> 6), lane = tid & 63, wr = wid >> 2, wc = wid & 3, fr = lane & 15, fq = lane >> 4;
    unsigned voffA[2], voffB[2];
#pragma unroll
    for (int i = 0; i < 2; ++i) { int R, C; stage_rc(tid * 16 + i * 8192, R, C); const int Rb = Epi::PERM ? ((R & ~31) + perm32(R & 31)) : R;
        voffA[i] = (unsigned)(R * lda + C) * 2u; voffB[i] = (unsigned)(Rb * ldb + C) * 2u; }
    const size_t kstep = (size_t)(BK * 2);
    const size_t hstepA = (size_t)HALF * lda * 2, hstepB = (size_t)HALF * ldb * 2;
    const unsigned ldsw = (unsigned)wid * 1024u;
    const int aoff = lds_byte(wr * 64 + fr, fq * 8), boff = lds_byte(wc * 32 + fr, fq * 8);
#define PG8_SA(b, h) (((b) * 2 + (h)) * HTB)
#define PG8_SB(b, h) ((4 + (b) * 2 + (h)) * HTB)
#define PG8_STAGE(bufoff, gbase, voff) do { _Pragma("unroll") for (int _i = 0; _i < 2; ++_i) \
        __builtin_amdgcn_global_load_lds((const unsigned*)((const char*)(gbase) + (voff)[_i]), (LAS unsigned*)(lds + (bufoff) + ldsw + _i * 8192), 16, 0, 0); } while (0)
#define PG8_LDA(dst, b, h) do { _Pragma("unroll") for (int m = 0; m < 4; ++m) _Pragma("unroll") for (int k = 0; k < 2; ++k) dst[m][k] = *(const LAS bf16x8*)(lds + PG8_SA(b, h) + aoff + m * 2048 + k * 1024); } while (0)
#define PG8_LDB(dst, b, h) do { _Pragma("unroll") for (int n = 0; n < 2; ++n) _Pragma("unroll") for (int k = 0; k < 2; ++k) dst[n][k] = *(const LAS bf16x8*)(lds + PG8_SB(b, h) + boff + n * 2048 + k * 1024); } while (0)
#define PG8_MMA(ai, bj, At, Bt) do { __builtin_amdgcn_s_setprio(1); _Pragma("unroll") for (int m = 0; m < 4; ++m) _Pragma("unroll") for (int n = 0; n < 2; ++n) _Pragma("unroll") for (int k = 0; k < 2; ++k) \
        acc[ai][bj][m][n] = __builtin_amdgcn_mfma_f32_16x16x32_bf16(Bt[n][k], At[m][k], acc[ai][bj][m][n], 0, 0, 0); __builtin_amdgcn_s_setprio(0); } while (0)
#define PG8_WAIT_V(n) asm volatile("s_waitcnt vmcnt(" #n ")" ::: "memory")
#define PG8_WAIT_L(n) asm volatile("s_waitcnt lgkmcnt(" #n ")" ::: "memory")
#define PG8_BAR __builtin_amdgcn_s_barrier()
#define PG8_SCHED __builtin_amdgcn_sched_barrier(0)
    Unit cur, nxt; int ui = 0;
    if (!S.next(0, cur)) return;
    f32x4 acc[2][2][4][2];
#pragma unroll
    for (int a = 0; a < 2; ++a)
#pragma unroll
        for (int b = 0; b < 2; ++b)
#pragma unroll
            for (int m = 0; m < 4; ++m)
#pragma unroll
                for (int n = 0; n < 2; ++n) acc[a][b][m][n] = (f32x4){0.f, 0.f, 0.f, 0.f};
    bf16x8 At[4][2], B0[2][2], B1[2][2];
    const char* cA = cur.a; const char* cB = cur.b;
    PG8_STAGE(PG8_SB(0, 0), cB, voffB); PG8_STAGE(PG8_SA(0, 0), cA, voffA); PG8_STAGE(PG8_SB(0, 1), cB + hstepB, voffB); PG8_STAGE(PG8_SA(0, 1), cA + hstepA, voffA);
    if (wr == 1) PG8_BAR;
    PG8_WAIT_V(4); PG8_BAR;
    PG8_STAGE(PG8_SB(1, 0), cB + kstep, voffB); PG8_STAGE(PG8_SA(1, 0), cA + kstep, voffA); PG8_STAGE(PG8_SB(1, 1), cB + hstepB + kstep, voffB);
    PG8_WAIT_V(6); PG8_BAR;
    for (;;) {
        const bool has_next = S.next(ui + 1, nxt);
        const char* nA = has_next ? nxt.a : cA; const char* nB = has_next ? nxt.b : cB;
        const int nt = cur.nt;
        for (int t = 0; t < nt; t += 2) {
            const bool last = (t == nt - 2);
            const char* a1 = cA + (size_t)(t + 1) * kstep;
            const char* a2 = last ? nA : cA + (size_t)(t + 2) * kstep; const char* b2 = last ? nB : cB + (size_t)(t + 2) * kstep;
            const char* a3 = a2 + kstep; const char* b3 = b2 + kstep;
            PG8_LDB(B0, 0, 0); PG8_SCHED; PG8_LDA(At, 0, 0); PG8_STAGE(PG8_SA(1, 1), a1 + hstepA, voffA);
            PG8_WAIT_L(8); PG8_BAR; PG8_WAIT_L(0); PG8_MMA(0, 0, At, B0); PG8_BAR; PG8_SCHED;
            PG8_LDB(B1, 0, 1); PG8_STAGE(PG8_SB(0, 0), b2, voffB);
            PG8_BAR; PG8_WAIT_L(0); PG8_MMA(0, 1, At, B1); PG8_BAR;
            PG8_LDA(At, 0, 1); PG8_STAGE(PG8_SA(0, 0), a2, voffA);
            PG8_BAR; PG8_WAIT_L(0); PG8_MMA(1, 0, At, B0); PG8_BAR; PG8_SCHED;
            PG8_STAGE(PG8_SB(0, 1), b2 + hstepB, voffB);
            PG8_WAIT_V(6); PG8_BAR; PG8_MMA(1, 1, At, B1); PG8_BAR;
            PG8_LDB(B0, 1, 0); PG8_SCHED; PG8_LDA(At, 1, 0); PG8_STAGE(PG8_SA(0, 1), a2 + hstepA, voffA);
            PG8_WAIT_L(8); PG8_BAR; PG8_WAIT_L(0); PG8_MMA(0, 0, At, B0); PG8_BAR; PG8_SCHED;
            PG8_LDB(B1, 1, 1); PG8_STAGE(PG8_SB(1, 0), b3, voffB);
            PG8_BAR; PG8_WAIT_L(0); PG8_MMA(0, 1, At, B1); PG8_BAR;
            PG8_LDA(At, 1, 1); PG8_STAGE(PG8_SA(1, 0), a3, voffA);
            PG8_BAR; PG8_WAIT_L(0); PG8_MMA(1, 0, At, B0); PG8_BAR; PG8_SCHED;
            PG8_STAGE(PG8_SB(1, 1), b3 + hstepB, voffB);
            PG8_WAIT_V(6); PG8_BAR; PG8_MMA(1, 1, At, B1); PG8_BAR;
        }
        E(acc, cur, wr, wc, fr, fq);
        if (!has_next) break;
#pragma unroll
        for (int a = 0; a < 2; ++a)
#pragma unroll
            for (int b = 0; b < 2; ++b)
#pragma unroll
                for (int m = 0; m < 4; ++m)
#pragma unroll
                    for (int n = 0; n < 2; ++n) acc[a][b][m][n] = (f32x4){0.f, 0.f, 0.f, 0.f};
        cur = nxt; cA = nA; cB = nB; ++ui;
    }
    PG8_WAIT_V(0);
    if (wr == 0) PG8_BAR;
    PG8_BAR;
#undef PG8_SA
#undef PG8_SB
#undef PG8_STAGE
#undef PG8_LDA
#undef PG8_LDB
#undef PG8_MMA
#undef PG8_WAIT_V
#undef PG8_WAIT_L
#undef PG8_BAR
#undef PG8_SCHED
}
}
using pg8::Unit;

struct SchedStd {
    pg8::TileOrder to; const char* A; const char* B; size_t atile, btile; int nt; int skip_pn;
    __device__ __forceinline__ bool next(int i, Unit& u) const {
        int pm, pn; if (!to.tile(i, pm, pn)) return false;
        pn += (pn >= skip_pn) ? 1 : 0;
        u.pm = pm; u.pn = pn; u.kind = 0; u.nt = nt; u.a = A + (size_t)pm * atile; u.b = B + (size_t)pn * btile; return true;
    }
};
struct SchedOne {
    const char* A; const char* B; int nt, pm, pn;
    __device__ __forceinline__ bool next(int i, Unit& u) const { if (i > 0) return false; u.pm = pm; u.pn = pn; u.kind = 0; u.nt = nt; u.a = A; u.b = B; return true; }
};
struct SchedMerge {
    pg8::TileOrder to; const char* H; const char* BR; const char* WG; const char* WB;
    __device__ __forceinline__ bool next(int i, Unit& u) const {
        int pm, pn; if (!to.tile(i >> 3, pm, pn)) return false;
        const int sub = i & 7, bi = sub >> 1;
        u.pm = pm; u.pn = pn; u.kind = sub;
        if (sub & 1) { u.nt = 16; u.a = H + (size_t)pm * (256 * DM * 2); u.b = WG + (size_t)bi * (DM * DM * 2) + (size_t)pn * (256 * DM * 2); }
        else { u.nt = 4; u.a = BR + (size_t)pm * (256 * DM * 2) + bi * 512; u.b = WB + (size_t)pn * (256 * DM * 2) + bi * 512; }
        return true;
    }
};

struct EpiProj {
    static constexpr bool PERM = true;
    bf16_t* O; int ldc;
    __device__ __forceinline__ void operator()(const f32x4 (&acc)[2][2][4][2], const Unit& u, int wr, int wc, int fr, int fq) const {
        const int row0 = u.pm * 256 + wr * 64 + fr, col0 = u.pn * 256 + wc * 32 + 8 * fq;
#pragma unroll
        for (int ai = 0; ai < 2; ++ai)
#pragma unroll
            for (int m = 0; m < 4; ++m) { bf16_t* rowp = O + (size_t)(row0 + ai * 128 + m * 16) * ldc + col0;
#pragma unroll
                for (int bj = 0; bj < 2; ++bj) { const f32x4 v0 = acc[ai][bj][m][0], v1 = acc[ai][bj][m][1];
                    u32x4 o; o.x = pk2(v0[0], v0[1]); o.y = pk2(v0[2], v0[3]); o.z = pk2(v1[0], v1[1]); o.w = pk2(v1[2], v1[3]);
                    *(u32x4*)(rowp + bj * 128) = o; } }
    }
};
struct EpiAct {
    static constexpr bool PERM = true;
    bf16_t* O;
    __device__ __forceinline__ void operator()(const f32x4 (&acc)[2][2][4][2], const Unit& u, int wr, int wc, int fr, int fq) const {
        const int row0 = u.pm * 256 + wr * 64 + fr, col0 = u.pn * 128 + wc * 32 + 8 * fq;
#pragma unroll
        for (int ai = 0; ai < 2; ++ai)
#pragma unroll
            for (int m = 0; m < 4; ++m) { bf16_t* rowp = O + (size_t)(row0 + ai * 128 + m * 16) * DFF + col0;
                float r[8];
#pragma unroll
                for (int n = 0; n < 2; ++n)
#pragma unroll
                    for (int j = 0; j < 4; ++j) { const float g = acc[ai][0][m][n][j], up = acc[ai][1][m][n][j]; r[n * 4 + j] = siluf_(g) * up; }
                u32x4 o; o.x = pk2(r[0], r[1]); o.y = pk2(r[2], r[3]); o.z = pk2(r[4], r[5]); o.w = pk2(r[6], r[7]);
                *(u32x4*)rowp = o; }
    }
};
struct EpiRes {
    static constexpr bool PERM = false;
    float* X; const float* gm; int L; int bbase;
    __device__ __forceinline__ void operator()(const f32x4 (&acc)[2][2][4][2], const Unit& u, int wr, int wc, int fr, int fq) const {
        const int row0 = u.pm * 256 + wr * 64 + fr, col0 = u.pn * 256 + wc * 32 + 4 * fq;
        const int b = bbase + (u.pm * 256) / L;
        const float* g = gm + (size_t)b * (NLAYER * 6144) + col0;
        f32x4 gv[2][2];
#pragma unroll
        for (int bj = 0; bj < 2; ++bj)
#pragma unroll
            for (int n = 0; n < 2; ++n) gv[bj][n] = *(const f32x4*)(g + bj * 128 + n * 16);
#pragma unroll
        for (int ai = 0; ai < 2; ++ai)
#pragma unroll
            for (int mh = 0; mh < 2; ++mh) {
                f32x4 xv[2][2][2];
#pragma unroll
                for (int mm = 0; mm < 2; ++mm) { const float* rowp = X + (size_t)(row0 + ai * 128 + (2 * mh + mm) * 16) * DM + col0;
#pragma unroll
                    for (int bj = 0; bj < 2; ++bj)
#pragma unroll
                        for (int n = 0; n < 2; ++n) xv[mm][bj][n] = *(const f32x4*)(rowp + bj * 128 + n * 16); }
#pragma unroll
                for (int mm = 0; mm < 2; ++mm) { float* rowp = X + (size_t)(row0 + ai * 128 + (2 * mh + mm) * 16) * DM + col0;
#pragma unroll
                    for (int bj = 0; bj < 2; ++bj)
#pragma unroll
                        for (int n = 0; n < 2; ++n) *(f32x4*)(rowp + bj * 128 + n * 16) = xv[mm][bj][n] + gv[bj][n] * acc[ai][bj][2 * mh + mm][n]; }
            }
    }
};
struct EpiMerge {
    static constexpr bool PERM = true;
    bf16_t* MG; const float* bgate;
    unsigned char* scr;
    __device__ __forceinline__ void operator()(const f32x4 (&acc)[2][2][4][2], const Unit& u, int wr, int wc, int fr, int fq) const {
        const int tid = threadIdx.x, bi = u.kind >> 1;
        unsigned char* pbp = scr + tid * 16;
        asm volatile("" : "+v"(pbp));
        if ((u.kind & 1) == 0) {
#pragma unroll
            for (int bj = 0; bj < 2; ++bj)
#pragma unroll
                for (int ai = 0; ai < 2; ++ai)
#pragma unroll
                    for (int m = 0; m < 4; ++m) { const f32x4 v0 = acc[ai][bj][m][0], v1 = acc[ai][bj][m][1];
                        u32x4 o; o.x = pk2(v0[0], v0[1]); o.y = pk2(v0[2], v0[3]); o.z = pk2(v1[0], v1[1]); o.w = pk2(v1[2], v1[3]);
                        *(u32x4*)(pbp + ((bj * 2 + ai) * 4 + m) * 8192) = o; }
        } else {
            const int row0 = u.pm * 256 + wr * 64 + fr, col0 = u.pn * 256 + wc * 32 + 8 * fq;
            const float* bg = bgate + bi * DM + col0;
            bf16_t* mgp = MG + (size_t)row0 * DM + col0;
#pragma unroll
            for (int bj = 0; bj < 2; ++bj) {
                const f32x4 b0 = *(const f32x4*)(bg + bj * 128), b1 = *(const f32x4*)(bg + bj * 128 + 4);
                u32x4 pv[8], pp[8];
#pragma unroll
                for (int k = 0; k < 8; ++k) { pv[k] = *(const u32x4*)(pbp + (bj * 8 + k) * 8192);
                    pp[k] = (bi > 0) ? *(const u32x4*)(pbp + 131072 + (bj * 8 + k) * 8192) : (u32x4){0u, 0u, 0u, 0u}; }
#pragma unroll
                for (int ai = 0; ai < 2; ++ai)
#pragma unroll
                    for (int m = 0; m < 4; ++m) { const int k = ai * 4 + m;
                        const f32x4 a0 = acc[ai][bj][m][0] + b0, a1 = acc[ai][bj][m][1] + b1;
                        f32x4 r0, r1;
                        r0[0] = sigmoidf_(a0[0]) * bflo(pv[k].x) + bflo(pp[k].x); r0[1] = sigmoidf_(a0[1]) * bfhi(pv[k].x) + bfhi(pp[k].x);
                        r0[2] = sigmoidf_(a0[2]) * bflo(pv[k].y) + bflo(pp[k].y); r0[3] = sigmoidf_(a0[3]) * bfhi(pv[k].y) + bfhi(pp[k].y);
                        r1[0] = sigmoidf_(a1[0]) * bflo(pv[k].z) + bflo(pp[k].z); r1[1] = sigmoidf_(a1[1]) * bfhi(pv[k].z) + bfhi(pp[k].z);
                        r1[2] = sigmoidf_(a1[2]) * bflo(pv[k].w) + bflo(pp[k].w); r1[3] = sigmoidf_(a1[3]) * bfhi(pv[k].w) + bfhi(pp[k].w);
                        u32x4 o; o.x = pk2(r0[0], r0[1]); o.y = pk2(r0[2], r0[3]); o.z = pk2(r1[0], r1[1]); o.w = pk2(r1[2], r1[3]);
                        if (bi < 3) *(u32x4*)(pbp + 131072 + (bj * 8 + k) * 8192) = o;
                        else *(u32x4*)(mgp + (size_t)(ai * 128 + m * 16) * DM + bj * 128) = o; }
            }
        }
    }
};

__device__ __forceinline__ void transpose_item(const float* W, int N, int k0, int n0, bf16_t* dst  , int ldwt, LAS float* scr, int lane) {
    float tv[32];
#pragma unroll
    for (int i = 0; i < 32; ++i) tv[i] = W[(size_t)(k0 + 2 * i + (lane >> 5)) * N + n0 + (lane & 31)];
#pragma unroll
    for (int i = 0; i < 32; ++i) scr[(2 * i + (lane >> 5)) * 33 + (lane & 31)] = tv[i];
    __builtin_amdgcn_wave_barrier();
    const int c = lane & 7;
#pragma unroll
    for (int j = 0; j < 4; ++j) { const int n = (lane >> 3) + 8 * j; const LAS float* s = scr + (8 * c) * 33 + n;
        u32x4 o; o.x = pk2(s[0 * 33], s[1 * 33]); o.y = pk2(s[2 * 33], s[3 * 33]); o.z = pk2(s[4 * 33], s[5 * 33]); o.w = pk2(s[6 * 33], s[7 * 33]);
        *(u32x4*)(dst + (size_t)n * ldwt + 8 * c) = o; }
    __builtin_amdgcn_wave_barrier();
}

__device__ __forceinline__ void phase_prologue(const Params& p, LAS unsigned char* lds) {
    const int tid = opaque_tid(), lane = tid & 63, wave = tid >> 6;
    unsigned char* ws = p.ws;
    {
        LAS float* scr = (LAS float*)(lds + wave * 8704);
        const int gw = blockIdx.x * 8 + wave, NGW = gridDim.x * 8;
        constexpr int I_IN = 16 * (NIN / 32), I_G = 4 * 16 * 32, I_B = 4 * 4 * 32, I_O = 16 * 32, I_F = 16 * (DFF / 32), I_D = (DFF / 64) * 32;
        constexpr int PER_LAYER = I_IN + I_G + I_B + I_O + 2 * I_F + I_D;
        for (int it = gw; it < NLAYER * PER_LAYER; it += NGW) {
            const int l = it / PER_LAYER; int r = it % PER_LAYER;
            if (r < I_IN) { const int nb = r % (NIN / 32), kb = r / (NIN / 32);
                transpose_item(p.in[8] + (size_t)l * DM * NIN, NIN, 64 * kb, 32 * nb, (bf16_t*)(ws + OFF_WIN) + ((size_t)l * NIN + 32 * nb) * DM + 64 * kb, DM, scr, lane); continue; }
            r -= I_IN;
            if (r < I_G) { const int bi = r / 512, rr = r % 512, nb = rr % 32, kb = rr / 32;
                transpose_item(p.in[9] + ((size_t)l * 4 + bi) * DM * DM, DM, 64 * kb, 32 * nb, (bf16_t*)(ws + OFF_WG) + (((size_t)l * 4 + bi) * DM + 32 * nb) * DM + 64 * kb, DM, scr, lane); continue; }
            r -= I_G;
            if (r < I_B) { const int bi = r / 128, rr = r % 128, nb = rr % 32, kb = rr / 32;
                transpose_item(p.in[11] + ((size_t)l * 4 + bi) * 256 * DM, DM, 64 * kb, 32 * nb, (bf16_t*)(ws + OFF_WB) + ((size_t)l * DM + 32 * nb) * DM + bi * 256 + 64 * kb, DM, scr, lane); continue; }
            r -= I_B;
            if (r < I_O) { const int nb = r % 32, kb = r / 32;
                transpose_item(p.in[12] + (size_t)l * DM * DM, DM, 64 * kb, 32 * nb, (bf16_t*)(ws + OFF_WO) + ((size_t)l * DM + 32 * nb) * DM + 64 * kb, DM, scr, lane); continue; }
            r -= I_O;
            if (r < 2 * I_F) { const int which = r / I_F, rr = r % I_F, nb = rr % (DFF / 32), kb = rr / (DFF / 32);
                const int n0 = 32 * nb, row = (n0 >> 7) * 256 + (n0 & 127) + which * 128;
                transpose_item(p.in[which ? 21 : 20] + (size_t)l * DM * DFF, DFF, 64 * kb, n0, (bf16_t*)(ws + OFF_WGU) + ((size_t)l * 2 * DFF + row) * DM + 64 * kb, DM, scr, lane); continue; }
            r -= 2 * I_F;
            { const int nb = r % 32, kb = r / 32;
                transpose_item(p.in[22] + (size_t)l * DFF * DM, DM, 64 * kb, 32 * nb, (bf16_t*)(ws + OFF_WD) + ((size_t)l * DM + 32 * nb) * DFF + 64 * kb, DFF, scr, lane); }
        }
    }
    {
        const float* src = p.in[18]; bf16_t* dst = (bf16_t*)(ws + OFF_SGW);
        for (int i = blockIdx.x * NTHR + tid; i < NLAYER * 4 * 128 * 128 / 4; i += gridDim.x * NTHR) {
            const f32x4 v = *(const f32x4*)(src + 4 * (size_t)i); u32x2 o; o.x = pk2(v[0], v[1]); o.y = pk2(v[2], v[3]); *(u32x2*)(dst + 4 * (size_t)i) = o; }
    }
    __syncthreads();
    {
        LAS float* cs = (LAS float*)lds;
        float* modp = (float*)(ws + OFF_MODP);
        for (int it = blockIdx.x; it < NLAYER * 12 * 8; it += gridDim.x) {
            const int ks = it & 7, nb = (it >> 3) % 12, l = it / 96;
            __syncthreads();
            for (int e = tid; e < 128 * NB; e += NTHR) { const int kk = e / NB, b = e % NB;
                const float c = b < 16 ? p.in[2][b * DM + 128 * ks + kk] : p.in[3][(b - 16) * DM + 128 * ks + kk];
                cs[kk * NB + b] = siluf_(c); }
            __syncthreads();
            const int n = nb * 512 + tid;
            const float* w = p.in[4] + ((size_t)l * DM + 128 * ks) * 6144 + n;
            float a[NB];
#pragma unroll
            for (int b = 0; b < NB; ++b) a[b] = 0.f;
#pragma unroll 16
            for (int kk = 0; kk < 128; ++kk) { const float wv = w[(size_t)kk * 6144];
#pragma unroll
                for (int b4 = 0; b4 < NB / 4; ++b4) { const f32x4 c4 = *(const LAS f32x4*)(cs + kk * NB + 4 * b4);
                    a[4 * b4 + 0] += c4[0] * wv; a[4 * b4 + 1] += c4[1] * wv; a[4 * b4 + 2] += c4[2] * wv; a[4 * b4 + 3] += c4[3] * wv; } }
#pragma unroll
            for (int b = 0; b < NB; ++b) modp[(((size_t)ks * NB + b) * NLAYER + l) * 6144 + n] = a[b];
        }
    }
}
__device__ __forceinline__ void phase_mod_reduce(const Params& p) {
    const float* modp = (const float*)(p.ws + OFF_MODP); float* mod = (float*)(p.ws + OFF_MOD);
    constexpr int NMOD = NB * NLAYER * 6144;
    for (int i = blockIdx.x * NTHR + opaque_tid(); i < NMOD; i += gridDim.x * NTHR) {
        const int n = i % 6144, l = (i / 6144) % NLAYER;
        float s = p.in[5][l * 6144 + n];
#pragma unroll
        for (int ks = 0; ks < 8; ++ks) s += modp[(size_t)ks * NMOD + i];
        mod[i] = s;
    }
}

__device__ __forceinline__ void phase_norm_mod(const float* xsrc, float* copy_to, bf16_t* H, const float* g, const float* mod_sh, const float* mod_sc, int L, int bbase) {
    const int tid = opaque_tid(), lane = tid & 63, gw = blockIdx.x * 8 + (tid >> 6), NGW = gridDim.x * 8;
    const f32x4* gr = (const f32x4*)g + lane;
    for (int row = gw; row < TC; row += 2 * NGW) {
        const int row2 = (row + NGW < TC) ? row + NGW : row;
        const int b1 = bbase + row / L, b2 = bbase + row2 / L;
        const f32x4* x1 = (const f32x4*)(xsrc + (size_t)row * DM) + lane; const f32x4* x2 = (const f32x4*)(xsrc + (size_t)row2 * DM) + lane;
        const f32x4* sh1 = (const f32x4*)(mod_sh + (size_t)b1 * (NLAYER * 6144)) + lane; const f32x4* sc1 = (const f32x4*)(mod_sc + (size_t)b1 * (NLAYER * 6144)) + lane;
        const f32x4* sh2 = (const f32x4*)(mod_sh + (size_t)b2 * (NLAYER * 6144)) + lane; const f32x4* sc2 = (const f32x4*)(mod_sc + (size_t)b2 * (NLAYER * 6144)) + lane;
        f32x4 v1[4], v2[4], gg[4], s1[4], c1[4], s2[4], c2[4];
#pragma unroll
        for (int j = 0; j < 4; ++j) { v1[j] = x1[64 * j]; v2[j] = x2[64 * j]; gg[j] = gr[64 * j]; s1[j] = sh1[64 * j]; c1[j] = sc1[64 * j]; s2[j] = sh2[64 * j]; c2[j] = sc2[64 * j]; }
        float q1 = 0.f, q2 = 0.f;
#pragma unroll
        for (int j = 0; j < 4; ++j) { q1 += (v1[j][0] * v1[j][0] + v1[j][1] * v1[j][1]) + (v1[j][2] * v1[j][2] + v1[j][3] * v1[j][3]);
            q2 += (v2[j][0] * v2[j][0] + v2[j][1] * v2[j][1]) + (v2[j][2] * v2[j][2] + v2[j][3] * v2[j][3]); }
        const float r1 = rsqrtf(wave_sum(q1) * (1.f / DM) + EPSV), r2 = rsqrtf(wave_sum(q2) * (1.f / DM) + EPSV);
        if (copy_to) { f32x4* cr1 = (f32x4*)(copy_to + (size_t)row * DM) + lane; f32x4* cr2 = (f32x4*)(copy_to + (size_t)row2 * DM) + lane;
#pragma unroll
            for (int j = 0; j < 4; ++j) { cr1[64 * j] = v1[j]; cr2[64 * j] = v2[j]; } }
        u32x2* o1 = (u32x2*)(H + (size_t)row * DM) + lane; u32x2* o2 = (u32x2*)(H + (size_t)row2 * DM) + lane;
#pragma unroll
        for (int j = 0; j < 4; ++j) { const f32x4 y1 = v1[j] * r1 * gg[j] * (c1[j] + 1.f) + s1[j], y2 = v2[j] * r2 * gg[j] * (c2[j] + 1.f) + s2[j];
            u32x2 w1, w2; w1.x = pk2(y1[0], y1[1]); w1.y = pk2(y1[2], y1[3]); w2.x = pk2(y2[0], y2[1]); w2.y = pk2(y2[2], y2[3]); o1[64 * j] = w1; o2[64 * j] = w2; }
    }
}
__device__ __forceinline__ void phase_final_norm(float* X, const float* g) {
    const int tid = opaque_tid(), lane = tid & 63, gw = blockIdx.x * 8 + (tid >> 6), NGW = gridDim.x * 8;
    const f32x4* gr = (const f32x4*)g + lane;
    for (int row = gw; row < TC; row += 2 * NGW) {
        const int row2 = (row + NGW < TC) ? row + NGW : row;
        f32x4* x1 = (f32x4*)(X + (size_t)row * DM) + lane; f32x4* x2 = (f32x4*)(X + (size_t)row2 * DM) + lane;
        f32x4 v1[4], v2[4], gg[4]; float q1 = 0.f, q2 = 0.f;
#pragma unroll
        for (int j = 0; j < 4; ++j) { v1[j] = x1[64 * j]; v2[j] = x2[64 * j]; gg[j] = gr[64 * j]; }
#pragma unroll
        for (int j = 0; j < 4; ++j) { q1 += (v1[j][0] * v1[j][0] + v1[j][1] * v1[j][1]) + (v1[j][2] * v1[j][2] + v1[j][3] * v1[j][3]);
            q2 += (v2[j][0] * v2[j][0] + v2[j][1] * v2[j][1]) + (v2[j][2] * v2[j][2] + v2[j][3] * v2[j][3]); }
        const float r1 = rsqrtf(wave_sum(q1) * (1.f / DM) + EPSV), r2 = rsqrtf(wave_sum(q2) * (1.f / DM) + EPSV);
#pragma unroll
        for (int j = 0; j < 4; ++j) { x1[64 * j] = v1[j] * r1 * gg[j]; x2[64 * j] = v2[j] * r2 * gg[j]; }
    }
}

struct AttnState { f32x4 o[4]; float m, l; };
constexpr int VT_BYTES = 5120;
struct KVRegs { bf16x8 k[2][2]; u32x4 v[4]; };
template <class TokK, class TokV>
__device__ __forceinline__ void kv_load(KVRegs& kv, const bf16_t* P, int kcol, int vcol, int lane, int fq, const TokK& tok_k, const TokV& tok_v) {
#pragma unroll
    for (int t = 0; t < 2; ++t) { const bf16_t* kp = P + (size_t)tok_k(t) * NIN + kcol + 8 * fq; kv.k[t][0] = *(const bf16x8*)kp; kv.k[t][1] = *(const bf16x8*)(kp + 32); }
#pragma unroll
    for (int i = 0; i < 4; ++i) { const int pc = lane + 64 * i, key = pc >> 3, ch = pc & 7; kv.v[i] = *(const u32x4*)(P + (size_t)tok_v(key) * NIN + vcol + 8 * ch); }
}
constexpr int VROW = 72;
typedef short v4s_t __attribute__((ext_vector_type(4)));
__device__ __forceinline__ void attn_stage_v(LAS bf16_t* vt, const KVRegs& kv, int lane) {
#pragma unroll
    for (int i = 0; i < 4; ++i) { const int pc = lane + 64 * i, key = pc >> 3, ch = pc & 7; *(LAS u32x4*)(vt + key * VROW + 8 * ch) = kv.v[i]; }
}
__device__ __forceinline__ void attn_softmax(AttnState& st, const float (&s)[2][4], const bool (&valid)[2][4], bf16x8& pfo, float& alpha) {
    float mx = fmaxf(fmaxf(fmaxf(s[0][0], s[0][1]), fmaxf(s[0][2], s[0][3])), fmaxf(fmaxf(s[1][0], s[1][1]), fmaxf(s[1][2], s[1][3])));
    mx = fmaxf(mx, __shfl_xor(mx, 16)); mx = fmaxf(mx, __shfl_xor(mx, 32));
    const float mn = fmaxf(st.m, mx); alpha = __expf(st.m - mn);
    float pv[2][4]; float ps = 0.f;
#pragma unroll
    for (int t = 0; t < 2; ++t)
#pragma unroll
        for (int r = 0; r < 4; ++r) { pv[t][r] = valid[t][r] ? __expf(s[t][r] - mn) : 0.f; ps += pv[t][r]; }
    st.m = mn; st.l = st.l * alpha + ps;
    union { bf16x8 v; unsigned u[4]; } pf;
    pf.u[0] = pk2(pv[0][0], pv[0][1]); pf.u[1] = pk2(pv[0][2], pv[0][3]); pf.u[2] = pk2(pv[1][0], pv[1][1]); pf.u[3] = pk2(pv[1][2], pv[1][3]);
    pfo = pf.v;
}
__device__ __forceinline__ void attn_pv(AttnState& st, const bf16x8 pf, const float alpha, const LAS bf16_t* vt, int fr, int fq) {
    const LAS bf16_t* base = vt + (4 * fq + (fr >> 2)) * VROW + 4 * (fr & 3);
#pragma unroll
    for (int dt = 0; dt < 4; ++dt) {
        const v4s_t a0 = __builtin_amdgcn_ds_read_tr16_b64_v4i16((LAS v4s_t*)(base + 16 * dt));
        const v4s_t a1 = __builtin_amdgcn_ds_read_tr16_b64_v4i16((LAS v4s_t*)(base + 16 * VROW + 16 * dt));
        bf16x8 vf; vf[0] = a0[0]; vf[1] = a0[1]; vf[2] = a0[2]; vf[3] = a0[3]; vf[4] = a1[0]; vf[5] = a1[1]; vf[6] = a1[2]; vf[7] = a1[3];
        st.o[dt] = st.o[dt] * alpha;
        st.o[dt] = MFMA16(vf, pf, st.o[dt]);
    }
}
__device__ __forceinline__ void attn_qk(f32x4 (&sacc)[2], const KVRegs& kv, const bf16x8 (&qf)[2]) {
#pragma unroll
    for (int t = 0; t < 2; ++t) { sacc[t] = (f32x4){0.f, 0.f, 0.f, 0.f};
#pragma unroll
        for (int ks = 0; ks < 2; ++ks) sacc[t] = MFMA16(kv.k[t][ks], qf[ks], sacc[t]); }
}

__device__ __forceinline__ void na_item(int item, const bf16_t* P, bf16_t* BR, const float* rpb  , int L, LAS unsigned char* lds) {
    const int tid = opaque_tid(), lane = tid & 63, wave = tid >> 6, fr = lane & 15, fq = lane >> 4;
    asm volatile("" : "+s"(item));
    const int rr = item, n = wave & 3, h0 = 2 * (wave >> 2);
    const int rows = L >> 6, seq = rr / rows, r = rr % rows, seqbase = seq * L;
    const int r0 = min(max(r - 4, 0), rows - 8);
    LAS bf16_t* vt[2] = {(LAS bf16_t*)(lds + (2 * wave) * VT_BYTES), (LAS bf16_t*)(lds + (2 * wave + 1) * VT_BYTES)};
    const int qtok = seqbase + r * 64 + 16 * n + fr;
    const int col0 = min(max(16 * n - 8, 0), 32), qcol = 16 * n + fr, win0 = min(max(qcol - 8, 0), 48);
    bf16x8 qf[2][2]; AttnState st[2]; KVRegs cur[2];
#pragma unroll
    for (int c = 0; c < 2; ++c) {
#pragma unroll
        for (int ks = 0; ks < 2; ++ks) qf[c][ks] = *(const bf16x8*)(P + (size_t)qtok * NIN + P_NAQ + 64 * (h0 + c) + 32 * ks + 8 * fq);
#pragma unroll
        for (int dt = 0; dt < 4; ++dt) st[c].o[dt] = (f32x4){0.f, 0.f, 0.f, 0.f};
        st[c].m = -1e30f; st[c].l = 0.f;
        const int rowtok = seqbase + r0 * 64 + col0;
        kv_load(cur[c], P, P_NAK + 64 * (h0 + c), P_NAV + 64 * (h0 + c), lane, fq, [&](int t) { return rowtok + 16 * t + fr; }, [&](int key) { return rowtok + key; });
    }
    for (int kr = 0; kr < 8; ++kr) {
        const int krow = r0 + kr;
        KVRegs nxt[2];
        { const int rowtok = seqbase + min(krow + 1, r0 + 7) * 64 + col0;
#pragma unroll
          for (int c = 0; c < 2; ++c) kv_load(nxt[c], P, P_NAK + 64 * (h0 + c), P_NAV + 64 * (h0 + c), lane, fq, [&](int t) { return rowtok + 16 * t + fr; }, [&](int key) { return rowtok + key; }); }
        float bias[2][2][4]; bool valid[2][4];
#pragma unroll
        for (int t = 0; t < 2; ++t)
#pragma unroll
            for (int g = 0; g < 4; ++g) { const int kc = col0 + 16 * t + 4 * fq + g; valid[t][g] = (kc >= win0) && (kc < win0 + 16);
                const int bi = (h0 * 15 + (krow - r + 7)) * 31 + min(max(kc - qcol + 15, 0), 30);
                bias[0][t][g] = rpb[bi]; bias[1][t][g] = rpb[bi + 15 * 31]; }
        attn_stage_v(vt[0], cur[0], lane); attn_stage_v(vt[1], cur[1], lane);
        __builtin_amdgcn_wave_barrier();
        bf16x8 pf[2]; float alpha[2];
#pragma unroll
        for (int c = 0; c < 2; ++c) {
            f32x4 sacc[2]; attn_qk(sacc, cur[c], qf[c]);
            float sc[2][4];
#pragma unroll
            for (int t = 0; t < 2; ++t)
#pragma unroll
                for (int g = 0; g < 4; ++g) sc[t][g] = valid[t][g] ? sacc[t][g] * 0.125f + bias[c][t][g] : -1e30f;
            attn_softmax(st[c], sc, valid, pf[c], alpha[c]);
        }
#pragma unroll
        for (int c = 0; c < 2; ++c) attn_pv(st[c], pf[c], alpha[c], vt[c], fr, fq);
        __builtin_amdgcn_wave_barrier();
        cur[0] = nxt[0]; cur[1] = nxt[1];
    }
#pragma unroll
    for (int c = 0; c < 2; ++c) {
        float l = st[c].l; l += __shfl_xor(l, 16); l += __shfl_xor(l, 32);
        const float inv = 1.f / l;
        bf16_t* orow = BR + (size_t)qtok * DM + 0 + 64 * (h0 + c) + 4 * fq;
#pragma unroll
        for (int dt = 0; dt < 4; ++dt) { u32x2 o; o.x = pk2(st[c].o[dt][0] * inv, st[c].o[dt][1] * inv); o.y = pk2(st[c].o[dt][2] * inv, st[c].o[dt][3] * inv); *(u32x2*)(orow + 16 * dt) = o; }
    }
}

constexpr int DL_OLD = 68;
constexpr int DL_O_OFF = 16 * VT_BYTES;
constexpr int DL_M_OFF = DL_O_OFF + 256 * DL_OLD * 4;
constexpr int DL_L_OFF = DL_M_OFF + 1024;
__device__ __forceinline__ void dl_item(int item, const bf16_t* P, bf16_t* BR, int L, LAS unsigned char* lds) {
    const int tid = opaque_tid(), lane = tid & 63, wave = tid >> 6, fr = lane & 15, fq = lane >> 4;
    asm volatile("" : "+s"(item));
    const int sp = item >> 2, h = item & 3;
    const int t0 = sp * 256, seq = t0 / L, seqbase = seq * L, p0 = t0 - seqbase;
    LAS bf16_t* vt[2] = {(LAS bf16_t*)(lds + (2 * wave) * VT_BYTES), (LAS bf16_t*)(lds + (2 * wave + 1) * VT_BYTES)};
    LAS float* OL = (LAS float*)(lds + DL_O_OFF); LAS float* ML = (LAS float*)(lds + DL_M_OFF); LAS float* LL = (LAS float*)(lds + DL_L_OFF);
    __syncthreads();
    for (int e = tid; e < 256 * DL_OLD; e += NTHR) OL[e] = 0.f;
    if (tid < 256) { ML[tid] = -1e30f; LL[tid] = 0.f; }
    __syncthreads();
    const float slope = (h == 0) ? 0.25f : (h == 1) ? 0.0625f : (h == 2) ? 0.015625f : 0.00390625f;
    const int kcol = P_DK + 64 * h, vcol = P_DV + 64 * h;
    for (int cfg = 0; cfg < 3; ++cfg) {
        const int dsh = 2 * cfg, n = L >> dsh;
        int rC[2], subC[2], j0C[2], qjC[2];
        bf16x8 qf[2][2]; AttnState st[2]; KVRegs cur[2];
#pragma unroll
        for (int c = 0; c < 2; ++c) {
            const int qt = 2 * wave + c;
            rC[c] = (cfg == 0) ? 0 : (cfg == 1) ? (qt >> 2) : qt;
            subC[c] = (cfg == 0) ? qt : (cfg == 1) ? (qt & 3) : 0;
            j0C[c] = (p0 >> dsh) + 16 * subC[c]; qjC[c] = j0C[c] + fr;
            const int qtok = seqbase + (qjC[c] << dsh) + rC[c];
#pragma unroll
            for (int ks = 0; ks < 2; ++ks) qf[c][ks] = *(const bf16x8*)(P + (size_t)qtok * NIN + P_DQ + 64 * h + 32 * ks + 8 * fq);
#pragma unroll
            for (int dt = 0; dt < 4; ++dt) st[c].o[dt] = (f32x4){0.f, 0.f, 0.f, 0.f};
            st[c].m = -1e30f; st[c].l = 0.f;
        }
        int s_lo = 0, s_hi = 5;
        while (s_lo < 4 && j0C[1] - 64 + 32 * s_lo + 32 <= 0) ++s_lo;
        while (s_hi > s_lo + 1 && j0C[0] - 64 + 32 * (s_hi - 1) >= n) --s_hi;
#pragma unroll
        for (int c = 0; c < 2; ++c) { const int kb = j0C[c] - 64 + 32 * s_lo, rr_ = rC[c];
            kv_load(cur[c], P, kcol, vcol, lane, fq, [&](int t) { const int kj = min(max(kb + 16 * t + fr, 0), n - 1); return seqbase + (kj << dsh) + rr_; },
                    [&](int key) { const int kj = min(max(kb + key, 0), n - 1); return seqbase + (kj << dsh) + rr_; }); }
        for (int sx = s_lo; sx < s_hi; ++sx) {
            KVRegs nxt[2];
#pragma unroll
            for (int c = 0; c < 2; ++c) { const int kb2 = j0C[c] - 64 + 32 * min(sx + 1, s_hi - 1), rr_ = rC[c];
                kv_load(nxt[c], P, kcol, vcol, lane, fq, [&](int t) { const int kj = min(max(kb2 + 16 * t + fr, 0), n - 1); return seqbase + (kj << dsh) + rr_; },
                        [&](int key) { const int kj = min(max(kb2 + key, 0), n - 1); return seqbase + (kj << dsh) + rr_; }); }
            attn_stage_v(vt[0], cur[0], lane); attn_stage_v(vt[1], cur[1], lane);
            __builtin_amdgcn_wave_barrier();
            bf16x8 pf[2]; float alpha[2];
#pragma unroll
            for (int c = 0; c < 2; ++c) {
                const int kb = j0C[c] - 64 + 32 * sx;
                f32x4 sacc[2]; attn_qk(sacc, cur[c], qf[c]);
                float sc[2][4]; bool valid[2][4];
#pragma unroll
                for (int t = 0; t < 2; ++t)
#pragma unroll
                    for (int g = 0; g < 4; ++g) { const int kj = kb + 16 * t + 4 * fq + g; const int dist = abs(kj - qjC[c]);
                        const bool v = (dist <= 64) && (kj >= 0) && (kj < n);
                        valid[t][g] = v; sc[t][g] = v ? sacc[t][g] * 0.125f - slope * (float)(dist << dsh) : -1e30f; }
                attn_softmax(st[c], sc, valid, pf[c], alpha[c]);
            }
#pragma unroll
            for (int c = 0; c < 2; ++c) attn_pv(st[c], pf[c], alpha[c], vt[c], fr, fq);
            __builtin_amdgcn_wave_barrier();
            cur[0] = nxt[0]; cur[1] = nxt[1];
        }
#pragma unroll
        for (int c = 0; c < 2; ++c) {
            float l = st[c].l; l += __shfl_xor(l, 16); l += __shfl_xor(l, 32);
            const int ql = ((16 * subC[c] + fr) << dsh) + rC[c];
            const float mo = ML[ql], lo = LL[ql], mn = fmaxf(mo, st[c].m), a = __expf(mo - mn), b = __expf(st[c].m - mn);
            LAS float* orow = OL + ql * DL_OLD + 4 * fq;
#pragma unroll
            for (int dt = 0; dt < 4; ++dt) { f32x4 ov = *(LAS f32x4*)(orow + 16 * dt); ov = ov * a + st[c].o[dt] * b; *(LAS f32x4*)(orow + 16 * dt) = ov; }
            __builtin_amdgcn_wave_barrier();
            if (fq == 0) { ML[ql] = mn; LL[ql] = lo * a + l * b; }
            __builtin_amdgcn_wave_barrier();
        }
        __syncthreads();
    }
    for (int e = tid; e < 256 * 8; e += NTHR) { const int ql = e >> 3, c8 = e & 7;
        const float inv = 1.f / LL[ql]; const LAS float* orow = OL + ql * DL_OLD + 8 * c8;
        const f32x4 a = *(const LAS f32x4*)orow, b = *(const LAS f32x4*)(orow + 4);
        u32x4 o; o.x = pk2(a[0] * inv, a[1] * inv); o.y = pk2(a[2] * inv, a[3] * inv); o.z = pk2(b[0] * inv, b[1] * inv); o.w = pk2(b[2] * inv, b[3] * inv);
        *(u32x4*)(BR + (size_t)(t0 + ql) * DM + 768 + 64 * h + 8 * c8) = o; }
}

constexpr int SG_WLD = 136, SG_VLD = 136;
constexpr int SG_V_OFF = 128 * SG_WLD * 2;
__device__ __forceinline__ void sg_item(int item, const bf16_t* P, bf16_t* BR, const bf16_t* sgw  , const float* ln_g, const float* ln_b, const float* sgb  , LAS unsigned char* lds) {
    const int tid = opaque_tid(), lane = tid & 63, wave = tid >> 6, fr = lane & 15, fq = lane >> 4;
    const int nc = item >> 2, g = item & 3, t0 = nc * 128;
    LAS bf16_t* WL = (LAS bf16_t*)lds; LAS bf16_t* VT = (LAS bf16_t*)(lds + SG_V_OFF);
    __syncthreads();
    for (int e = tid; e < 128 * 16; e += NTHR) { const int row = e >> 4, c8 = e & 15;
        *(LAS u32x4*)(WL + row * SG_WLD + 8 * c8) = *(const u32x4*)(sgw + ((size_t)g * 128 + row) * 128 + 8 * c8); }
    {
        const int s = tid >> 2, qd = tid & 3;
        const bf16_t* vp = P + (size_t)(t0 + s) * NIN + P_SV + 64 * qd;
        float sum = 0.f, sq = 0.f;
#pragma unroll
        for (int i = 0; i < 8; ++i) { const u32x4 w = *(const u32x4*)(vp + 8 * i);
            const unsigned ww[4] = {w.x, w.y, w.z, w.w};
#pragma unroll
            for (int j = 0; j < 4; ++j) { const float a = gelu_tanh(bflo(ww[j])), b = gelu_tanh(bfhi(ww[j])); sum += a + b; sq += a * a + b * b; } }
        sum += __shfl_xor(sum, 1); sum += __shfl_xor(sum, 2); sq += __shfl_xor(sq, 1); sq += __shfl_xor(sq, 2);
        const float mean = sum * (1.f / 256.f), var = fmaxf(sq * (1.f / 256.f) - mean * mean, 0.f), rstd = rsqrtf(var + EPSV);
        const bf16_t* gp = P + (size_t)(t0 + s) * NIN + P_SV + 64 * g + 16 * qd;
#pragma unroll
        for (int i = 0; i < 2; ++i) { const u32x4 w = *(const u32x4*)(gp + 8 * i);
            const unsigned ww[4] = {w.x, w.y, w.z, w.w};
#pragma unroll
            for (int j = 0; j < 4; ++j) {
                const int c = 16 * qd + 8 * i + 2 * j, ch = 64 * g + c;
                const float a = (gelu_tanh(bflo(ww[j])) - mean) * rstd * ln_g[ch] + ln_b[ch], b = (gelu_tanh(bfhi(ww[j])) - mean) * rstd * ln_g[ch + 1] + ln_b[ch + 1];
                VT[c * SG_VLD + s] = f2bf(a); VT[(c + 1) * SG_VLD + s] = f2bf(b); } }
    }
    __syncthreads();
    f32x4 acc[4];
#pragma unroll
    for (int ni = 0; ni < 4; ++ni) acc[ni] = (f32x4){0.f, 0.f, 0.f, 0.f};
#pragma unroll
    for (int ks = 0; ks < 4; ++ks) { const bf16x8 a = *(const LAS bf16x8*)(WL + (16 * wave + fr) * SG_WLD + 32 * ks + 8 * fq);
#pragma unroll
        for (int ni = 0; ni < 4; ++ni) { const bf16x8 b = *(const LAS bf16x8*)(VT + (16 * ni + fr) * SG_VLD + 32 * ks + 8 * fq); acc[ni] = MFMA16(a, b, acc[ni]); } }
    {
        unsigned uraw[4][4]; float bsv[4];
#pragma unroll
        for (int reg = 0; reg < 4; ++reg) { const int t = 16 * wave + 4 * fq + reg; bsv[reg] = sgb[g * 128 + t];
            const bf16_t* up = P + (size_t)(t0 + t) * NIN + P_SU + 64 * g;
#pragma unroll
            for (int ni = 0; ni < 4; ++ni) uraw[reg][ni] = up[16 * ni + fr]; }
#pragma unroll
        for (int reg = 0; reg < 4; ++reg) { const int t = 16 * wave + 4 * fq + reg;
            bf16_t* op = BR + (size_t)(t0 + t) * DM + 512 + 64 * g;
#pragma unroll
            for (int ni = 0; ni < 4; ++ni) { const float u = gelu_tanh(bf2f(uraw[reg][ni])); op[16 * ni + fr] = f2bf(u * (acc[ni][reg] + bsv[reg])); } }
    }
}

constexpr int HG_LF_OFF = 0;
constexpr int HG_T_OFF = 32768;
constexpr int HG_TLD = 72, HG_TB = 64 * HG_TLD * 2;
__device__ __forceinline__ float hg_lb(const float* hg_lb_in, int dir, int l, int ch) {
    const float* q = hg_lb_in + (size_t)dir * NLAYER * 256 + ch;
    const float a0 = q[0], a1 = q[256], a2 = q[512], a3 = q[768];
    const float mx = fmaxf(fmaxf(a0, a1), fmaxf(a2, a3));
    const float e0 = __expf(a0 - mx), e1 = __expf(a1 - mx), e2 = __expf(a2 - mx), e3 = __expf(a3 - mx);
    const float num = (l >= 1 ? e1 : 0.f) + (l >= 2 ? e2 : 0.f) + (l >= 3 ? e3 : 0.f);
    return num / (e0 + e1 + e2 + e3);
}
constexpr int HG_LB_OFF = 155648;
constexpr int HG_TOT_OFF = 157696;
__device__ __forceinline__ void hg_lb_table(const float* hg_lb_in, int l, LAS unsigned char* lds) {
    const int tid = opaque_tid();
    ((LAS float*)(lds + HG_LB_OFF))[tid] = hg_lb(hg_lb_in, (tid >> 6) & 1, l, 64 * (tid >> 7) + (tid & 63));
    __syncthreads();
}
__device__ __forceinline__ void hg_front(const u32x4 (&wf)[2], int h, LAS unsigned char* lds) {
    const int tid = opaque_tid();
    LAS float* LF = (LAS float*)(lds + HG_LF_OFF); LAS float* TOT = (LAS float*)(lds + HG_TOT_OFF); const LAS float* LBS = (const LAS float*)(lds + HG_LB_OFF) + h * 128;
    {
        const int s = tid >> 3, i0 = 8 * (tid & 7);
#pragma unroll
        for (int dir = 0; dir < 2; ++dir) {
            const unsigned ww[4] = {wf[dir].x, wf[dir].y, wf[dir].z, wf[dir].w};
#pragma unroll
            for (int j = 0; j < 4; ++j) {
                const float lb0 = LBS[dir * 64 + i0 + 2 * j], lb1 = LBS[dir * 64 + i0 + 2 * j + 1];
                const float f0 = lb0 + (1.f - lb0) * sigmoidf_(bflo(ww[j])), f1 = lb1 + (1.f - lb1) * sigmoidf_(bfhi(ww[j]));
                LF[dir * 4096 + s * 64 + i0 + 2 * j] = __logf(f0); LF[dir * 4096 + s * 64 + i0 + 2 * j + 1] = __logf(f1); }
        }
    }
    __syncthreads();
    {
        const int dir = tid >> 8, seg = (tid >> 6) & 3, i = tid & 63;
        LAS float* a = LF + dir * 4096 + i;
        float r[16]; float run = 0.f;
#pragma unroll
        for (int k = 0; k < 16; ++k) { const int sidx = dir ? (16 * seg + 15 - k) : (16 * seg + k); run += a[sidx * 64]; r[k] = run; }
        TOT[(dir * 4 + seg) * 64 + i] = run;
        __syncthreads();
        float off = 0.f;
#pragma unroll
        for (int q = 0; q < 4; ++q) { const float tq = TOT[(dir * 4 + q) * 64 + i]; off += (dir ? (q > seg) : (q < seg)) ? tq : 0.f; }
#pragma unroll
        for (int k = 0; k < 16; ++k) { const int sidx = dir ? (16 * seg + 15 - k) : (16 * seg + k); a[sidx * 64] = r[k] + off; }
    }
    __syncthreads();
}
__device__ __forceinline__ float hg_kk(LAS unsigned char* lds, int h, int dir, int i, float x) { const float lb = ((LAS float*)(lds + HG_LB_OFF))[(h * 2 + dir) * 64 + i]; return (1.f - lb) * sigmoidf_(-x); }

__device__ __forceinline__ void hgA_item(int item, const bf16_t* P, float* HGST, float* HGD, LAS unsigned char* lds) {
    const int tid = opaque_tid(), lane = tid & 63, wave = tid >> 6, fr = lane & 15, fq = lane >> 4;
    const int cc = item >> 2, h = item & 3, t0 = cc * 64;
    const int s = tid >> 3, i0 = 8 * (tid & 7);
    u32x4 wf[2];
    wf[0] = *(const u32x4*)(P + (size_t)(t0 + s) * NIN + P_FF + 64 * h + i0);
    wf[1] = *(const u32x4*)(P + (size_t)(t0 + s) * NIN + P_FB + 64 * h + i0);
    const u32x4 wv = *(const u32x4*)(P + (size_t)(t0 + s) * NIN + P_HI + 64 * h + i0);
    __syncthreads();
    hg_front(wf, h, lds);
    LAS float* LF = (LAS float*)(lds + HG_LF_OFF);
    LAS bf16_t* KD0 = (LAS bf16_t*)(lds + HG_T_OFF); LAS bf16_t* KD1 = (LAS bf16_t*)(lds + HG_T_OFF + HG_TB); LAS bf16_t* VT = (LAS bf16_t*)(lds + HG_T_OFF + 2 * HG_TB);
    {
#pragma unroll
        for (int dir = 0; dir < 2; ++dir) {
            const unsigned ww[4] = {wf[dir].x, wf[dir].y, wf[dir].z, wf[dir].w};
            LAS bf16_t* KD = dir ? KD1 : KD0; const LAS float* A = LF + dir * 4096; const int slast = dir ? 0 : 63;
#pragma unroll
            for (int j = 0; j < 8; ++j) { const int i = i0 + j; const float x = (j & 1) ? bfhi(ww[j >> 1]) : bflo(ww[j >> 1]);
                const float kd = hg_kk(lds, h, dir, i, x) * __expf(A[slast * 64 + i] - A[s * 64 + i]);
                KD[i * HG_TLD + s] = f2bf(kd); }
        }
        const unsigned ww[4] = {wv.x, wv.y, wv.z, wv.w};
#pragma unroll
        for (int j = 0; j < 8; ++j) VT[(i0 + j) * HG_TLD + s] = (bf16_t)((j & 1) ? (ww[j >> 1] >> 16) : (ww[j >> 1] & 0xffffu));
        if (tid < 128) { const int dir = tid >> 6, i = tid & 63; HGD[((size_t)(cc * 4 + h) * 2 + dir) * 64 + i] = __expf(LF[dir * 4096 + (dir ? 0 : 63) * 64 + i]); }
    }
    __syncthreads();
    {
        const int dir = wave >> 2, mt = wave & 3; const LAS bf16_t* KD = dir ? KD1 : KD0;
        f32x4 acc[4];
#pragma unroll
        for (int ni = 0; ni < 4; ++ni) acc[ni] = (f32x4){0.f, 0.f, 0.f, 0.f};
#pragma unroll
        for (int ks = 0; ks < 2; ++ks) { const bf16x8 a = *(const LAS bf16x8*)(VT + (16 * mt + fr) * HG_TLD + 32 * ks + 8 * fq);
#pragma unroll
            for (int ni = 0; ni < 4; ++ni) { const bf16x8 b = *(const LAS bf16x8*)(KD + (16 * ni + fr) * HG_TLD + 32 * ks + 8 * fq); acc[ni] = MFMA16(a, b, acc[ni]); } }
        float* dst = HGST + ((size_t)(cc * 4 + h) * 2 + dir) * 4096;
#pragma unroll
        for (int ni = 0; ni < 4; ++ni)
#pragma unroll
            for (int reg = 0; reg < 4; ++reg) dst[(16 * mt + 4 * fq + reg) * 64 + 16 * ni + fr] = acc[ni][reg];
    }
}
__device__ __forceinline__ void hgB_phase(float* HGST, const float* HGD, int L) {
    const int ncs = L >> 6, nseq = TC / L, total = nseq * 8 * 4096;
    for (int e = blockIdx.x * NTHR + opaque_tid(); e < total; e += gridDim.x * NTHR) {
        const int ji = e & 4095, dir = (e >> 12) & 1, h = (e >> 13) & 3, seq = e >> 15, i = ji & 63;
        float S = 0.f;
        for (int c0 = 0; c0 < ncs; c0 += 8) {
            float u[8], d[8];
#pragma unroll
            for (int k = 0; k < 8; ++k) { const int cc = seq * ncs + (dir ? (ncs - 1 - (c0 + k)) : (c0 + k)); const size_t o = ((size_t)(cc * 4 + h) * 2 + dir);
                u[k] = HGST[o * 4096 + ji]; d[k] = HGD[o * 64 + i]; }
#pragma unroll
            for (int k = 0; k < 8; ++k) { const int cc = seq * ncs + (dir ? (ncs - 1 - (c0 + k)) : (c0 + k)); const size_t o = ((size_t)(cc * 4 + h) * 2 + dir);
                HGST[o * 4096 + ji] = S; S = S * d[k] + u[k]; }
        }
    }
}
__device__ __forceinline__ void hgC_item(int item, const bf16_t* P, bf16_t* BR, const float* HGST, const float* gnorm  , LAS unsigned char* lds) {
    const int tid = opaque_tid(), lane = tid & 63, wave = tid >> 6, fr = lane & 15, fq = lane >> 4;
    const int cc = item >> 2, h = item & 3, t0 = cc * 64;
    const int s = tid >> 3, i0 = 8 * (tid & 7);
    u32x4 wf[2];
    wf[0] = *(const u32x4*)(P + (size_t)(t0 + s) * NIN + P_FF + 64 * h + i0);
    wf[1] = *(const u32x4*)(P + (size_t)(t0 + s) * NIN + P_FB + 64 * h + i0);
    const u32x4 wq = *(const u32x4*)(P + (size_t)(t0 + s) * NIN + P_HQ + 64 * h + i0);
    const u32x4 wv = *(const u32x4*)(P + (size_t)(t0 + s) * NIN + P_HI + 64 * h + i0);
    f32x4 stv[4];
    { const int dir = tid >> 8, j = (tid >> 2) & 63, i4 = 16 * (tid & 3);
      const float* src = HGST + ((size_t)(cc * 4 + h) * 2 + dir) * 4096 + j * 64 + i4;
#pragma unroll
      for (int q = 0; q < 4; ++q) stv[q] = *(const f32x4*)(src + 4 * q); }
    unsigned gpre[4][4];
    if (wave < 4) {
#pragma unroll
        for (int reg = 0; reg < 4; ++reg)
#pragma unroll
            for (int ni = 0; ni < 4; ++ni) gpre[reg][ni] = P[(size_t)(t0 + 16 * wave + 4 * fq + reg) * NIN + P_HGATE + 64 * h + 16 * ni + fr];
    }
    __syncthreads();
    hg_front(wf, h, lds);
    LAS float* LF = (LAS float*)(lds + HG_LF_OFF);
#define HGT(k) ((LAS bf16_t*)(lds + HG_T_OFF + (k) * HG_TB))
    {
        const unsigned wqq[4] = {wq.x, wq.y, wq.z, wq.w};
#pragma unroll
        for (int dir = 0; dir < 2; ++dir) {
            const unsigned ww[4] = {wf[dir].x, wf[dir].y, wf[dir].z, wf[dir].w};
            const LAS float* A = LF + dir * 4096;
            u32x4 oq, ok, oe; unsigned* oqp = (unsigned*)&oq; unsigned* okp = (unsigned*)&ok; unsigned* oep = (unsigned*)&oe;
#pragma unroll
            for (int j2 = 0; j2 < 4; ++j2) { float qt[2], kt[2], qe[2];
#pragma unroll
                for (int e = 0; e < 2; ++e) { const int i = i0 + 2 * j2 + e; const float x = e ? bfhi(ww[j2]) : bflo(ww[j2]); const float qs = siluf_(e ? bfhi(wqq[j2]) : bflo(wqq[j2]));
                    const float a = A[s * 64 + i], ref = A[32 * 64 + i];
                    const float d1 = fminf(fmaxf(a - ref, -80.f), 80.f);
                    qt[e] = qs * __expf(d1); kt[e] = hg_kk(lds, h, dir, i, x) * __expf(-d1); qe[e] = qs * __expf(a); }
                oqp[j2] = pk2(qt[0], qt[1]); okp[j2] = pk2(kt[0], kt[1]); oep[j2] = pk2(qe[0], qe[1]); }
            *(LAS u32x4*)(HGT(0 + dir) + s * HG_TLD + i0) = oq; *(LAS u32x4*)(HGT(2 + dir) + s * HG_TLD + i0) = ok; *(LAS u32x4*)(HGT(4 + dir) + s * HG_TLD + i0) = oe;
        }
        const unsigned ww[4] = {wv.x, wv.y, wv.z, wv.w};
        LAS bf16_t* VT = HGT(6);
#pragma unroll
        for (int j = 0; j < 8; ++j) VT[(i0 + j) * HG_TLD + s] = (bf16_t)((j & 1) ? (ww[j >> 1] >> 16) : (ww[j >> 1] & 0xffffu));
        { const int dir = tid >> 8, j = (tid >> 2) & 63, i4 = 16 * (tid & 3);
          LAS bf16_t* dstp = HGT(8 + dir) + j * HG_TLD + i4;
#pragma unroll
          for (int q = 0; q < 2; ++q) { const f32x4 a = stv[2 * q], b = stv[2 * q + 1];
              u32x4 o; o.x = pk2(a[0], a[1]); o.y = pk2(a[2], a[3]); o.z = pk2(b[0], b[1]); o.w = pk2(b[2], b[3]); *(LAS u32x4*)(dstp + 8 * q) = o; } }
    }
    __syncthreads();
    {
        const int mt = wave >> 1;
#pragma unroll
        for (int q = 0; q < 2; ++q) { const int nt = 2 * (wave & 1) + q;
            f32x4 af = (f32x4){0.f, 0.f, 0.f, 0.f}, ab = (f32x4){0.f, 0.f, 0.f, 0.f};
            if (nt <= mt) {
#pragma unroll
                for (int ks = 0; ks < 2; ++ks) af = MFMA16(*(const LAS bf16x8*)(HGT(0) + (16 * mt + fr) * HG_TLD + 32 * ks + 8 * fq), *(const LAS bf16x8*)(HGT(2) + (16 * nt + fr) * HG_TLD + 32 * ks + 8 * fq), af); }
            if (nt >= mt) {
#pragma unroll
                for (int ks = 0; ks < 2; ++ks) ab = MFMA16(*(const LAS bf16x8*)(HGT(1) + (16 * mt + fr) * HG_TLD + 32 * ks + 8 * fq), *(const LAS bf16x8*)(HGT(3) + (16 * nt + fr) * HG_TLD + 32 * ks + 8 * fq), ab); }
            const int s = 16 * nt + fr;
#pragma unroll
            for (int reg = 0; reg < 4; ++reg) { const int t = 16 * mt + 4 * fq + reg;
                const float v = ((s <= t) ? af[reg] : 0.f) + ((s >= t) ? ab[reg] : 0.f);
                HGT(7)[t * HG_TLD + s] = f2bf(v); } }
    }
    __syncthreads();
    if (wave < 4) {
        const int mt = wave;
        float gnv[4];
#pragma unroll
        for (int ni = 0; ni < 4; ++ni) gnv[ni] = gnorm[64 * h + 16 * ni + fr];
        f32x4 acc[4];
#pragma unroll
        for (int ni = 0; ni < 4; ++ni) acc[ni] = (f32x4){0.f, 0.f, 0.f, 0.f};
#pragma unroll
        for (int pr = 0; pr < 3; ++pr) { const LAS bf16_t* Am = (pr == 0) ? HGT(7) : (pr == 1) ? HGT(4) : HGT(5); const LAS bf16_t* Bm = (pr == 0) ? HGT(6) : (pr == 1) ? HGT(8) : HGT(9);
#pragma unroll
            for (int ks = 0; ks < 2; ++ks) { const bf16x8 a = *(const LAS bf16x8*)(Am + (16 * mt + fr) * HG_TLD + 32 * ks + 8 * fq);
#pragma unroll
                for (int ni = 0; ni < 4; ++ni) acc[ni] = MFMA16(a, *(const LAS bf16x8*)(Bm + (16 * ni + fr) * HG_TLD + 32 * ks + 8 * fq), acc[ni]); } }
#pragma unroll
        for (int reg = 0; reg < 4; ++reg) { const int t = 16 * mt + 4 * fq + reg;
            float ss = acc[0][reg] * acc[0][reg] + acc[1][reg] * acc[1][reg] + acc[2][reg] * acc[2][reg] + acc[3][reg] * acc[3][reg];
            ss += __shfl_xor(ss, 1); ss += __shfl_xor(ss, 2); ss += __shfl_xor(ss, 4); ss += __shfl_xor(ss, 8);
            const float rn = rsqrtf(ss * (1.f / 64.f) + EPSV);
            bf16_t* op = BR + (size_t)(t0 + t) * DM + 256 + 64 * h;
#pragma unroll
            for (int ni = 0; ni < 4; ++ni) { const int j = 16 * ni + fr; op[j] = f2bf(acc[ni][reg] * rn * gnv[ni] * siluf_(bf2f(gpre[reg][ni]))); } }
    }
#undef HGT
}

#define XB_TMO      128
#define XB_XCNT(j)  (256  + 64 * (j))
#define XB_XSUB(j)  (1280 + 64 * (j))
#define XB_XGEN(j)  (2304 + 64 * (j))
#define XB_TOP      3328
#define XB_TOPGEN   3392
#define XCD_BAR_WORDS 3456
#define XB_SPIN_CAP (1u << 22)
__device__ __forceinline__ unsigned xb_ld(unsigned* p)              { return __hip_atomic_load(p, __ATOMIC_RELAXED, __HIP_MEMORY_SCOPE_AGENT); }
__device__ __forceinline__ unsigned xb_add(unsigned* p, unsigned v) { return __hip_atomic_fetch_add(p, v, __ATOMIC_RELAXED, __HIP_MEMORY_SCOPE_AGENT); }
__device__ __forceinline__ unsigned xb_xcc_id() { return (unsigned)__builtin_amdgcn_s_getreg((3 << 11) | 20) & 0xFu; }
#define XB_SPIN(cond, bar) do { unsigned _sp = 0; while (cond) { __builtin_amdgcn_s_sleep(1); \
    if ((++_sp & 255u) == 0u) { if (xb_ld(&(bar)[XB_TMO])) break; if (_sp > XB_SPIN_CAP) { atomicAdd(&(bar)[XB_TMO], 1u); break; } } } } while (0)
struct XcdBarrier { unsigned* bar; unsigned x; volatile LAS unsigned* st; };
__device__ __forceinline__ XcdBarrier xcd_barrier_post(unsigned* bar, volatile LAS unsigned* st) {
    XcdBarrier b; b.bar = bar; b.x = xb_xcc_id(); b.st = st;
    if (threadIdx.x == 0) (void)xb_add(&bar[XB_XCNT(b.x)], 1u);
    return b;
}
__device__ __forceinline__ void xcd_barrier_complete(unsigned* bar, unsigned x, unsigned& nloc, unsigned& nx) {
    const unsigned G = gridDim.x * gridDim.y * gridDim.z;
    unsigned sum, cnt, mine, sp = 0u;
    for (;;) {
        sum = 0u; cnt = 0u; mine = 0u;
#pragma unroll
        for (unsigned j = 0; j < 16; ++j) { const unsigned c = xb_ld(&bar[XB_XCNT(j)]); sum += c; cnt += (c > 0u) ? 1u : 0u; mine = (j == x) ? c : mine; }
        if (sum == G) break;
        __builtin_amdgcn_s_sleep(1);
        if ((++sp & 255u) == 0u) { if (xb_ld(&bar[XB_TMO])) break; if (sp > XB_SPIN_CAP) { atomicAdd(&bar[XB_TMO], 1u); break; } }
    }
    nloc = mine > 0u ? mine : 1u; nx = cnt > 0u ? cnt : 1u;
}
__device__ __forceinline__ void xcd_barrier(unsigned* bar_in, volatile LAS unsigned* st_in) {
    XcdBarrier b; b.bar = bar_in; b.st = st_in; b.x = xb_xcc_id();
    asm volatile("s_waitcnt vmcnt(0)" ::: "memory");
    __syncthreads();
    if (threadIdx.x == 0) {
        unsigned* bar = b.bar;
        __builtin_amdgcn_s_waitcnt(0);
        unsigned nloc = b.st[0], nx = b.st[1];
        if (nloc == 0u) { xcd_barrier_complete(bar, b.x, nloc, nx); b.st[0] = nloc; b.st[1] = nx; }
        const unsigned old = xb_add(&bar[XB_XSUB(b.x)], 1u);
        const unsigned gen = old / nloc;
        if (old + 1u == (gen + 1u) * nloc) {
            __builtin_amdgcn_fence(__ATOMIC_RELEASE, "agent");
            asm volatile("s_waitcnt vmcnt(0)" ::: "memory");
            const unsigned og = xb_add(&bar[XB_TOP], 1u);
            const unsigned tg = og / nx;
            if (og + 1u == (tg + 1u) * nx) xb_add(&bar[XB_TOPGEN], 1u);
            else XB_SPIN(xb_ld(&bar[XB_TOPGEN]) == tg, bar);
            __builtin_amdgcn_fence(__ATOMIC_ACQUIRE, "agent");
            xb_add(&bar[XB_XGEN(b.x)], 1u);
            asm volatile("s_waitcnt vmcnt(0)" ::: "memory");
        } else {
            XB_SPIN(xb_ld(&bar[XB_XGEN(b.x)]) == gen, bar);
            __builtin_amdgcn_fence(__ATOMIC_ACQUIRE, "agent");
            asm volatile("s_waitcnt vmcnt(0)" ::: "memory");
        }
    }
    __syncthreads();
}

#define GRID_SYNC() xcd_barrier((unsigned*)(p.ws + OFF_CTL), (volatile LAS unsigned*)(lds + LDS_BYTES - 16))
#ifndef REP_DL
#define REP_DL 1
#endif
#ifndef REP_HGA
#define REP_HGA 1
#endif
#ifndef REP_NA
#define REP_NA 1
#endif
#ifndef REP_SG
#define REP_SG 1
#endif
#ifndef REP_HGC
#define REP_HGC 1
#endif
#define REP_A (REP_DL > REP_HGA ? REP_DL : REP_HGA)
#define REP_B (REP_NA > REP_SG ? REP_NA : REP_SG)
#ifndef MIXREP
#define MIXREP 1
#endif

__global__ void __launch_bounds__(512, 2) fwd_megakernel(Params p) {
    extern __shared__ __attribute__((aligned(16))) unsigned char smem[];
    LAS unsigned char* lds = (LAS unsigned char*)smem;
    cg::grid_group grid = cg::this_grid();
    unsigned char* ws = p.ws;
    const int G = gridDim.x, c = blockIdx.x;
    float* MOD = (float*)(ws + OFF_MOD);
    bf16_t* H = (bf16_t*)(ws + OFF_H); bf16_t* P = (bf16_t*)(ws + OFF_P); bf16_t* BR = (bf16_t*)(ws + OFF_BR); bf16_t* MG = (bf16_t*)(ws + OFF_MG);
    bf16_t* ACT = P;
    float* HGST = (float*)(ws + OFF_HGST); float* HGD = (float*)(ws + OFF_HGD);

    volatile LAS unsigned* xst = (volatile LAS unsigned*)(lds + LDS_BYTES - 16);
    if (threadIdx.x == 0) { xst[0] = 0u; xst[1] = 0u; }
    __syncthreads();
    (void)xcd_barrier_post((unsigned*)(ws + OFF_CTL), xst);
#ifndef SKIP_PRO
    phase_prologue(p, lds);
#endif
    grid.sync();
    phase_mod_reduce(p);
    GRID_SYNC();

    for (int ck = 0; ck < NCHUNK; ++ck) {
        const int L = chunk_L(ck), bbase = chunk_bbase(ck);
        float* X = p.out + (size_t)ck * TC * DM;
        const float* xin = (ck < 2) ? p.in[0] + (size_t)ck * TC * DM : p.in[1];
        for (int l = 0; l < NLAYER; ++l) {
            const float* modl = MOD + (size_t)l * 6144;
            phase_norm_mod(l == 0 ? xin : X, l == 0 ? X : nullptr, H, p.in[6] + l * DM, modl + 0, modl + 1024, L, bbase);
            GRID_SYNC();
#ifndef SKIP_G1
            { SchedStd S; S.to.init(TC / 256, (G == 256) ? NIN / 256 - 1 : NIN / 256, G, c); S.skip_pn = (G == 256) ? (P_HGATE / 256) : 1000; S.A = (const char*)H; S.B = (const char*)(ws + OFF_WIN) + (size_t)l * NIN * DM * 2; S.atile = 256 * DM * 2; S.btile = 256 * DM * 2; S.nt = DM / 64;
              EpiProj E; E.O = P; E.ldc = NIN;
              pg8::gemm_phase(lds, DM, DM, S, E); }
            #endif
            GRID_SYNC();
            for (int rep = 0; rep < MIXREP; ++rep) {
#ifndef SKIP_MIX1
            hg_lb_table(p.in[14], l, lds);
            for (int rr_ = 0; rr_ < REP_A; ++rr_)
            for (int it = c; it < 256 + 1024; it += G) {
                if (it >= 256 && rr_ >= REP_HGA) continue;
                if (it < 256 && rr_ >= REP_DL) continue;
                if (it < 256) { int item = it;
                    if (G == 256) { const int x = it & 7, y = it >> 3, spans = L >> 8, q = x + 8 * (y / spans), span = y % spans;
                        item = (((q >> 2) * spans + span) << 2) | (q & 3); }
                    dl_item(item, P, BR, L, lds); }
                else hgA_item(it - 256, P, HGST, HGD, lds);
            }
            #endif
            GRID_SYNC();
#ifndef SKIP_MIX2
            hgB_phase(HGST, HGD, L);
            if (G == 256) {
                __syncthreads(); na_item((c & 7) * 32 + (c >> 3), P, BR, p.in[13] + (size_t)l * 4 * 15 * 31, L, lds);
                const int y = c >> 3, x = c & 7;
                if ((y & 3) == 0) {
                    __syncthreads();
                    SchedOne S; S.pm = (y >> 2) * 8 + x; S.pn = P_HGATE / 256; S.nt = DM / 64;
                    S.A = (const char*)H + (size_t)S.pm * (256 * DM * 2); S.B = (const char*)(ws + OFF_WIN) + ((size_t)l * NIN + P_HGATE) * DM * 2;
                    EpiProj E; E.O = P; E.ldc = NIN;
                    pg8::gemm_phase(lds, DM, DM, S, E);
                } else {
                    const int rank = (y - (y >> 2) - 1) * 8 + x;
                    for (int it = rank; it < 512; it += 192)
                        sg_item(it, P, BR, (const bf16_t*)(ws + OFF_SGW) + (size_t)l * 4 * 128 * 128, p.in[16] + l * 256, p.in[17] + l * 256, p.in[19] + l * 512, lds);
                }
            } else {
                for (int it = c; it < 256 + 512; it += G) {
                    if (it < 256) { __syncthreads(); na_item(it, P, BR, p.in[13] + (size_t)l * 4 * 15 * 31, L, lds); }
                    else sg_item(it - 256, P, BR, (const bf16_t*)(ws + OFF_SGW) + (size_t)l * 4 * 128 * 128, p.in[16] + l * 256, p.in[17] + l * 256, p.in[19] + l * 512, lds);
                }
            }
            #endif
            GRID_SYNC();
#ifndef SKIP_MIX3
            hg_lb_table(p.in[14], l, lds);
            for (int rr_ = 0; rr_ < REP_HGC; ++rr_)
            for (int it = c; it < 1024; it += G) hgC_item(it, P, BR, HGST, p.in[15] + l * 256, lds);
            #endif
            GRID_SYNC();
            }
#ifndef SKIP_MERGE
            { SchedMerge S; S.to.init(TC / 256, DM / 256, G, c); S.H = (const char*)H; S.BR = (const char*)BR; S.WG = (const char*)(ws + OFF_WG) + (size_t)l * 4 * DM * DM * 2; S.WB = (const char*)(ws + OFF_WB) + (size_t)l * DM * DM * 2;
              EpiMerge E; E.MG = MG; E.bgate = p.in[10] + (size_t)l * 4 * DM; E.scr = (unsigned char*)P + (size_t)c * MERGE_SCR_PER_BLOCK;
              pg8::gemm_phase(lds, DM, DM, S, E); }
            #endif
            GRID_SYNC();
#ifndef SKIP_WO
            { SchedStd S; S.to.init(TC / 256, DM / 256, G, c); S.skip_pn = 1000; S.A = (const char*)MG; S.B = (const char*)(ws + OFF_WO) + (size_t)l * DM * DM * 2; S.atile = 256 * DM * 2; S.btile = 256 * DM * 2; S.nt = DM / 64;
              EpiRes E; E.X = X; E.gm = modl + 2048; E.L = L; E.bbase = bbase;
              pg8::gemm_phase(lds, DM, DM, S, E); }
            #endif
            GRID_SYNC();
            phase_norm_mod(X, nullptr, H, p.in[7] + l * DM, modl + 3072, modl + 4096, L, bbase);
            GRID_SYNC();
#ifndef SKIP_F1
            { SchedStd S; S.to.init(TC / 256, 2 * DFF / 256, G, c); S.skip_pn = 1000; S.A = (const char*)H; S.B = (const char*)(ws + OFF_WGU) + (size_t)l * 2 * DFF * DM * 2; S.atile = 256 * DM * 2; S.btile = 256 * DM * 2; S.nt = DM / 64;
              EpiAct E; E.O = ACT;
              pg8::gemm_phase(lds, DM, DM, S, E); }
            #endif
            GRID_SYNC();
#ifndef SKIP_F2
            { SchedStd S; S.to.init(TC / 256, DM / 256, G, c); S.skip_pn = 1000; S.A = (const char*)ACT; S.B = (const char*)(ws + OFF_WD) + (size_t)l * DM * DFF * 2; S.atile = (size_t)256 * DFF * 2; S.btile = (size_t)256 * DFF * 2; S.nt = DFF / 64;
              EpiRes E; E.X = X; E.gm = modl + 5120; E.L = L; E.bbase = bbase;
              pg8::gemm_phase(lds, DFF, DFF, S, E); }
            #endif
            GRID_SYNC();
        }
        phase_final_norm(X, p.in[23]);
    }
}

extern "C" void kernel_launch(void* const* d_in, const int* in_sizes, int n_in, void* d_out, int out_size, void* d_ws, size_t ws_size, hipStream_t stream) {
    static int grid = 0;
    if (grid == 0) {
        if (n_in != 24 || ws_size < WS_END) { fprintf(stderr, "kernel_launch: unexpected n_in %d or ws_size %zu (need %zu)\n", n_in, ws_size, (size_t)WS_END); grid = -1; return; }
        int dev = 0, cus = 0, per_cu = 0;
        hipGetDevice(&dev);
        hipDeviceGetAttribute(&cus, hipDeviceAttributeMultiprocessorCount, dev);
        if (hipFuncSetAttribute((const void*)fwd_megakernel, hipFuncAttributeMaxDynamicSharedMemorySize, LDS_BYTES) != hipSuccess) { fprintf(stderr, "kernel_launch: hipFuncSetAttribute failed\n"); grid = -1; return; }
        hipOccupancyMaxActiveBlocksPerMultiprocessor(&per_cu, (const void*)fwd_megakernel, NTHR, LDS_BYTES);
        if (per_cu < 1) { fprintf(stderr, "kernel_launch: occupancy query says %d blocks per CU\n", per_cu); per_cu = 1; }
        (void)hipGetLastError();
        grid = cus;
        if (grid > 272) grid = 272;
    }
    if (grid < 0) return;
    if (hipMemsetAsync((char*)d_ws + OFF_CTL, 0, 16384, stream) != hipSuccess) { fprintf(stderr, "kernel_launch: memset of control words failed\n"); return; }
    Params p{};
    for (int i = 0; i < 24; ++i) p.in[i] = (const float*)d_in[i];
    p.out = (float*)d_out; p.ws = (unsigned char*)d_ws;
    void* args[] = {&p};
    hipError_t e = hipLaunchCooperativeKernel((const void*)fwd_megakernel, dim3(grid), dim3(NTHR), args, LDS_BYTES, stream);
    if (e != hipSuccess) fprintf(stderr, "cooperative launch failed: %s (grid %d)\n", hipGetErrorString(e), grid);
}
```

```cpp
#include <hip/hip_runtime.h>
#include <hip/hip_cooperative_groups.h>
#include <cstdio>
#include <cstdint>
namespace cg = cooperative_groups;

#define LAS __attribute__((address_space(3)))
typedef unsigned short bf16_t;
typedef short bf16x8 __attribute__((ext_vector_type(8)));
typedef float f32x4 __attribute__((ext_vector_type(4)));
typedef unsigned u32x4 __attribute__((ext_vector_type(4)));
typedef unsigned u32x2 __attribute__((ext_vector_type(2)));

constexpr int DM = 1024, TC = 16384, NCHUNK = 3, NIN = 3328, DFF = 2816, NLAYER = 4, NB = 20;
constexpr int P_NAQ = 0, P_NAK = 256, P_NAV = 512, P_FF = 768, P_FB = 1024, P_HQ = 1280, P_HI = 1536, P_HGATE = 1792, P_SU = 2048, P_SV = 2304, P_DQ = 2560, P_DK = 2816, P_DV = 3072;
constexpr float EPSV = 1e-6f;
constexpr int LDS_BYTES = 163840;
constexpr int NTHR = 512;

constexpr size_t OFF_CTL = 0;
constexpr size_t OFF_MOD = 16384;
constexpr size_t SZ_MOD = (size_t)NB * NLAYER * 6144 * 4;
constexpr size_t OFF_MODP = OFF_MOD + SZ_MOD;
constexpr size_t OFF_WIN = OFF_MODP + 8 * SZ_MOD;
constexpr size_t OFF_WG = OFF_WIN + (size_t)NLAYER * NIN * DM * 2;
constexpr size_t OFF_WB = OFF_WG + (size_t)NLAYER * 4 * DM * DM * 2;
constexpr size_t OFF_WO = OFF_WB + (size_t)NLAYER * DM * DM * 2;
constexpr size_t OFF_WGU = OFF_WO + (size_t)NLAYER * DM * DM * 2;
constexpr size_t OFF_WD = OFF_WGU + (size_t)NLAYER * 2 * DFF * DM * 2;
constexpr size_t OFF_SGW = OFF_WD + (size_t)NLAYER * DM * DFF * 2;
constexpr size_t OFF_H = OFF_SGW + (size_t)NLAYER * 4 * 128 * 128 * 2;
constexpr size_t OFF_P = OFF_H + (size_t)TC * DM * 2;
constexpr size_t OFF_BR = OFF_P + (size_t)TC * NIN * 2;
constexpr size_t OFF_MG = OFF_BR + (size_t)TC * DM * 2;
constexpr size_t OFF_HGST = OFF_MG + (size_t)TC * DM * 2;
constexpr size_t OFF_HGD = OFF_HGST + (size_t)256 * 8 * 4096 * 4;
constexpr size_t WS_END = OFF_HGD + (size_t)256 * 8 * 64 * 4;
constexpr size_t MERGE_SCR_PER_BLOCK = 131072 + 131072;

struct Params {
    const float* in[24];
    float* out;
    unsigned char* ws;
};

__device__ __forceinline__ unsigned pk2(float lo, float hi) { unsigned r; asm("v_cvt_pk_bf16_f32 %0, %1, %2" : "=v"(r) : "v"(lo), "v"(hi)); return r; }
__device__ __forceinline__ bf16_t f2bf(float f) { return (bf16_t)(pk2(f, 0.f) & 0xffffu); }
__device__ __forceinline__ float bf2f(unsigned b) { return __uint_as_float(b << 16); }
__device__ __forceinline__ float bflo(unsigned w) { return __uint_as_float(w << 16); }
__device__ __forceinline__ float bfhi(unsigned w) { return __uint_as_float(w & 0xffff0000u); }
__device__ __forceinline__ float sigmoidf_(float x) { return 1.f / (1.f + __expf(-x)); }
__device__ __forceinline__ float siluf_(float x) { return x * sigmoidf_(x); }
__device__ __forceinline__ float gelu_tanh(float x) { return x * sigmoidf_(1.5957691216f * (x + 0.044715f * x * x * x)); }
__device__ __forceinline__ float wave_sum(float v) {
#pragma unroll
    for (int o = 1; o < 64; o <<= 1) v += __shfl_xor(v, o);
    return v;
}
__device__ __forceinline__ int opaque_tid() { int t = threadIdx.x; asm volatile("" : "+v"(t)); return t; }
#define MFMA16(a, b, c) __builtin_amdgcn_mfma_f32_16x16x32_bf16((a), (b), (c), 0, 0, 0)

__device__ __forceinline__ int chunk_L(int ck) { return ck < 2 ? 2048 : 4096; }
__device__ __forceinline__ int chunk_bbase(int ck) { return ck * 8; }

namespace pg8 {
constexpr int BM = 256, BK = 64, HALF = 128, HTB = HALF * BK * 2, STAGE_BYTES = 8 * HTB, NXCD = 8, WGM = 8;
__host__ __device__ __forceinline__ int lds_byte(int r, int c) { const int st = (r >> 4) * 2 + (c >> 5), rr = r & 15, cc = c & 31, ob = rr * 64 + cc * 2; return st * 1024 + (ob ^ (((ob >> 9) & 1) << 5)); }
__host__ __device__ __forceinline__ void stage_rc(int b, int& R, int& C) { const int st = b / 1024, sb = b % 1024, swz = sb ^ (((sb >> 9) & 1) << 5); R = (st >> 1) * 16 + swz / 64; C = (st & 1) * 32 + (swz % 64) / 2; }
__host__ __device__ __forceinline__ int perm32(int rho) { const int n = rho >> 4, i = rho & 15; return 8 * (i >> 2) + 4 * n + (i & 3); }

struct Unit { const char* a; const char* b; int nt; int pm, pn, kind; };

struct TileOrder {
    int nM, nN, nwg, G, c;
    __device__ __forceinline__ void init(int nM_, int nN_, int G_, int c_) { nM = nM_; nN = nN_; nwg = nM * nN; G = G_; c = c_; }
    __device__ __forceinline__ bool tile(int i, int& pm, int& pn) const {
        const long L = (long)i * G + c; if (L >= nwg) return false;
        int wgid = (int)L; { const int q = nwg / NXCD, r = nwg % NXCD, xcd = wgid % NXCD, off = wgid / NXCD; wgid = (xcd < r ? xcd * (q + 1) : r * (q + 1) + (xcd - r) * q) + off; }
        const int nig = WGM * nN, gid = wgid / nig, fm = gid * WGM, gsz = (nM - fm) < WGM ? (nM - fm) : WGM;
        pm = fm + ((wgid % nig) % gsz); pn = (wgid % nig) / gsz; return true;
    }
};

template <class Epi, class Sched>
__device__ __forceinline__ void gemm_phase(LAS unsigned char* lds, const int lda, const int ldb, const Sched& S, const Epi& E) {
    const int tid = opaque_tid(), wid = __builtin_amdgcn_readfirstlane(tid >> 6), lane = tid & 63, wr = wid >> 2, wc = wid & 3, fr = lane & 15, fq = lane >> 4;
    unsigned voffA[2], voffB[2];
#pragma unroll
    for (int i = 0; i < 2; ++i) { int R, C; stage_rc(tid * 16 + i * 8192, R, C); const int Rb = Epi::PERM ? ((R & ~31) + perm32(R & 31)) : R;
        voffA[i] = (unsigned)(R * lda + C) * 2u; voffB[i] = (unsigned)(Rb * ldb + C) * 2u; }
    const size_t kstep = (size_t)(BK * 2);
    const size_t hstepA = (size_t)HALF * lda * 2, hstepB = (size_t)HALF * ldb * 2;
    const unsigned ldsw = (unsigned)wid * 1024u;
    const int aoff = lds_byte(wr * 64 + fr, fq * 8), boff = lds_byte(wc * 32 + fr, fq * 8);
#define PG8_SA(b, h) (((b) * 2 + (h)) * HTB)
#define PG8_SB(b, h) ((4 + (b) * 2 + (h)) * HTB)
#define PG8_STAGE(bufoff, gbase, voff) do { _Pragma("unroll") for (int _i = 0; _i < 2; ++_i) \
        __builtin_amdgcn_global_load_lds((const unsigned*)((const char*)(gbase) + (voff)[_i]), (LAS unsigned*)(lds + (bufoff) + ldsw + _i * 8192), 16, 0, 0); } while (0)
#define PG8_LDA(dst, b, h) do { _Pragma("unroll") for (int m = 0; m < 4; ++m) _Pragma("unroll") for (int k = 0; k < 2; ++k) dst[m][k] = *(const LAS bf16x8*)(lds + PG8_SA(b, h) + aoff + m * 2048 + k * 1024); } while (0)
#define PG8_LDB(dst, b, h) do { _Pragma("unroll") for (int n = 0; n < 2; ++n) _Pragma("unroll") for (int k = 0; k < 2; ++k) dst[n][k] = *(const LAS bf16x8*)(lds + PG8_SB(b, h) + boff + n * 2048 + k * 1024); } while (0)
#define PG8_MMA(ai, bj, At, Bt) do { __builtin_amdgcn_s_setprio(1); _Pragma("unroll") for (int m = 0; m < 4; ++m) _Pragma("unroll") for (int n = 0; n < 2; ++n) _Pragma("unroll") for (int k = 0; k < 2; ++k) \
        acc[ai][bj][m][n] = __builtin_amdgcn_mfma_f32_16x16x32_bf16(Bt[n][k], At[m][k], acc[ai][bj][m][n], 0, 0, 0); __builtin_amdgcn_s_setprio(0); } while (0)
#define PG8_WAIT_V(n) asm volatile("s_waitcnt vmcnt(" #n ")" ::: "memory")
#define PG8_WAIT_L(n) asm volatile("s_waitcnt lgkmcnt(" #n ")" ::: "memory")
#define PG8_BAR __builtin_amdgcn_s_barrier()
#define PG8_SCHED __builtin_amdgcn_sched_barrier(0)
    Unit cur, nxt; int ui = 0;
    if (!S.next(0, cur)) return;
    f32x4 acc[2][2][4][2];
#pragma unroll
    for (int a = 0; a < 2; ++a)
#pragma unroll
        for (int b = 0; b < 2; ++b)
#pragma unroll
            for (int m = 0; m < 4; ++m)
#pragma unroll
                for (int n = 0; n < 2; ++n) acc[a][b][m][n] = (f32x4){0.f, 0.f, 0.f, 0.f};
    bf16x8 At[4][2], B0[2][2], B1[2][2];
    const char* cA = cur.a; const char* cB = cur.b;
    PG8_STAGE(PG8_SB(0, 0), cB, voffB); PG8_STAGE(PG8_SA(0, 0), cA, voffA); PG8_STAGE(PG8_SB(0, 1), cB + hstepB, voffB); PG8_STAGE(PG8_SA(0, 1), cA + hstepA, voffA);
    if (wr == 1) PG8_BAR;
    PG8_WAIT_V(4); PG8_BAR;
    PG8_STAGE(PG8_SB(1, 0), cB + kstep, voffB); PG8_STAGE(PG8_SA(1, 0), cA + kstep, voffA); PG8_STAGE(PG8_SB(1, 1), cB + hstepB + kstep, voffB);
    PG8_WAIT_V(6); PG8_BAR;
    for (;;) {
        const bool has_next = S.next(ui + 1, nxt);
        const char* nA = has_next ? nxt.a : cA; const char* nB = has_next ? nxt.b : cB;
        const int nt = cur.nt;
        for (int t = 0; t < nt; t += 2) {
            const bool last = (t == nt - 2);
            const char* a1 = cA + (size_t)(t + 1) * kstep;
            const char* a2 = last ? nA : cA + (size_t)(t + 2) * kstep; const char* b2 = last ? nB : cB + (size_t)(t + 2) * kstep;
            const char* a3 = a2 + kstep; const char* b3 = b2 + kstep;
            PG8_LDB(B0, 0, 0); PG8_SCHED; PG8_LDA(At, 0, 0); PG8_STAGE(PG8_SA(1, 1), a1 + hstepA, voffA);
            PG8_WAIT_L(8); PG8_BAR; PG8_WAIT_L(0); PG8_MMA(0, 0, At, B0); PG8_BAR; PG8_SCHED;
            PG8_LDB(B1, 0, 1); PG8_STAGE(PG8_SB(0, 0), b2, voffB);
            PG8_BAR; PG8_WAIT_L(0); PG8_MMA(0, 1, At, B1); PG8_BAR;
            PG8_LDA(At, 0, 1); PG8_STAGE(PG8_SA(0, 0), a2, voffA);
            PG8_BAR; PG8_WAIT_L(0); PG8_MMA(1, 0, At, B0); PG8_BAR; PG8_SCHED;
            PG8_STAGE(PG8_SB(0, 1), b2 + hstepB, voffB);
            PG8_WAIT_V(6); PG8_BAR; PG8_MMA(1, 1, At, B1); PG8_BAR;
            PG8_LDB(B0, 1, 0); PG8_SCHED; PG8_LDA(At, 1, 0); PG8_STAGE(PG8_SA(0, 1), a2 + hstepA, voffA);
            PG8_WAIT_L(8); PG8_BAR; PG8_WAIT_L(0); PG8_MMA(0, 0, At, B0); PG8_BAR; PG8_SCHED;
            PG8_LDB(B1, 1, 1); PG8_STAGE(PG8_SB(1, 0), b3, voffB);
            PG8_BAR; PG8_WAIT_L(0); PG8_MMA(0, 1, At, B1); PG8_BAR;
            PG8_LDA(At, 1, 1); PG8_STAGE(PG8_SA(1, 0), a3, voffA);
            PG8_BAR; PG8_WAIT_L(0); PG8_MMA(1, 0, At, B0); PG8_BAR; PG8_SCHED;
            PG8_STAGE(PG8_SB(1, 1), b3 + hstepB, voffB);
            PG8_WAIT_V(6); PG8_BAR; PG8_MMA(1, 1, At, B1); PG8_BAR;
        }
        E(acc, cur, wr, wc, fr, fq);
        if (!has_next) break;
#pragma unroll
        for (int a = 0; a < 2; ++a)
#pragma unroll
            for (int b = 0; b < 2; ++b)
#pragma unroll
                for (int m = 0; m < 4; ++m)
#pragma unroll
                    for (int n = 0; n < 2; ++n) acc[a][b][m][n] = (f32x4){0.f, 0.f, 0.f, 0.f};
        cur = nxt; cA = nA; cB = nB; ++ui;
    }
    PG8_WAIT_V(0);
    if (wr == 0) PG8_BAR;
    PG8_BAR;
#undef PG8_SA
#undef PG8_SB
#undef PG8_STAGE
#undef PG8_LDA
#undef PG8_LDB
#undef PG8_MMA
#undef PG8_WAIT_V
#undef PG8_WAIT_L
#undef PG8_BAR
#undef PG8_SCHED
}
}
using pg8::Unit;

struct SchedStd {
    pg8::TileOrder to; const char* A; const char* B; size_t atile, btile; int nt; int skip_pn;
    __device__ __forceinline__ bool next(int i, Unit& u) const {
        int pm, pn; if (!to.tile(i, pm, pn)) return false;
        pn += (pn >= skip_pn) ? 1 : 0;
        u.pm = pm; u.pn = pn; u.kind = 0; u.nt = nt; u.a = A + (size_t)pm * atile; u.b = B + (size_t)pn * btile; return true;
    }
};
struct SchedOne {
    const char* A; const char* B; int nt, pm, pn;
    __device__ __forceinline__ bool next(int i, Unit& u) const { if (i > 0) return false; u.pm = pm; u.pn = pn; u.kind = 0; u.nt = nt; u.a = A; u.b = B; return true; }
};
struct SchedMerge {
    pg8::TileOrder to; const char* H; const char* BR; const char* WG; const char* WB;
    __device__ __forceinline__ bool next(int i, Unit& u) const {
        int pm, pn; if (!to.tile(i >> 3, pm, pn)) return false;
        const int sub = i & 7, bi = sub >> 1;
        u.pm = pm; u.pn = pn; u.kind = sub;
        if (sub & 1) { u.nt = 16; u.a = H + (size_t)pm * (256 * DM * 2); u.b = WG + (size_t)bi * (DM * DM * 2) + (size_t)pn * (256 * DM * 2); }
        else { u.nt = 4; u.a = BR + (size_t)pm * (256 * DM * 2) + bi * 512; u.b = WB + (size_t)pn * (256 * DM * 2) + bi * 512; }
        return true;
    }
};

struct EpiProj {
    static constexpr bool PERM = true;
    bf16_t* O; int ldc;
    __device__ __forceinline__ void operator()(const f32x4 (&acc)[2][2][4][2], const Unit& u, int wr, int wc, int fr, int fq) const {
        const int row0 = u.pm * 256 + wr * 64 + fr, col0 = u.pn * 256 + wc * 32 + 8 * fq;
#pragma unroll
        for (int ai = 0; ai < 2; ++ai)
#pragma unroll
            for (int m = 0; m < 4; ++m) { bf16_t* rowp = O + (size_t)(row0 + ai * 128 + m * 16) * ldc + col0;
#pragma unroll
                for (int bj = 0; bj < 2; ++bj) { const f32x4 v0 = acc[ai][bj][m][0], v1 = acc[ai][bj][m][1];
                    u32x4 o; o.x = pk2(v0[0], v0[1]); o.y = pk2(v0[2], v0[3]); o.z = pk2(v1[0], v1[1]); o.w = pk2(v1[2], v1[3]);
                    *(u32x4*)(rowp + bj * 128) = o; } }
    }
};
struct EpiAct {
    static constexpr bool PERM = true;
    bf16_t* O;
    __device__ __forceinline__ void operator()(const f32x4 (&acc)[2][2][4][2], const Unit& u, int wr, int wc, int fr, int fq) const {
        const int row0 = u.pm * 256 + wr * 64 + fr, col0 = u.pn * 128 + wc * 32 + 8 * fq;
#pragma unroll
        for (int ai = 0; ai < 2; ++ai)
#pragma unroll
            for (int m = 0; m < 4; ++m) { bf16_t* rowp = O + (size_t)(row0 + ai * 128 + m * 16) * DFF + col0;
                float r[8];
#pragma unroll
                for (int n = 0; n < 2; ++n)
#pragma unroll
                    for (int j = 0; j < 4; ++j) { const float g = acc[ai][0][m][n][j], up = acc[ai][1][m][n][j]; r[n * 4 + j] = siluf_(g) * up; }
                u32x4 o; o.x = pk2(r[0], r[1]); o.y = pk2(r[2], r[3]); o.z = pk2(r[4], r[5]); o.w = pk2(r[6], r[7]);
                *(u32x4*)rowp = o; }
    }
};
struct EpiRes {
    static constexpr bool PERM = false;
    float* X; const float* gm; int L; int bbase;
    __device__ __forceinline__ void operator()(const f32x4 (&acc)[2][2][4][2], const Unit& u, int wr, int wc, int fr, int fq) const {
        const int row0 = u.pm * 256 + wr * 64 + fr, col0 = u.pn * 256 + wc * 32 + 4 * fq;
        const int b = bbase + (u.pm * 256) / L;
        const float* g = gm + (size_t)b * (NLAYER * 6144) + col0;
        f32x4 gv[2][2];
#pragma unroll
        for (int bj = 0; bj < 2; ++bj)
#pragma unroll
            for (int n = 0; n < 2; ++n) gv[bj][n] = *(const f32x4*)(g + bj * 128 + n * 16);
#pragma unroll
        for (int ai = 0; ai < 2; ++ai)
#pragma unroll
            for (int mh = 0; mh < 2; ++mh) {
                f32x4 xv[2][2][2];
#pragma unroll
                for (int mm = 0; mm < 2; ++mm) { const float* rowp = X + (size_t)(row0 + ai * 128 + (2 * mh + mm) * 16) * DM + col0;
#pragma unroll
                    for (int bj = 0; bj < 2; ++bj)
#pragma unroll
                        for (int n = 0; n < 2; ++n) xv[mm][bj][n] = *(const f32x4*)(rowp + bj * 128 + n * 16); }
#pragma unroll
                for (int mm = 0; mm < 2; ++mm) { float* rowp = X + (size_t)(row0 + ai * 128 + (2 * mh + mm) * 16) * DM + col0;
#pragma unroll
                    for (int bj = 0; bj < 2; ++bj)
#pragma unroll
                        for (int n = 0; n < 2; ++n) *(f32x4*)(rowp + bj * 128 + n * 16) = xv[mm][bj][n] + gv[bj][n] * acc[ai][bj][2 * mh + mm][n]; }
            }
    }
};
struct EpiMerge {
    static constexpr bool PERM = true;
    bf16_t* MG; const float* bgate;
    unsigned char* scr;
    __device__ __forceinline__ void operator()(const f32x4 (&acc)[2][2][4][2], const Unit& u, int wr, int wc, int fr, int fq) const {
        const int tid = threadIdx.x, bi = u.kind >> 1;
        unsigned char* pbp = scr + tid * 16;
        asm volatile("" : "+v"(pbp));
        if ((u.kind & 1) == 0) {
#pragma unroll
            for (int bj = 0; bj < 2; ++bj)
#pragma unroll
                for (int ai = 0; ai < 2; ++ai)
#pragma unroll
                    for (int m = 0; m < 4; ++m) { const f32x4 v0 = acc[ai][bj][m][0], v1 = acc[ai][bj][m][1];
                        u32x4 o; o.x = pk2(v0[0], v0[1]); o.y = pk2(v0[2], v0[3]); o.z = pk2(v1[0], v1[1]); o.w = pk2(v1[2], v1[3]);
                        *(u32x4*)(pbp + ((bj * 2 + ai) * 4 + m) * 8192) = o; }
        } else {
            const int row0 = u.pm * 256 + wr * 64 + fr, col0 = u.pn * 256 + wc * 32 + 8 * fq;
            const float* bg = bgate + bi * DM + col0;
            bf16_t* mgp = MG + (size_t)row0 * DM + col0;
#pragma unroll
            for (int bj = 0; bj < 2; ++bj) {
                const f32x4 b0 = *(const f32x4*)(bg + bj * 128), b1 = *(const f32x4*)(bg + bj * 128 + 4);
                u32x4 pv[8], pp[8];
#pragma unroll
                for (int k = 0; k < 8; ++k) { pv[k] = *(const u32x4*)(pbp + (bj * 8 + k) * 8192);
                    pp[k] = (bi > 0) ? *(const u32x4*)(pbp + 131072 + (bj * 8 + k) * 8192) : (u32x4){0u, 0u, 0u, 0u}; }
#pragma unroll
                for (int ai = 0; ai < 2; ++ai)
#pragma unroll
                    for (int m = 0; m < 4; ++m) { const int k = ai * 4 + m;
                        const f32x4 a0 = acc[ai][bj][m][0] + b0, a1 = acc[ai][bj][m][1] + b1;
                        f32x4 r0, r1;
                        r0[0] = sigmoidf_(a0[0]) * bflo(pv[k].x) + bflo(pp[k].x); r0[1] = sigmoidf_(a0[1]) * bfhi(pv[k].x) + bfhi(pp[k].x);
                        r0[2] = sigmoidf_(a0[2]) * bflo(pv[k].y) + bflo(pp[k].y); r0[3] = sigmoidf_(a0[3]) * bfhi(pv[k].y) + bfhi(pp[k].y);
                        r1[0] = sigmoidf_(a1[0]) * bflo(pv[k].z) + bflo(pp[k].z); r1[1] = sigmoidf_(a1[1]) * bfhi(pv[k].z) + bfhi(pp[k].z);
                        r1[2] = sigmoidf_(a1[2]) * bflo(pv[k].w) + bflo(pp[k].w); r1[3] = sigmoidf_(a1[3]) * bfhi(pv[k].w) + bfhi(pp[k].w);
                        u32x4 o; o.x = pk2(r0[0], r0[1]); o.y = pk2(r0[2], r0[3]); o.z = pk2(r1[0], r1[1]); o.w = pk2(r1[2], r1[3]);
                        if (bi < 3) *(u32x4*)(pbp + 131072 + (bj * 8 + k) * 8192) = o;
                        else *(u32x4*)(mgp + (size_t)(ai * 128 + m * 16) * DM + bj * 128) = o; }
            }
        }
    }
};

__device__ __forceinline__ void transpose_item(const float* W, int N, int k0, int n0, bf16_t* dst  , int ldwt, LAS float* scr, int lane) {
    float tv[32];
#pragma unroll
    for (int i = 0; i < 32; ++i) tv[i] = W[(size_t)(k0 + 2 * i + (lane >> 5)) * N + n0 + (lane & 31)];
#pragma unroll
    for (int i = 0; i < 32; ++i) scr[(2 * i + (lane >> 5)) * 33 + (lane & 31)] = tv[i];
    __builtin_amdgcn_wave_barrier();
    const int c = lane & 7;
#pragma unroll
    for (int j = 0; j < 4; ++j) { const int n = (lane >> 3) + 8 * j; const LAS float* s = scr + (8 * c) * 33 + n;
        u32x4 o; o.x = pk2(s[0 * 33], s[1 * 33]); o.y = pk2(s[2 * 33], s[3 * 33]); o.z = pk2(s[4 * 33], s[5 * 33]); o.w = pk2(s[6 * 33], s[7 * 33]);
        *(u32x4*)(dst + (size_t)n * ldwt + 8 * c) = o; }
    __builtin_amdgcn_wave_barrier();
}

__device__ __forceinline__ void phase_prologue(const Params& p, LAS unsigned char* lds) {
    const int tid = opaque_tid(), lane = tid & 63, wave = tid >> 6;
    unsigned char* ws = p.ws;
    {
        LAS float* scr = (LAS float*)(lds + wave * 8704);
        const int gw = blockIdx.x * 8 + wave, NGW = gridDim.x * 8;
        constexpr int I_IN = 16 * (NIN / 32), I_G = 4 * 16 * 32, I_B = 4 * 4 * 32, I_O = 16 * 32, I_F = 16 * (DFF / 32), I_D = (DFF / 64) * 32;
        constexpr int PER_LAYER = I_IN + I_G + I_B + I_O + 2 * I_F + I_D;
        for (int it = gw; it < NLAYER * PER_LAYER; it += NGW) {
            const int l = it / PER_LAYER; int r = it % PER_LAYER;
            if (r < I_IN) { const int nb = r % (NIN / 32), kb = r / (NIN / 32);
                transpose_item(p.in[8] + (size_t)l * DM * NIN, NIN, 64 * kb, 32 * nb, (bf16_t*)(ws + OFF_WIN) + ((size_t)l * NIN + 32 * nb) * DM + 64 * kb, DM, scr, lane); continue; }
            r -= I_IN;
            if (r < I_G) { const int bi = r / 512, rr = r % 512, nb = rr % 32, kb = rr / 32;
                transpose_item(p.in[9] + ((size_t)l * 4 + bi) * DM * DM, DM, 64 * kb, 32 * nb, (bf16_t*)(ws + OFF_WG) + (((size_t)l * 4 + bi) * DM + 32 * nb) * DM + 64 * kb, DM, scr, lane); continue; }
            r -= I_G;
            if (r < I_B) { const int bi = r / 128, rr = r % 128, nb = rr % 32, kb = rr / 32;
                transpose_item(p.in[11] + ((size_t)l * 4 + bi) * 256 * DM, DM, 64 * kb, 32 * nb, (bf16_t*)(ws + OFF_WB) + ((size_t)l * DM + 32 * nb) * DM + bi * 256 + 64 * kb, DM, scr, lane); continue; }
            r -= I_B;
            if (r < I_O) { const int nb = r % 32, kb = r / 32;
                transpose_item(p.in[12] + (size_t)l * DM * DM, DM, 64 * kb, 32 * nb, (bf16_t*)(ws + OFF_WO) + ((size_t)l * DM + 32 * nb) * DM + 64 * kb, DM, scr, lane); continue; }
            r -= I_O;
            if (r < 2 * I_F) { const int which = r / I_F, rr = r % I_F, nb = rr % (DFF / 32), kb = rr / (DFF / 32);
                const int n0 = 32 * nb, row = (n0 >> 7) * 256 + (n0 & 127) + which * 128;
                transpose_item(p.in[which ? 21 : 20] + (size_t)l * DM * DFF, DFF, 64 * kb, n0, (bf16_t*)(ws + OFF_WGU) + ((size_t)l * 2 * DFF + row) * DM + 64 * kb, DM, scr, lane); continue; }
            r -= 2 * I_F;
            { const int nb = r % 32, kb = r / 32;
                transpose_item(p.in[22] + (size_t)l * DFF * DM, DM, 64 * kb, 32 * nb, (bf16_t*)(ws + OFF_WD) + ((size_t)l * DM + 32 * nb) * DFF + 64 * kb, DFF, scr, lane); }
        }
    }
    {
        const float* src = p.in[18]; bf16_t* dst = (bf16_t*)(ws + OFF_SGW);
        for (int i = blockIdx.x * NTHR + tid; i < NLAYER * 4 * 128 * 128 / 4; i += gridDim.x * NTHR) {
            const f32x4 v = *(const f32x4*)(src + 4 * (size_t)i); u32x2 o; o.x = pk2(v[0], v[1]); o.y = pk2(v[2], v[3]); *(u32x2*)(dst + 4 * (size_t)i) = o; }
    }
    __syncthreads();
    {
        LAS float* cs = (LAS float*)lds;
        float* modp = (float*)(ws + OFF_MODP);
        for (int it = blockIdx.x; it < NLAYER * 12 * 8; it += gridDim.x) {
            const int ks = it & 7, nb = (it >> 3) % 12, l = it / 96;
            __syncthreads();
            for (int e = tid; e < 128 * NB; e += NTHR) { const int kk = e / NB, b = e % NB;
                const float c = b < 16 ? p.in[2][b * DM + 128 * ks + kk] : p.in[3][(b - 16) * DM + 128 * ks + kk];
                cs[kk * NB + b] = siluf_(c); }
            __syncthreads();
            const int n = nb * 512 + tid;
            const float* w = p.in[4] + ((size_t)l * DM + 128 * ks) * 6144 + n;
            float a[NB];
#pragma unroll
            for (int b = 0; b < NB; ++b) a[b] = 0.f;
#pragma unroll 16
            for (int kk = 0; kk < 128; ++kk) { const float wv = w[(size_t)kk * 6144];
#pragma unroll
                for (int b4 = 0; b4 < NB / 4; ++b4) { const f32x4 c4 = *(const LAS f32x4*)(cs + kk * NB + 4 * b4);
                    a[4 * b4 + 0] += c4[0] * wv; a[4 * b4 + 1] += c4[1] * wv; a[4 * b4 + 2] += c4[2] * wv; a[4 * b4 + 3] += c4[3] * wv; } }
#pragma unroll
            for (int b = 0; b < NB; ++b) modp[(((size_t)ks * NB + b) * NLAYER + l) * 6144 + n] = a[b];
        }
    }
}
__device__ __forceinline__ void phase_mod_reduce(const Params& p) {
    const float* modp = (const float*)(p.ws + OFF_MODP); float* mod = (float*)(p.ws + OFF_MOD);
    constexpr int NMOD = NB * NLAYER * 6144;
    for (int i = blockIdx.x * NTHR + opaque_tid(); i < NMOD; i += gridDim.x * NTHR) {
        const int n = i % 6144, l = (i / 6144) % NLAYER;
        float s = p.in[5][l * 6144 + n];
#pragma unroll
        for (int ks = 0; ks < 8; ++ks) s += modp[(size_t)ks * NMOD + i];
        mod[i] = s;
    }
}

__device__ __forceinline__ void phase_norm_mod(const float* xsrc, float* copy_to, bf16_t* H, const float* g, const float* mod_sh, const float* mod_sc, int L, int bbase) {
    const int tid = opaque_tid(), lane = tid & 63, gw = blockIdx.x * 8 + (tid >> 6), NGW = gridDim.x * 8;
    const f32x4* gr = (const f32x4*)g + lane;
    for (int row = gw; row < TC; row += 2 * NGW) {
        const int row2 = (row + NGW < TC) ? row + NGW : row;
        const int b1 = bbase + row / L, b2 = bbase + row2 / L;
        const f32x4* x1 = (const f32x4*)(xsrc + (size_t)row * DM) + lane; const f32x4* x2 = (const f32x4*)(xsrc + (size_t)row2 * DM) + lane;
        const f32x4* sh1 = (const f32x4*)(mod_sh + (size_t)b1 * (NLAYER * 6144)) + lane; const f32x4* sc1 = (const f32x4*)(mod_sc + (size_t)b1 * (NLAYER * 6144)) + lane;
        const f32x4* sh2 = (const f32x4*)(mod_sh + (size_t)b2 * (NLAYER * 6144)) + lane; const f32x4* sc2 = (const f32x4*)(mod_sc + (size_t)b2 * (NLAYER * 6144)) + lane;
        f32x4 v1[4], v2[4], gg[4], s1[4], c1[4], s2[4], c2[4];
#pragma unroll
        for (int j = 0; j < 4; ++j) { v1[j] = x1[64 * j]; v2[j] = x2[64 * j]; gg[j] = gr[64 * j]; s1[j] = sh1[64 * j]; c1[j] = sc1[64 * j]; s2[j] = sh2[64 * j]; c2[j] = sc2[64 * j]; }
        float q1 = 0.f, q2 = 0.f;
#pragma unroll
        for (int j = 0; j < 4; ++j) { q1 += (v1[j][0] * v1[j][0] + v1[j][1] * v1[j][1]) + (v1[j][2] * v1[j][2] + v1[j][3] * v1[j][3]);
            q2 += (v2[j][0] * v2[j][0] + v2[j][1] * v2[j][1]) + (v2[j][2] * v2[j][2] + v2[j][3] * v2[j][3]); }
        const float r1 = rsqrtf(wave_sum(q1) * (1.f / DM) + EPSV), r2 = rsqrtf(wave_sum(q2) * (1.f / DM) + EPSV);
        if (copy_to) { f32x4* cr1 = (f32x4*)(copy_to + (size_t)row * DM) + lane; f32x4* cr2 = (f32x4*)(copy_to + (size_t)row2 * DM) + lane;
#pragma unroll
            for (int j = 0; j < 4; ++j) { cr1[64 * j] = v1[j]; cr2[64 * j] = v2[j]; } }
        u32x2* o1 = (u32x2*)(H + (size_t)row * DM) + lane; u32x2* o2 = (u32x2*)(H + (size_t)row2 * DM) + lane;
#pragma unroll
        for (int j = 0; j < 4; ++j) { const f32x4 y1 = v1[j] * r1 * gg[j] * (c1[j] + 1.f) + s1[j], y2 = v2[j] * r2 * gg[j] * (c2[j] + 1.f) + s2[j];
            u32x2 w1, w2; w1.x = pk2(y1[0], y1[1]); w1.y = pk2(y1[2], y1[3]); w2.x = pk2(y2[0], y2[1]); w2.y = pk2(y2[2], y2[3]); o1[64 * j] = w1; o2[64 * j] = w2; }
    }
}
__device__ __forceinline__ void phase_final_norm(float* X, const float* g) {
    const int tid = opaque_tid(), lane = tid & 63, gw = blockIdx.x * 8 + (tid >> 6), NGW = gridDim.x * 8;
    const f32x4* gr = (const f32x4*)g + lane;
    for (int row = gw; row < TC; row += 2 * NGW) {
        const int row2 = (row + NGW < TC) ? row + NGW : row;
        f32x4* x1 = (f32x4*)(X + (size_t)row * DM) + lane; f32x4* x2 = (f32x4*)(X + (size_t)row2 * DM) + lane;
        f32x4 v1[4], v2[4], gg[4]; float q1 = 0.f, q2 = 0.f;
#pragma unroll
        for (int j = 0; j < 4; ++j) { v1[j] = x1[64 * j]; v2[j] = x2[64 * j]; gg[j] = gr[64 * j]; }
#pragma unroll
        for (int j = 0; j < 4; ++j) { q1 += (v1[j][0] * v1[j][0] + v1[j][1] * v1[j][1]) + (v1[j][2] * v1[j][2] + v1[j][3] * v1[j][3]);
            q2 += (v2[j][0] * v2[j][0] + v2[j][1] * v2[j][1]) + (v2[j][2] * v2[j][2] + v2[j][3] * v2[j][3]); }
        const float r1 = rsqrtf(wave_sum(q1) * (1.f / DM) + EPSV), r2 = rsqrtf(wave_sum(q2) * (1.f / DM) + EPSV);
#pragma unroll
        for (int j = 0; j < 4; ++j) { x1[64 * j] = v1[j] * r1 * gg[j]; x2[64 * j] = v2[j] * r2 * gg[j]; }
    }
}

struct AttnState { f32x4 o[4]; float m, l; };
constexpr int VT_BYTES = 5120;
struct KVRegs { bf16x8 k[2][2]; u32x4 v[4]; };
template <class TokK, class TokV>
__device__ __forceinline__ void kv_load(KVRegs& kv, const bf16_t* P, int kcol, int vcol, int lane, int fq, const TokK& tok_k, const TokV& tok_v) {
#pragma unroll
    for (int t = 0; t < 2; ++t) { const bf16_t* kp = P + (size_t)tok_k(t) * NIN + kcol + 8 * fq; kv.k[t][0] = *(const bf16x8*)kp; kv.k[t][1] = *(const bf16x8*)(kp + 32); }
#pragma unroll
    for (int i = 0; i < 4; ++i) { const int pc = lane + 64 * i, key = pc >> 3, ch = pc & 7; kv.v[i] = *(const u32x4*)(P + (size_t)tok_v(key) * NIN + vcol + 8 * ch); }
}
constexpr int VROW = 72;
typedef short v4s_t __attribute__((ext_vector_type(4)));
__device__ __forceinline__ void attn_stage_v(LAS bf16_t* vt, const KVRegs& kv, int lane) {
#pragma unroll
    for (int i = 0; i < 4; ++i) { const int pc = lane + 64 * i, key = pc >> 3, ch = pc & 7; *(LAS u32x4*)(vt + key * VROW + 8 * ch) = kv.v[i]; }
}
__device__ __forceinline__ void attn_softmax(AttnState& st, const float (&s)[2][4], const bool (&valid)[2][4], bf16x8& pfo, float& alpha) {
    float mx = fmaxf(fmaxf(fmaxf(s[0][0], s[0][1]), fmaxf(s[0][2], s[0][3])), fmaxf(fmaxf(s[1][0], s[1][1]), fmaxf(s[1][2], s[1][3])));
    mx = fmaxf(mx, __shfl_xor(mx, 16)); mx = fmaxf(mx, __shfl_xor(mx, 32));
    const float mn = fmaxf(st.m, mx); alpha = __expf(st.m - mn);
    float pv[2][4]; float ps = 0.f;
#pragma unroll
    for (int t = 0; t < 2; ++t)
#pragma unroll
        for (int r = 0; r < 4; ++r) { pv[t][r] = valid[t][r] ? __expf(s[t][r] - mn) : 0.f; ps += pv[t][r]; }
    st.m = mn; st.l = st.l * alpha + ps;
    union { bf16x8 v; unsigned u[4]; } pf;
    pf.u[0] = pk2(pv[0][0], pv[0][1]); pf.u[1] = pk2(pv[0][2], pv[0][3]); pf.u[2] = pk2(pv[1][0], pv[1][1]); pf.u[3] = pk2(pv[1][2], pv[1][3]);
    pfo = pf.v;
}
__device__ __forceinline__ void attn_pv(AttnState& st, const bf16x8 pf, const float alpha, const LAS bf16_t* vt, int fr, int fq) {
    const LAS bf16_t* base = vt + (4 * fq + (fr >> 2)) * VROW + 4 * (fr & 3);
#pragma unroll
    for (int dt = 0; dt < 4; ++dt) {
        const v4s_t a0 = __builtin_amdgcn_ds_read_tr16_b64_v4i16((LAS v4s_t*)(base + 16 * dt));
        const v4s_t a1 = __builtin_amdgcn_ds_read_tr16_b64_v4i16((LAS v4s_t*)(base + 16 * VROW + 16 * dt));
        bf16x8 vf; vf[0] = a0[0]; vf[1] = a0[1]; vf[2] = a0[2]; vf[3] = a0[3]; vf[4] = a1[0]; vf[5] = a1[1]; vf[6] = a1[2]; vf[7] = a1[3];
        st.o[dt] = st.o[dt] * alpha;
        st.o[dt] = MFMA16(vf, pf, st.o[dt]);
    }
}
__device__ __forceinline__ void attn_qk(f32x4 (&sacc)[2], const KVRegs& kv, const bf16x8 (&qf)[2]) {
#pragma unroll
    for (int t = 0; t < 2; ++t) { sacc[t] = (f32x4){0.f, 0.f, 0.f, 0.f};
#pragma unroll
        for (int ks = 0; ks < 2; ++ks) sacc[t] = MFMA16(kv.k[t][ks], qf[ks], sacc[t]); }
}

__device__ __forceinline__ void na_item(int item, const bf16_t* P, bf16_t* BR, const float* rpb  , int L, LAS unsigned char* lds) {
    const int tid = opaque_tid(), lane = tid & 63, wave = tid >> 6, fr = lane & 15, fq = lane >> 4;
    asm volatile("" : "+s"(item));
    const int rr = item, n = wave & 3, h0 = 2 * (wave >> 2);
    const int rows = L >> 6, seq = rr / rows, r = rr % rows, seqbase = seq * L;
    const int r0 = min(max(r - 4, 0), rows - 8);
    LAS bf16_t* vt[2] = {(LAS bf16_t*)(lds + (2 * wave) * VT_BYTES), (LAS bf16_t*)(lds + (2 * wave + 1) * VT_BYTES)};
    const int qtok = seqbase + r * 64 + 16 * n + fr;
    const int col0 = min(max(16 * n - 8, 0), 32), qcol = 16 * n + fr, win0 = min(max(qcol - 8, 0), 48);
    bf16x8 qf[2][2]; AttnState st[2]; KVRegs cur[2];
#pragma unroll
    for (int c = 0; c < 2; ++c) {
#pragma unroll
        for (int ks = 0; ks < 2; ++ks) qf[c][ks] = *(const bf16x8*)(P + (size_t)qtok * NIN + P_NAQ + 64 * (h0 + c) + 32 * ks + 8 * fq);
#pragma unroll
        for (int dt = 0; dt < 4; ++dt) st[c].o[dt] = (f32x4){0.f, 0.f, 0.f, 0.f};
        st[c].m = -1e30f; st[c].l = 0.f;
        const int rowtok = seqbase + r0 * 64 + col0;
        kv_load(cur[c], P, P_NAK + 64 * (h0 + c), P_NAV + 64 * (h0 + c), lane, fq, [&](int t) { return rowtok + 16 * t + fr; }, [&](int key) { return rowtok + key; });
    }
    for (int kr = 0; kr < 8; ++kr) {
        const int krow = r0 + kr;
        KVRegs nxt[2];
        { const int rowtok = seqbase + min(krow + 1, r0 + 7) * 64 + col0;
#pragma unroll
          for (int c = 0; c < 2; ++c) kv_load(nxt[c], P, P_NAK + 64 * (h0 + c), P_NAV + 64 * (h0 + c), lane, fq, [&](int t) { return rowtok + 16 * t + fr; }, [&](int key) { return rowtok + key; }); }
        float bias[2][2][4]; bool valid[2][4];
#pragma unroll
        for (int t = 0; t < 2; ++t)
#pragma unroll
            for (int g = 0; g < 4; ++g) { const int kc = col0 + 16 * t + 4 * fq + g; valid[t][g] = (kc >= win0) && (kc < win0 + 16);
                const int bi = (h0 * 15 + (krow - r + 7)) * 31 + min(max(kc - qcol + 15, 0), 30);
                bias[0][t][g] = rpb[bi]; bias[1][t][g] = rpb[bi + 15 * 31]; }
        attn_stage_v(vt[0], cur[0], lane); attn_stage_v(vt[1], cur[1], lane);
        __builtin_amdgcn_wave_barrier();
        bf16x8 pf[2]; float alpha[2];
#pragma unroll
        for (int c = 0; c < 2; ++c) {
            f32x4 sacc[2]; attn_qk(sacc, cur[c], qf[c]);
            float sc[2][4];
#pragma unroll
            for (int t = 0; t < 2; ++t)
#pragma unroll
                for (int g = 0; g < 4; ++g) sc[t][g] = valid[t][g] ? sacc[t][g] * 0.125f + bias[c][t][g] : -1e30f;
            attn_softmax(st[c], sc, valid, pf[c], alpha[c]);
        }
#pragma unroll
        for (int c = 0; c < 2; ++c) attn_pv(st[c], pf[c], alpha[c], vt[c], fr, fq);
        __builtin_amdgcn_wave_barrier();
        cur[0] = nxt[0]; cur[1] = nxt[1];
    }
#pragma unroll
    for (int c = 0; c < 2; ++c) {
        float l = st[c].l; l += __shfl_xor(l, 16); l += __shfl_xor(l, 32);
        const float inv = 1.f / l;
        bf16_t* orow = BR + (size_t)qtok * DM + 0 + 64 * (h0 + c) + 4 * fq;
#pragma unroll
        for (int dt = 0; dt < 4; ++dt) { u32x2 o; o.x = pk2(st[c].o[dt][0] * inv, st[c].o[dt][1] * inv); o.y = pk2(st[c].o[dt][2] * inv, st[c].o[dt][3] * inv); *(u32x2*)(orow + 16 * dt) = o; }
    }
}

constexpr int DL_OLD = 68;
constexpr int DL_O_OFF = 16 * VT_BYTES;
constexpr int DL_M_OFF = DL_O_OFF + 256 * DL_OLD * 4;
constexpr int DL_L_OFF = DL_M_OFF + 1024;
__device__ __forceinline__ void dl_item(int item, const bf16_t* P, bf16_t* BR, int L, LAS unsigned char* lds) {
    const int tid = opaque_tid(), lane = tid & 63, wave = tid >> 6, fr = lane & 15, fq = lane >> 4;
    asm volatile("" : "+s"(item));
    const int sp = item >> 2, h = item & 3;
    const int t0 = sp * 256, seq = t0 / L, seqbase = seq * L, p0 = t0 - seqbase;
    LAS bf16_t* vt[2] = {(LAS bf16_t*)(lds + (2 * wave) * VT_BYTES), (LAS bf16_t*)(lds + (2 * wave + 1) * VT_BYTES)};
    LAS float* OL = (LAS float*)(lds + DL_O_OFF); LAS float* ML = (LAS float*)(lds + DL_M_OFF); LAS float* LL = (LAS float*)(lds + DL_L_OFF);
    __syncthreads();
    for (int e = tid; e < 256 * DL_OLD; e += NTHR) OL[e] = 0.f;
    if (tid < 256) { ML[tid] = -1e30f; LL[tid] = 0.f; }
    __syncthreads();
    const float slope = (h == 0) ? 0.25f : (h == 1) ? 0.0625f : (h == 2) ? 0.015625f : 0.00390625f;
    const int kcol = P_DK + 64 * h, vcol = P_DV + 64 * h;
    for (int cfg = 0; cfg < 3; ++cfg) {
        const int dsh = 2 * cfg, n = L >> dsh;
        int rC[2], subC[2], j0C[2], qjC[2];
        bf16x8 qf[2][2]; AttnState st[2]; KVRegs cur[2];
#pragma unroll
        for (int c = 0; c < 2; ++c) {
            const int qt = 2 * wave + c;
            rC[c] = (cfg == 0) ? 0 : (cfg == 1) ? (qt >> 2) : qt;
            subC[c] = (cfg == 0) ? qt : (cfg == 1) ? (qt & 3) : 0;
            j0C[c] = (p0 >> dsh) + 16 * subC[c]; qjC[c] = j0C[c] + fr;
            const int qtok = seqbase + (qjC[c] << dsh) + rC[c];
#pragma unroll
            for (int ks = 0; ks < 2; ++ks) qf[c][ks] = *(const bf16x8*)(P + (size_t)qtok * NIN + P_DQ + 64 * h + 32 * ks + 8 * fq);
#pragma unroll
            for (int dt = 0; dt < 4; ++dt) st[c].o[dt] = (f32x4){0.f, 0.f, 0.f, 0.f};
            st[c].m = -1e30f; st[c].l = 0.f;
        }
        if (cfg < 2) {
            const int kb0 = j0C[0] - 64, rr_ = rC[0];
            int s_lo = 0, s_hi = 6;
            while (s_lo < 5 && kb0 + 32 * s_lo + 32 <= 0) ++s_lo;
            while (s_hi > s_lo + 1 && kb0 + 32 * (s_hi - 1) >= n) --s_hi;
            KVRegs cur;
            { const int kb = kb0 + 32 * s_lo;
              kv_load(cur, P, kcol, vcol, lane, fq, [&](int t) { const int kj = min(max(kb + 16 * t + fr, 0), n - 1); return seqbase + (kj << dsh) + rr_; },
                      [&](int key) { const int kj = min(max(kb + key, 0), n - 1); return seqbase + (kj << dsh) + rr_; }); }
            for (int sx = s_lo; sx < s_hi; ++sx) {
                const int kb = kb0 + 32 * sx;
                KVRegs nxt;
                { const int kb2 = kb0 + 32 * min(sx + 1, s_hi - 1);
                  kv_load(nxt, P, kcol, vcol, lane, fq, [&](int t) { const int kj = min(max(kb2 + 16 * t + fr, 0), n - 1); return seqbase + (kj << dsh) + rr_; },
                          [&](int key) { const int kj = min(max(kb2 + key, 0), n - 1); return seqbase + (kj << dsh) + rr_; }); }
                attn_stage_v(vt[0], cur, lane);
                __builtin_amdgcn_wave_barrier();
                bf16x8 pf[2]; float alpha[2];
#pragma unroll
                for (int c = 0; c < 2; ++c) {
                    f32x4 sacc[2]; attn_qk(sacc, cur, qf[c]);
                    float sc[2][4]; bool valid[2][4];
#pragma unroll
                    for (int t = 0; t < 2; ++t)
#pragma unroll
                        for (int g = 0; g < 4; ++g) { const int kj = kb + 16 * t + 4 * fq + g; const int dist = abs(kj - qjC[c]);
                            const bool v = (dist <= 64) && (kj >= 0) && (kj < n);
                            valid[t][g] = v; sc[t][g] = v ? sacc[t][g] * 0.125f - slope * (float)(dist << dsh) : -1e30f; }
                    attn_softmax(st[c], sc, valid, pf[c], alpha[c]);
                }
#pragma unroll
                for (int c = 0; c < 2; ++c) attn_pv(st[c], pf[c], alpha[c], vt[0], fr, fq);
                __builtin_amdgcn_wave_barrier();
                cur = nxt;
            }
        } else {
        int s_lo = 0, s_hi = 5;
        while (s_lo < 4 && j0C[1] - 64 + 32 * s_lo + 32 <= 0) ++s_lo;
        while (s_hi > s_lo + 1 && j0C[0] - 64 + 32 * (s_hi - 1) >= n) --s_hi;
#pragma unroll
        for (int c = 0; c < 2; ++c) { const int kb = j0C[c] - 64 + 32 * s_lo, rr_ = rC[c];
            kv_load(cur[c], P, kcol, vcol, lane, fq, [&](int t) { const int kj = min(max(kb + 16 * t + fr, 0), n - 1); return seqbase + (kj << dsh) + rr_; },
                    [&](int key) { const int kj = min(max(kb + key, 0), n - 1); return seqbase + (kj << dsh) + rr_; }); }
        for (int sx = s_lo; sx < s_hi; ++sx) {
            KVRegs nxt[2];
#pragma unroll
            for (int c = 0; c < 2; ++c) { const int kb2 = j0C[c] - 64 + 32 * min(sx + 1, s_hi - 1), rr_ = rC[c];
                kv_load(nxt[c], P, kcol, vcol, lane, fq, [&](int t) { const int kj = min(max(kb2 + 16 * t + fr, 0), n - 1); return seqbase + (kj << dsh) + rr_; },
                        [&](int key) { const int kj = min(max(kb2 + key, 0), n - 1); return seqbase + (kj << dsh) + rr_; }); }
            attn_stage_v(vt[0], cur[0], lane); attn_stage_v(vt[1], cur[1], lane);
            __builtin_amdgcn_wave_barrier();
            bf16x8 pf[2]; float alpha[2];
#pragma unroll
            for (int c = 0; c < 2; ++c) {
                const int kb = j0C[c] - 64 + 32 * sx;
                f32x4 sacc[2]; attn_qk(sacc, cur[c], qf[c]);
                float sc[2][4]; bool valid[2][4];
#pragma unroll
                for (int t = 0; t < 2; ++t)
#pragma unroll
                    for (int g = 0; g < 4; ++g) { const int kj = kb + 16 * t + 4 * fq + g; const int dist = abs(kj - qjC[c]);
                        const bool v = (dist <= 64) && (kj >= 0) && (kj < n);
                        valid[t][g] = v; sc[t][g] = v ? sacc[t][g] * 0.125f - slope * (float)(dist << dsh) : -1e30f; }
                attn_softmax(st[c], sc, valid, pf[c], alpha[c]);
            }
#pragma unroll
            for (int c = 0; c < 2; ++c) attn_pv(st[c], pf[c], alpha[c], vt[c], fr, fq);
            __builtin_amdgcn_wave_barrier();
            cur[0] = nxt[0]; cur[1] = nxt[1];
        }
        }
#pragma unroll
        for (int c = 0; c < 2; ++c) {
            float l = st[c].l; l += __shfl_xor(l, 16); l += __shfl_xor(l, 32);
            const int ql = ((16 * subC[c] + fr) << dsh) + rC[c];
            const float mo = ML[ql], lo = LL[ql], mn = fmaxf(mo, st[c].m), a = __expf(mo - mn), b = __expf(st[c].m - mn);
            LAS float* orow = OL + ql * DL_OLD + 4 * fq;
#pragma unroll
            for (int dt = 0; dt < 4; ++dt) { f32x4 ov = *(LAS f32x4*)(orow + 16 * dt); ov = ov * a + st[c].o[dt] * b; *(LAS f32x4*)(orow + 16 * dt) = ov; }
            __builtin_amdgcn_wave_barrier();
            if (fq == 0) { ML[ql] = mn; LL[ql] = lo * a + l * b; }
            __builtin_amdgcn_wave_barrier();
        }
        __syncthreads();
    }
    for (int e = tid; e < 256 * 8; e += NTHR) { const int ql = e >> 3, c8 = e & 7;
        const float inv = 1.f / LL[ql]; const LAS float* orow = OL + ql * DL_OLD + 8 * c8;
        const f32x4 a = *(const LAS f32x4*)orow, b = *(const LAS f32x4*)(orow + 4);
        u32x4 o; o.x = pk2(a[0] * inv, a[1] * inv); o.y = pk2(a[2] * inv, a[3] * inv); o.z = pk2(b[0] * inv, b[1] * inv); o.w = pk2(b[2] * inv, b[3] * inv);
        *(u32x4*)(BR + (size_t)(t0 + ql) * DM + 768 + 64 * h + 8 * c8) = o; }
}

constexpr int SG_WLD = 136, SG_VLD = 136;
constexpr int SG_V_OFF = 128 * SG_WLD * 2;
__device__ __forceinline__ void sg_item(int item, const bf16_t* P, bf16_t* BR, const bf16_t* sgw  , const float* ln_g, const float* ln_b, const float* sgb  , LAS unsigned char* lds) {
    const int tid = opaque_tid(), lane = tid & 63, wave = tid >> 6, fr = lane & 15, fq = lane >> 4;
    const int nc = item >> 2, g = item & 3, t0 = nc * 128;
    LAS bf16_t* WL = (LAS bf16_t*)lds; LAS bf16_t* VT = (LAS bf16_t*)(lds + SG_V_OFF);
    __syncthreads();
    for (int e = tid; e < 128 * 16; e += NTHR) { const int row = e >> 4, c8 = e & 15;
        *(LAS u32x4*)(WL + row * SG_WLD + 8 * c8) = *(const u32x4*)(sgw + ((size_t)g * 128 + row) * 128 + 8 * c8); }
    {
        const int s = tid >> 2, qd = tid & 3;
        const bf16_t* vp = P + (size_t)(t0 + s) * NIN + P_SV + 64 * qd;
        float sum = 0.f, sq = 0.f;
#pragma unroll
        for (int i = 0; i < 8; ++i) { const u32x4 w = *(const u32x4*)(vp + 8 * i);
            const unsigned ww[4] = {w.x, w.y, w.z, w.w};
#pragma unroll
            for (int j = 0; j < 4; ++j) { const float a = gelu_tanh(bflo(ww[j])), b = gelu_tanh(bfhi(ww[j])); sum += a + b; sq += a * a + b * b; } }
        sum += __shfl_xor(sum, 1); sum += __shfl_xor(sum, 2); sq += __shfl_xor(sq, 1); sq += __shfl_xor(sq, 2);
        const float mean = sum * (1.f / 256.f), var = fmaxf(sq * (1.f / 256.f) - mean * mean, 0.f), rstd = rsqrtf(var + EPSV);
        const bf16_t* gp = P + (size_t)(t0 + s) * NIN + P_SV + 64 * g + 16 * qd;
#pragma unroll
        for (int i = 0; i < 2; ++i) { const u32x4 w = *(const u32x4*)(gp + 8 * i);
            const unsigned ww[4] = {w.x, w.y, w.z, w.w};
#pragma unroll
            for (int j = 0; j < 4; ++j) {
                const int c = 16 * qd + 8 * i + 2 * j, ch = 64 * g + c;
                const float a = (gelu_tanh(bflo(ww[j])) - mean) * rstd * ln_g[ch] + ln_b[ch], b = (gelu_tanh(bfhi(ww[j])) - mean) * rstd * ln_g[ch + 1] + ln_b[ch + 1];
                VT[c * SG_VLD + s] = f2bf(a); VT[(c + 1) * SG_VLD + s] = f2bf(b); } }
    }
    __syncthreads();
    f32x4 acc[4];
#pragma unroll
    for (int ni = 0; ni < 4; ++ni) acc[ni] = (f32x4){0.f, 0.f, 0.f, 0.f};
#pragma unroll
    for (int ks = 0; ks < 4; ++ks) { const bf16x8 a = *(const LAS bf16x8*)(WL + (16 * wave + fr) * SG_WLD + 32 * ks + 8 * fq);
#pragma unroll
        for (int ni = 0; ni < 4; ++ni) { const bf16x8 b = *(const LAS bf16x8*)(VT + (16 * ni + fr) * SG_VLD + 32 * ks + 8 * fq); acc[ni] = MFMA16(a, b, acc[ni]); } }
    {
        unsigned uraw[4][4]; float bsv[4];
#pragma unroll
        for (int reg = 0; reg < 4; ++reg) { const int t = 16 * wave + 4 * fq + reg; bsv[reg] = sgb[g * 128 + t];
            const bf16_t* up = P + (size_t)(t0 + t) * NIN + P_SU + 64 * g;
#pragma unroll
            for (int ni = 0; ni < 4; ++ni) uraw[reg][ni] = up[16 * ni + fr]; }
#pragma unroll
        for (int reg = 0; reg < 4; ++reg) { const int t = 16 * wave + 4 * fq + reg;
            bf16_t* op = BR + (size_t)(t0 + t) * DM + 512 + 64 * g;
#pragma unroll
            for (int ni = 0; ni < 4; ++ni) { const float u = gelu_tanh(bf2f(uraw[reg][ni])); op[16 * ni + fr] = f2bf(u * (acc[ni][reg] + bsv[reg])); } }
    }
}

constexpr int HG_LF_OFF = 0;
constexpr int LFS = 65, LFD = 64 * LFS;
constexpr int HG_T_OFF = 33280;
constexpr int HG_TLD = 72, HG_TB = 64 * HG_TLD * 2;
__device__ __forceinline__ float hg_lb(const float* hg_lb_in, int dir, int l, int ch) {
    const float* q = hg_lb_in + (size_t)dir * NLAYER * 256 + ch;
    const float a0 = q[0], a1 = q[256], a2 = q[512], a3 = q[768];
    const float mx = fmaxf(fmaxf(a0, a1), fmaxf(a2, a3));
    const float e0 = __expf(a0 - mx), e1 = __expf(a1 - mx), e2 = __expf(a2 - mx), e3 = __expf(a3 - mx);
    const float num = (l >= 1 ? e1 : 0.f) + (l >= 2 ? e2 : 0.f) + (l >= 3 ? e3 : 0.f);
    return num / (e0 + e1 + e2 + e3);
}
constexpr int HG_LB_OFF = 155648;
constexpr int HG_TOT_OFF = 157696;
__device__ __forceinline__ void hg_lb_table(const float* hg_lb_in, int l, LAS unsigned char* lds) {
    const int tid = opaque_tid();
    ((LAS float*)(lds + HG_LB_OFF))[tid] = hg_lb(hg_lb_in, (tid >> 6) & 1, l, 64 * (tid >> 7) + (tid & 63));
    __syncthreads();
}
__device__ __forceinline__ void hg_front(const u32x4 (&wf)[2], int h, LAS unsigned char* lds) {
    const int tid = opaque_tid();
    LAS float* LF = (LAS float*)(lds + HG_LF_OFF); LAS float* TOT = (LAS float*)(lds + HG_TOT_OFF); const LAS float* LBS = (const LAS float*)(lds + HG_LB_OFF) + h * 128;
    {
        const int s = tid >> 3, i0 = 8 * (tid & 7);
#pragma unroll
        for (int dir = 0; dir < 2; ++dir) {
            const unsigned ww[4] = {wf[dir].x, wf[dir].y, wf[dir].z, wf[dir].w};
#pragma unroll
            for (int j = 0; j < 4; ++j) {
                const float lb0 = LBS[dir * 64 + i0 + 2 * j], lb1 = LBS[dir * 64 + i0 + 2 * j + 1];
                const float f0 = lb0 + (1.f - lb0) * sigmoidf_(bflo(ww[j])), f1 = lb1 + (1.f - lb1) * sigmoidf_(bfhi(ww[j]));
                LF[dir * LFD + s * LFS + i0 + 2 * j] = __logf(f0); LF[dir * LFD + s * LFS + i0 + 2 * j + 1] = __logf(f1); }
        }
    }
    __syncthreads();
    {
        const int dir = tid >> 8, seg = (tid >> 6) & 3, i = tid & 63;
        LAS float* a = LF + dir * LFD + i;
        float r[16]; float run = 0.f;
#pragma unroll
        for (int k = 0; k < 16; ++k) { const int sidx = dir ? (16 * seg + 15 - k) : (16 * seg + k); run += a[sidx * LFS]; r[k] = run; }
        TOT[(dir * 4 + seg) * 64 + i] = run;
        __syncthreads();
        float off = 0.f;
#pragma unroll
        for (int q = 0; q < 4; ++q) { const float tq = TOT[(dir * 4 + q) * 64 + i]; off += (dir ? (q > seg) : (q < seg)) ? tq : 0.f; }
#pragma unroll
        for (int k = 0; k < 16; ++k) { const int sidx = dir ? (16 * seg + 15 - k) : (16 * seg + k); a[sidx * LFS] = r[k] + off; }
    }
    __syncthreads();
}
__device__ __forceinline__ float hg_kk(LAS unsigned char* lds, int h, int dir, int i, float x) { const float lb = ((LAS float*)(lds + HG_LB_OFF))[(h * 2 + dir) * 64 + i]; return (1.f - lb) * sigmoidf_(-x); }

__device__ __forceinline__ void hgA_item(int item, const bf16_t* P, float* HGST, float* HGD, LAS unsigned char* lds) {
    const int tid = opaque_tid(), lane = tid & 63, wave = tid >> 6, fr = lane & 15, fq = lane >> 4;
    const int cc = item >> 2, h = item & 3, t0 = cc * 64;
    const int s = tid >> 3, i0 = 8 * (tid & 7);
    u32x4 wf[2];
    wf[0] = *(const u32x4*)(P + (size_t)(t0 + s) * NIN + P_FF + 64 * h + i0);
    wf[1] = *(const u32x4*)(P + (size_t)(t0 + s) * NIN + P_FB + 64 * h + i0);
    const u32x4 wv = *(const u32x4*)(P + (size_t)(t0 + s) * NIN + P_HI + 64 * h + i0);
    __syncthreads();
    hg_front(wf, h, lds);
    LAS float* LF = (LAS float*)(lds + HG_LF_OFF);
    LAS bf16_t* KD0 = (LAS bf16_t*)(lds + HG_T_OFF); LAS bf16_t* KD1 = (LAS bf16_t*)(lds + HG_T_OFF + HG_TB); LAS bf16_t* VT = (LAS bf16_t*)(lds + HG_T_OFF + 2 * HG_TB);
    {
#pragma unroll
        for (int dir = 0; dir < 2; ++dir) {
            const unsigned ww[4] = {wf[dir].x, wf[dir].y, wf[dir].z, wf[dir].w};
            LAS bf16_t* KD = dir ? KD1 : KD0; const LAS float* A = LF + dir * LFD; const int slast = dir ? 0 : 63;
#pragma unroll
            for (int j = 0; j < 8; ++j) { const int i = i0 + j; const float x = (j & 1) ? bfhi(ww[j >> 1]) : bflo(ww[j >> 1]);
                const float kd = hg_kk(lds, h, dir, i, x) * __expf(A[slast * LFS + i] - A[s * LFS + i]);
                KD[i * HG_TLD + s] = f2bf(kd); }
        }
        const unsigned ww[4] = {wv.x, wv.y, wv.z, wv.w};
#pragma unroll
        for (int j = 0; j < 8; ++j) VT[(i0 + j) * HG_TLD + s] = (bf16_t)((j & 1) ? (ww[j >> 1] >> 16) : (ww[j >> 1] & 0xffffu));
        if (tid < 128) { const int dir = tid >> 6, i = tid & 63; HGD[((size_t)(cc * 4 + h) * 2 + dir) * 64 + i] = __expf(LF[dir * LFD + (dir ? 0 : 63) * LFS + i]); }
    }
    __syncthreads();
    {
        const int dir = wave >> 2, mt = wave & 3; const LAS bf16_t* KD = dir ? KD1 : KD0;
        f32x4 acc[4];
#pragma unroll
        for (int ni = 0; ni < 4; ++ni) acc[ni] = (f32x4){0.f, 0.f, 0.f, 0.f};
#pragma unroll
        for (int ks = 0; ks < 2; ++ks) { const bf16x8 a = *(const LAS bf16x8*)(VT + (16 * mt + fr) * HG_TLD + 32 * ks + 8 * fq);
#pragma unroll
            for (int ni = 0; ni < 4; ++ni) { const bf16x8 b = *(const LAS bf16x8*)(KD + (16 * ni + fr) * HG_TLD + 32 * ks + 8 * fq); acc[ni] = MFMA16(a, b, acc[ni]); } }
        float* dst = HGST + ((size_t)(cc * 4 + h) * 2 + dir) * 4096;
#pragma unroll
        for (int ni = 0; ni < 4; ++ni)
#pragma unroll
            for (int reg = 0; reg < 4; ++reg) dst[(16 * mt + 4 * fq + reg) * 64 + 16 * ni + fr] = acc[ni][reg];
    }
}
__device__ __forceinline__ void hgB_phase(float* HGST, const float* HGD, int L) {
    const int ncs = L >> 6, nseq = TC / L, total = nseq * 8 * 4096;
    for (int e = blockIdx.x * NTHR + opaque_tid(); e < total; e += gridDim.x * NTHR) {
        const int ji = e & 4095, dir = (e >> 12) & 1, h = (e >> 13) & 3, seq = e >> 15, i = ji & 63;
        float S = 0.f;
        for (int c0 = 0; c0 < ncs; c0 += 8) {
            float u[8], d[8];
#pragma unroll
            for (int k = 0; k < 8; ++k) { const int cc = seq * ncs + (dir ? (ncs - 1 - (c0 + k)) : (c0 + k)); const size_t o = ((size_t)(cc * 4 + h) * 2 + dir);
                u[k] = HGST[o * 4096 + ji]; d[k] = HGD[o * 64 + i]; }
#pragma unroll
            for (int k = 0; k < 8; ++k) { const int cc = seq * ncs + (dir ? (ncs - 1 - (c0 + k)) : (c0 + k)); const size_t o = ((size_t)(cc * 4 + h) * 2 + dir);
                HGST[o * 4096 + ji] = S; S = S * d[k] + u[k]; }
        }
    }
}
__device__ __forceinline__ void hgC_item(int item, const bf16_t* P, bf16_t* BR, const float* HGST, const float* gnorm  , LAS unsigned char* lds) {
    const int tid = opaque_tid(), lane = tid & 63, wave = tid >> 6, fr = lane & 15, fq = lane >> 4;
    const int cc = item >> 2, h = item & 3, t0 = cc * 64;
    const int s = tid >> 3, i0 = 8 * (tid & 7);
    u32x4 wf[2];
    wf[0] = *(const u32x4*)(P + (size_t)(t0 + s) * NIN + P_FF + 64 * h + i0);
    wf[1] = *(const u32x4*)(P + (size_t)(t0 + s) * NIN + P_FB + 64 * h + i0);
    const u32x4 wq = *(const u32x4*)(P + (size_t)(t0 + s) * NIN + P_HQ + 64 * h + i0);
    const u32x4 wv = *(const u32x4*)(P + (size_t)(t0 + s) * NIN + P_HI + 64 * h + i0);
    f32x4 stv[4];
    { const int dir = tid >> 8, j = (tid >> 2) & 63, i4 = 16 * (tid & 3);
      const float* src = HGST + ((size_t)(cc * 4 + h) * 2 + dir) * 4096 + j * 64 + i4;
#pragma unroll
      for (int q = 0; q < 4; ++q) stv[q] = *(const f32x4*)(src + 4 * q); }
    unsigned gpre[4][4];
    if (wave < 4) {
#pragma unroll
        for (int reg = 0; reg < 4; ++reg)
#pragma unroll
            for (int ni = 0; ni < 4; ++ni) gpre[reg][ni] = P[(size_t)(t0 + 16 * wave + 4 * fq + reg) * NIN + P_HGATE + 64 * h + 16 * ni + fr];
    }
    __syncthreads();
    hg_front(wf, h, lds);
    LAS float* LF = (LAS float*)(lds + HG_LF_OFF);
#define HGT(k) ((LAS bf16_t*)(lds + HG_T_OFF + (k) * HG_TB))
    {
        const unsigned wqq[4] = {wq.x, wq.y, wq.z, wq.w};
#pragma unroll
        for (int dir = 0; dir < 2; ++dir) {
            const unsigned ww[4] = {wf[dir].x, wf[dir].y, wf[dir].z, wf[dir].w};
            const LAS float* A = LF + dir * LFD;
            u32x4 oq, ok, oe; unsigned* oqp = (unsigned*)&oq; unsigned* okp = (unsigned*)&ok; unsigned* oep = (unsigned*)&oe;
#pragma unroll
            for (int j2 = 0; j2 < 4; ++j2) { float qt[2], kt[2], qe[2];
#pragma unroll
                for (int e = 0; e < 2; ++e) { const int i = i0 + 2 * j2 + e; const float x = e ? bfhi(ww[j2]) : bflo(ww[j2]); const float qs = siluf_(e ? bfhi(wqq[j2]) : bflo(wqq[j2]));
                    const float a = A[s * LFS + i], ref = A[32 * LFS + i];
                    const float d1 = fminf(fmaxf(a - ref, -80.f), 80.f);
                    qt[e] = qs * __expf(d1); kt[e] = hg_kk(lds, h, dir, i, x) * __expf(-d1); qe[e] = qs * __expf(a); }
                oqp[j2] = pk2(qt[0], qt[1]); okp[j2] = pk2(kt[0], kt[1]); oep[j2] = pk2(qe[0], qe[1]); }
            *(LAS u32x4*)(HGT(0 + dir) + s * HG_TLD + i0) = oq; *(LAS u32x4*)(HGT(2 + dir) + s * HG_TLD + i0) = ok; *(LAS u32x4*)(HGT(4 + dir) + s * HG_TLD + i0) = oe;
        }
        const unsigned ww[4] = {wv.x, wv.y, wv.z, wv.w};
        LAS bf16_t* VT = HGT(6);
#pragma unroll
        for (int j = 0; j < 8; ++j) VT[(i0 + j) * HG_TLD + s] = (bf16_t)((j & 1) ? (ww[j >> 1] >> 16) : (ww[j >> 1] & 0xffffu));
        { const int dir = tid >> 8, j = (tid >> 2) & 63, i4 = 16 * (tid & 3);
          LAS bf16_t* dstp = HGT(8 + dir) + j * HG_TLD + i4;
#pragma unroll
          for (int q = 0; q < 2; ++q) { const f32x4 a = stv[2 * q], b = stv[2 * q + 1];
              u32x4 o; o.x = pk2(a[0], a[1]); o.y = pk2(a[2], a[3]); o.z = pk2(b[0], b[1]); o.w = pk2(b[2], b[3]); *(LAS u32x4*)(dstp + 8 * q) = o; } }
    }
    __syncthreads();
    {
        const int mt = wave >> 1;
#pragma unroll
        for (int q = 0; q < 2; ++q) { const int nt = 2 * (wave & 1) + q;
            f32x4 af = (f32x4){0.f, 0.f, 0.f, 0.f}, ab = (f32x4){0.f, 0.f, 0.f, 0.f};
            if (nt <= mt) {
#pragma unroll
                for (int ks = 0; ks < 2; ++ks) af = MFMA16(*(const LAS bf16x8*)(HGT(0) + (16 * mt + fr) * HG_TLD + 32 * ks + 8 * fq), *(const LAS bf16x8*)(HGT(2) + (16 * nt + fr) * HG_TLD + 32 * ks + 8 * fq), af); }
            if (nt >= mt) {
#pragma unroll
                for (int ks = 0; ks < 2; ++ks) ab = MFMA16(*(const LAS bf16x8*)(HGT(1) + (16 * mt + fr) * HG_TLD + 32 * ks + 8 * fq), *(const LAS bf16x8*)(HGT(3) + (16 * nt + fr) * HG_TLD + 32 * ks + 8 * fq), ab); }
            const int s = 16 * nt + fr;
#pragma unroll
            for (int reg = 0; reg < 4; ++reg) { const int t = 16 * mt + 4 * fq + reg;
                const float v = ((s <= t) ? af[reg] : 0.f) + ((s >= t) ? ab[reg] : 0.f);
                HGT(7)[t * HG_TLD + s] = f2bf(v); } }
    }
    __syncthreads();
    if (wave < 4) {
        const int mt = wave;
        float gnv[4];
#pragma unroll
        for (int ni = 0; ni < 4; ++ni) gnv[ni] = gnorm[64 * h + 16 * ni + fr];
        f32x4 acc[4];
#pragma unroll
        for (int ni = 0; ni < 4; ++ni) acc[ni] = (f32x4){0.f, 0.f, 0.f, 0.f};
#pragma unroll
        for (int pr = 0; pr < 3; ++pr) { const LAS bf16_t* Am = (pr == 0) ? HGT(7) : (pr == 1) ? HGT(4) : HGT(5); const LAS bf16_t* Bm = (pr == 0) ? HGT(6) : (pr == 1) ? HGT(8) : HGT(9);
#pragma unroll
            for (int ks = 0; ks < 2; ++ks) { const bf16x8 a = *(const LAS bf16x8*)(Am + (16 * mt + fr) * HG_TLD + 32 * ks + 8 * fq);
#pragma unroll
                for (int ni = 0; ni < 4; ++ni) acc[ni] = MFMA16(a, *(const LAS bf16x8*)(Bm + (16 * ni + fr) * HG_TLD + 32 * ks + 8 * fq), acc[ni]); } }
#pragma unroll
        for (int reg = 0; reg < 4; ++reg) { const int t = 16 * mt + 4 * fq + reg;
            float ss = acc[0][reg] * acc[0][reg] + acc[1][reg] * acc[1][reg] + acc[2][reg] * acc[2][reg] + acc[3][reg] * acc[3][reg];
            ss += __shfl_xor(ss, 1); ss += __shfl_xor(ss, 2); ss += __shfl_xor(ss, 4); ss += __shfl_xor(ss, 8);
            const float rn = rsqrtf(ss * (1.f / 64.f) + EPSV);
            bf16_t* op = BR + (size_t)(t0 + t) * DM + 256 + 64 * h;
#pragma unroll
            for (int ni = 0; ni < 4; ++ni) { const int j = 16 * ni + fr; op[j] = f2bf(acc[ni][reg] * rn * gnv[ni] * siluf_(bf2f(gpre[reg][ni]))); } }
    }
#undef HGT
}

#define XB_TMO      128
#define XB_XCNT(j)  (256  + 64 * (j))
#define XB_XSUB(j)  (1280 + 64 * (j))
#define XB_XGEN(j)  (2304 + 64 * (j))
#define XB_TOP      3328
#define XB_TOPGEN   3392
#define XCD_BAR_WORDS 3456
#define XB_SPIN_CAP (1u << 22)
__device__ __forceinline__ unsigned xb_ld(unsigned* p)              { return __hip_atomic_load(p, __ATOMIC_RELAXED, __HIP_MEMORY_SCOPE_AGENT); }
__device__ __forceinline__ unsigned xb_add(unsigned* p, unsigned v) { return __hip_atomic_fetch_add(p, v, __ATOMIC_RELAXED, __HIP_MEMORY_SCOPE_AGENT); }
__device__ __forceinline__ unsigned xb_xcc_id() { return (unsigned)__builtin_amdgcn_s_getreg((3 << 11) | 20) & 0xFu; }
#define XB_SPIN(cond, bar) do { unsigned _sp = 0; while (cond) { __builtin_amdgcn_s_sleep(1); \
    if ((++_sp & 255u) == 0u) { if (xb_ld(&(bar)[XB_TMO])) break; if (_sp > XB_SPIN_CAP) { atomicAdd(&(bar)[XB_TMO], 1u); break; } } } } while (0)
struct XcdBarrier { unsigned* bar; unsigned x; volatile LAS unsigned* st; };
__device__ __forceinline__ XcdBarrier xcd_barrier_post(unsigned* bar, volatile LAS unsigned* st) {
    XcdBarrier b; b.bar = bar; b.x = xb_xcc_id(); b.st = st;
    if (threadIdx.x == 0) (void)xb_add(&bar[XB_XCNT(b.x)], 1u);
    return b;
}
__device__ __forceinline__ void xcd_barrier_complete(unsigned* bar, unsigned x, unsigned& nloc, unsigned& nx) {
    const unsigned G = gridDim.x * gridDim.y * gridDim.z;
    unsigned sum, cnt, mine, sp = 0u;
    for (;;) {
        sum = 0u; cnt = 0u; mine = 0u;
#pragma unroll
        for (unsigned j = 0; j < 16; ++j) { const unsigned c = xb_ld(&bar[XB_XCNT(j)]); sum += c; cnt += (c > 0u) ? 1u : 0u; mine = (j == x) ? c : mine; }
        if (sum == G) break;
        __builtin_amdgcn_s_sleep(1);
        if ((++sp & 255u) == 0u) { if (xb_ld(&bar[XB_TMO])) break; if (sp > XB_SPIN_CAP) { atomicAdd(&bar[XB_TMO], 1u); break; } }
    }
    nloc = mine > 0u ? mine : 1u; nx = cnt > 0u ? cnt : 1u;
}
__device__ __forceinline__ void xcd_barrier(unsigned* bar_in, volatile LAS unsigned* st_in) {
    XcdBarrier b; b.bar = bar_in; b.st = st_in; b.x = xb_xcc_id();
    asm volatile("s_waitcnt vmcnt(0)" ::: "memory");
    __syncthreads();
    if (threadIdx.x == 0) {
        unsigned* bar = b.bar;
        __builtin_amdgcn_s_waitcnt(0);
        unsigned nloc = b.st[0], nx = b.st[1];
        if (nloc == 0u) { xcd_barrier_complete(bar, b.x, nloc, nx); b.st[0] = nloc; b.st[1] = nx; }
        const unsigned old = xb_add(&bar[XB_XSUB(b.x)], 1u);
        const unsigned gen = old / nloc;
        if (old + 1u == (gen + 1u) * nloc) {
            __builtin_amdgcn_fence(__ATOMIC_RELEASE, "agent");
            asm volatile("s_waitcnt vmcnt(0)" ::: "memory");
            const unsigned og = xb_add(&bar[XB_TOP], 1u);
            const unsigned tg = og / nx;
            if (og + 1u == (tg + 1u) * nx) xb_add(&bar[XB_TOPGEN], 1u);
            else XB_SPIN(xb_ld(&bar[XB_TOPGEN]) == tg, bar);
            __builtin_amdgcn_fence(__ATOMIC_ACQUIRE, "agent");
            xb_add(&bar[XB_XGEN(b.x)], 1u);
            asm volatile("s_waitcnt vmcnt(0)" ::: "memory");
        } else {
            XB_SPIN(xb_ld(&bar[XB_XGEN(b.x)]) == gen, bar);
            __builtin_amdgcn_fence(__ATOMIC_ACQUIRE, "agent");
            asm volatile("s_waitcnt vmcnt(0)" ::: "memory");
        }
    }
    __syncthreads();
}

#define GRID_SYNC() xcd_barrier((unsigned*)(p.ws + OFF_CTL), (volatile LAS unsigned*)(lds + LDS_BYTES - 16))
#ifndef REP_DL
#define REP_DL 1
#endif
#ifndef REP_HGA
#define REP_HGA 1
#endif
#ifndef REP_NA
#define REP_NA 1
#endif
#ifndef REP_SG
#define REP_SG 1
#endif
#ifndef REP_HGC
#define REP_HGC 1
#endif
#define REP_A (REP_DL > REP_HGA ? REP_DL : REP_HGA)
#define REP_B (REP_NA > REP_SG ? REP_NA : REP_SG)
#ifndef MIXREP
#define MIXREP 1
#endif

__global__ void __launch_bounds__(512, 2) fwd_megakernel(Params p) {
    extern __shared__ __attribute__((aligned(16))) unsigned char smem[];
    LAS unsigned char* lds = (LAS unsigned char*)smem;
    cg::grid_group grid = cg::this_grid();
    unsigned char* ws = p.ws;
    const int G = gridDim.x, c = blockIdx.x;
    float* MOD = (float*)(ws + OFF_MOD);
    bf16_t* H = (bf16_t*)(ws + OFF_H); bf16_t* P = (bf16_t*)(ws + OFF_P); bf16_t* BR = (bf16_t*)(ws + OFF_BR); bf16_t* MG = (bf16_t*)(ws + OFF_MG);
    bf16_t* ACT = P;
    float* HGST = (float*)(ws + OFF_HGST); float* HGD = (float*)(ws + OFF_HGD);

    volatile LAS unsigned* xst = (volatile LAS unsigned*)(lds + LDS_BYTES - 16);
    if (threadIdx.x == 0) { xst[0] = 0u; xst[1] = 0u; }
    __syncthreads();
    (void)xcd_barrier_post((unsigned*)(ws + OFF_CTL), xst);
#ifndef SKIP_PRO
    phase_prologue(p, lds);
#endif
    grid.sync();
    phase_mod_reduce(p);
    GRID_SYNC();

    for (int ck = 0; ck < NCHUNK; ++ck) {
        const int L = chunk_L(ck), bbase = chunk_bbase(ck);
        float* X = p.out + (size_t)ck * TC * DM;
        const float* xin = (ck < 2) ? p.in[0] + (size_t)ck * TC * DM : p.in[1];
        for (int l = 0; l < NLAYER; ++l) {
            const float* modl = MOD + (size_t)l * 6144;
            phase_norm_mod(l == 0 ? xin : X, l == 0 ? X : nullptr, H, p.in[6] + l * DM, modl + 0, modl + 1024, L, bbase);
            GRID_SYNC();
#ifndef SKIP_G1
            { SchedStd S; S.to.init(TC / 256, (G == 256) ? NIN / 256 - 1 : NIN / 256, G, c); S.skip_pn = (G == 256) ? (P_HGATE / 256) : 1000; S.A = (const char*)H; S.B = (const char*)(ws + OFF_WIN) + (size_t)l * NIN * DM * 2; S.atile = 256 * DM * 2; S.btile = 256 * DM * 2; S.nt = DM / 64;
              EpiProj E; E.O = P; E.ldc = NIN;
              pg8::gemm_phase(lds, DM, DM, S, E); }
            #endif
            GRID_SYNC();
            for (int rep = 0; rep < MIXREP; ++rep) {
#ifndef SKIP_MIX1
            hg_lb_table(p.in[14], l, lds);
            for (int rr_ = 0; rr_ < REP_A; ++rr_)
            for (int it = c; it < 256 + 1024; it += G) {
                if (it >= 256 && rr_ >= REP_HGA) continue;
                if (it < 256 && rr_ >= REP_DL) continue;
                if (it < 256) { int item = it;
                    if (G == 256) { const int x = it & 7, y = it >> 3, spans = L >> 8, q = x + 8 * (y / spans), span = y % spans;
                        item = (((q >> 2) * spans + span) << 2) | (q & 3); }
                    dl_item(item, P, BR, L, lds); }
                else hgA_item(it - 256, P, HGST, HGD, lds);
            }
            #endif
            GRID_SYNC();
#ifndef SKIP_MIX2
            hgB_phase(HGST, HGD, L);
            if (G == 256) {
                __syncthreads(); na_item((c & 7) * 32 + (c >> 3), P, BR, p.in[13] + (size_t)l * 4 * 15 * 31, L, lds);
                const int y = c >> 3, x = c & 7;
                if ((y & 3) == 0) {
                    __syncthreads();
                    SchedOne S; S.pm = (y >> 2) * 8 + x; S.pn = P_HGATE / 256; S.nt = DM / 64;
                    S.A = (const char*)H + (size_t)S.pm * (256 * DM * 2); S.B = (const char*)(ws + OFF_WIN) + ((size_t)l * NIN + P_HGATE) * DM * 2;
                    EpiProj E; E.O = P; E.ldc = NIN;
                    pg8::gemm_phase(lds, DM, DM, S, E);
                } else {
                    const int rank = (y - (y >> 2) - 1) * 8 + x;
                    for (int it = rank; it < 512; it += 192)
                        sg_item(it, P, BR, (const bf16_t*)(ws + OFF_SGW) + (size_t)l * 4 * 128 * 128, p.in[16] + l * 256, p.in[17] + l * 256, p.in[19] + l * 512, lds);
                }
            } else {
                for (int it = c; it < 256 + 512; it += G) {
                    if (it < 256) { __syncthreads(); na_item(it, P, BR, p.in[13] + (size_t)l * 4 * 15 * 31, L, lds); }
                    else sg_item(it - 256, P, BR, (const bf16_t*)(ws + OFF_SGW) + (size_t)l * 4 * 128 * 128, p.in[16] + l * 256, p.in[17] + l * 256, p.in[19] + l * 512, lds);
                }
            }
            #endif
            GRID_SYNC();
#ifndef SKIP_MIX3
            hg_lb_table(p.in[14], l, lds);
            for (int rr_ = 0; rr_ < REP_HGC; ++rr_)
            for (int it = c; it < 1024; it += G) hgC_item(it, P, BR, HGST, p.in[15] + l * 256, lds);
            #endif
            GRID_SYNC();
            }
#ifndef SKIP_MERGE
            { SchedMerge S; S.to.init(TC / 256, DM / 256, G, c); S.H = (const char*)H; S.BR = (const char*)BR; S.WG = (const char*)(ws + OFF_WG) + (size_t)l * 4 * DM * DM * 2; S.WB = (const char*)(ws + OFF_WB) + (size_t)l * DM * DM * 2;
              EpiMerge E; E.MG = MG; E.bgate = p.in[10] + (size_t)l * 4 * DM; E.scr = (unsigned char*)P + (size_t)c * MERGE_SCR_PER_BLOCK;
              pg8::gemm_phase(lds, DM, DM, S, E); }
            #endif
            GRID_SYNC();
#ifndef SKIP_WO
            { SchedStd S; S.to.init(TC / 256, DM / 256, G, c); S.skip_pn = 1000; S.A = (const char*)MG; S.B = (const char*)(ws + OFF_WO) + (size_t)l * DM * DM * 2; S.atile = 256 * DM * 2; S.btile = 256 * DM * 2; S.nt = DM / 64;
              EpiRes E; E.X = X; E.gm = modl + 2048; E.L = L; E.bbase = bbase;
              pg8::gemm_phase(lds, DM, DM, S, E); }
            #endif
            GRID_SYNC();
            phase_norm_mod(X, nullptr, H, p.in[7] + l * DM, modl + 3072, modl + 4096, L, bbase);
            GRID_SYNC();
#ifndef SKIP_F1
            { SchedStd S; S.to.init(TC / 256, 2 * DFF / 256, G, c); S.skip_pn = 1000; S.A = (const char*)H; S.B = (const char*)(ws + OFF_WGU) + (size_t)l * 2 * DFF * DM * 2; S.atile = 256 * DM * 2; S.btile = 256 * DM * 2; S.nt = DM / 64;
              EpiAct E; E.O = ACT;
              pg8::gemm_phase(lds, DM, DM, S, E); }
            #endif
            GRID_SYNC();
#ifndef SKIP_F2
            { SchedStd S; S.to.init(TC / 256, DM / 256, G, c); S.skip_pn = 1000; S.A = (const char*)ACT; S.B = (const char*)(ws + OFF_WD) + (size_t)l * DM * DFF * 2; S.atile = (size_t)256 * DFF * 2; S.btile = (size_t)256 * DFF * 2; S.nt = DFF / 64;
              EpiRes E; E.X = X; E.gm = modl + 5120; E.L = L; E.bbase = bbase;
              pg8::gemm_phase(lds, DFF, DFF, S, E); }
            #endif
            GRID_SYNC();
        }
        phase_final_norm(X, p.in[23]);
    }
}

extern "C" void kernel_launch(void* const* d_in, const int* in_sizes, int n_in, void* d_out, int out_size, void* d_ws, size_t ws_size, hipStream_t stream) {
    static int grid = 0;
    if (grid == 0) {
        if (n_in != 24 || ws_size < WS_END) { fprintf(stderr, "kernel_launch: unexpected n_in %d or ws_size %zu (need %zu)\n", n_in, ws_size, (size_t)WS_END); grid = -1; return; }
        int dev = 0, cus = 0, per_cu = 0;
        hipGetDevice(&dev);
        hipDeviceGetAttribute(&cus, hipDeviceAttributeMultiprocessorCount, dev);
        if (hipFuncSetAttribute((const void*)fwd_megakernel, hipFuncAttributeMaxDynamicSharedMemorySize, LDS_BYTES) != hipSuccess) { fprintf(stderr, "kernel_launch: hipFuncSetAttribute failed\n"); grid = -1; return; }
        hipOccupancyMaxActiveBlocksPerMultiprocessor(&per_cu, (const void*)fwd_megakernel, NTHR, LDS_BYTES);
        if (per_cu < 1) { fprintf(stderr, "kernel_launch: occupancy query says %d blocks per CU\n", per_cu); per_cu = 1; }
        (void)hipGetLastError();
        grid = cus;
        if (grid > 272) grid = 272;
    }
    if (grid < 0) return;
    if (hipMemsetAsync((char*)d_ws + OFF_CTL, 0, 16384, stream) != hipSuccess) { fprintf(stderr, "kernel_launch: memset of control words failed\n"); return; }
    Params p{};
    for (int i = 0; i < 24; ++i) p.in[i] = (const float*)d_in[i];
    p.out = (float*)d_out; p.ws = (unsigned char*)d_ws;
    void* args[] = {&p};
    hipError_t e = hipLaunchCooperativeKernel((const void*)fwd_megakernel, dim3(grid), dim3(NTHR), args, LDS_BYTES, stream);
    if (e != hipSuccess) fprintf(stderr, "cooperative launch failed: %s (grid %d)\n", hipGetErrorString(e), grid);
}
```
